# Optimizing an MI355X kernel written in HIP

```python
import math
import jax
import jax.numpy as jnp
from jax import lax
import numpy as np

D_MODEL = 4096
BATCH = 1
SEQ = 16384
DEPTH = 2

D_LRU = D_MODEL // 4
D_HYENA = D_MODEL // 4
D_RET = D_MODEL // 2
MIX_WIDTH = D_LRU + D_HYENA + D_RET

LRU_HEADS = 8
LRU_HEAD_DIM = D_LRU // LRU_HEADS
LRU_CONV = 4
LRU_C = 8.0

HYENA_ORDER = 2
HYENA_GROUPS = 8
HYENA_CONV = 3
HYENA_EMB = 33
HYENA_FILTER_HIDDEN = 64
HYENA_N_FILTERS = 2 * HYENA_ORDER
HYENA_MIN_DECAY = math.log(1e-2) / 0.3
HYENA_MAX_DECAY = math.log(1e-2) / 1.5

RET_HEADS = 8
RET_KEY_DIM = 128
RET_VAL_DIM = D_RET // RET_HEADS
RET_CHUNK = 128
ROPE_BASE = 10000.0

D_FF = ((8 * D_MODEL + 3 * 256 - 1) // (3 * 256)) * 256

EPS = 1e-6
QK_WIDTH = RET_HEADS * RET_KEY_DIM
IN_WIDTH = 2 * D_LRU + 3 * D_HYENA + 2 * QK_WIDTH + 2 * D_RET
IN_SPLITS = (
    D_LRU,
    2 * D_LRU,
    2 * D_LRU + 3 * D_HYENA,
    2 * D_LRU + 3 * D_HYENA + QK_WIDTH,
    2 * D_LRU + 3 * D_HYENA + 2 * QK_WIDTH,
    2 * D_LRU + 3 * D_HYENA + 2 * QK_WIDTH + D_RET,
)

kernel_name = "hybrid_lru_hyena_retention_encoder"


def rms_norm(x, gain):
    xf = x.astype(jnp.float32)
    y = xf * lax.rsqrt(jnp.mean(xf * xf, axis=-1, keepdims=True) + EPS)
    return (y * gain.astype(jnp.float32)).astype(x.dtype)


def group_rms_norm(y, gain, groups):
    b, s, w = y.shape
    yg = y.reshape(b, s, groups, w // groups)
    yg = yg * lax.rsqrt(jnp.mean(yg * yg, axis=-1, keepdims=True) + EPS)
    return yg.reshape(b, s, w) * gain.astype(jnp.float32)


def centred_dwconv(x, w, bias):
    width = w.shape[0]
    left = width // 2
    s = x.shape[1]
    xp = jnp.pad(x, ((0, 0), (left, width - 1 - left), (0, 0)))
    w = w.astype(jnp.float32)
    y = bias.astype(jnp.float32)
    for j in range(width):
        y = y + xp[:, j:j + s] * w[j]
    return y


def _linear_recurrence(left, right):
    a1, b1 = left
    a2, b2 = right
    return a1 * a2, a2 * b1 + b2


def rg_lru_bidir(xc, wr, br, wi, bi, lam):
    b, s, c = xc.shape
    xh = xc.reshape(b, s, LRU_HEADS, LRU_HEAD_DIM)
    f32 = jnp.float32
    r = jax.nn.sigmoid(jnp.einsum('bshi,dhij->dbshj', xh, wr.astype(f32)).reshape(2, b, s, c)
                       + br.astype(f32)[:, None, None, :])
    i = jax.nn.sigmoid(jnp.einsum('bshi,dhij->dbshj', xh, wi.astype(f32)).reshape(2, b, s, c)
                       + bi.astype(f32)[:, None, None, :])
    log_a = -LRU_C * r * jax.nn.softplus(-lam.astype(f32))[:, None, None, :]
    a = jnp.exp(log_a)
    inp = jnp.sqrt(-jnp.expm1(2.0 * log_a)) * (i * xc[None])
    _, h_fwd = lax.associative_scan(_linear_recurrence, (a[0], inp[0]), axis=1)
    _, h_bwd = lax.associative_scan(_linear_recurrence, (a[1], inp[1]), axis=1, reverse=True)
    return h_fwd + h_bwd


def implicit_filters(length, w1, b1, w2, b2, w3, freq, decay):
    f32 = jnp.float32
    bands = (HYENA_EMB - 1) // 2
    t = jnp.linspace(0.0, 1.0, length, dtype=f32)[:, None]
    omega = (2.0 * math.pi / length) * jnp.arange(length, dtype=f32)[:, None]
    f = jnp.linspace(1e-4, bands - 1, bands, dtype=f32)[None, :]
    feats = jnp.concatenate([t, jnp.cos(f * omega), -jnp.sin(f * omega)], axis=-1)
    freq = freq.astype(f32)
    hdn = jnp.sin(freq * (feats @ w1.astype(f32) + b1.astype(f32)))
    hdn = jnp.sin(freq * (hdn @ w2.astype(f32) + b2.astype(f32)))
    filt = (hdn @ w3.astype(f32)).reshape(length, HYENA_ORDER, 2, D_HYENA)
    rates = jnp.abs(decay.astype(f32)).reshape(HYENA_ORDER, 2, D_HYENA)
    window = jnp.exp(-t[:, :, None, None] * rates[None])
    return filt * window


def two_sided(h_fwd, h_bwd):
    zero = jnp.zeros_like(h_fwd[:1])
    return jnp.concatenate([h_fwd[:1] + h_bwd[:1], h_fwd[1:], zero, h_bwd[:0:-1]], axis=0)


def long_conv(z, g):
    length = z.shape[1]
    zf = jnp.fft.rfft(z, n=2 * length, axis=1)
    gf = jnp.fft.rfft(g, n=2 * length, axis=0)
    return jnp.fft.irfft(zf * gf[None], n=2 * length, axis=1)[:, :length]


def hyena_bidir(u, conv_w, conv_b, f_w1, f_b1, f_w2, f_b2, f_w3, freq, decay, skip):
    length = u.shape[1]
    u = centred_dwconv(u, conv_w, conv_b)
    v, *gates = jnp.split(u, HYENA_ORDER + 1, axis=-1)
    filt = implicit_filters(length, f_w1, f_b1, f_w2, f_b2, f_w3, freq, decay)
    skip = skip.astype(jnp.float32)
    z = v
    for o in range(HYENA_ORDER):
        g = two_sided(filt[:, o, 0], filt[:, o, 1])
        z = gates[o] * (long_conv(z, g) + skip[o] * z)
    return z


def rotary(x, pos):
    half = x.shape[-1] // 2
    inv = ROPE_BASE ** (-jnp.arange(half, dtype=jnp.float32) / half)
    ang = pos[:, None] * inv[None, :]
    cos = jnp.cos(ang)[None, :, None, :]
    sin = jnp.sin(ang)[None, :, None, :]
    x1, x2 = x[..., :half], x[..., half:]
    return jnp.concatenate([x1 * cos - x2 * sin, x1 * sin + x2 * cos], axis=-1)


def retention_bidir(q, k, v):
    b, s, nh, dk = q.shape
    dv = v.shape[-1]
    c = RET_CHUNK
    nc = s // c
    f32 = jnp.float32
    log_g = jnp.log1p(-jnp.exp2(-5.0 - jnp.arange(nh, dtype=f32)))
    qc = q.reshape(b, nc, c, nh, dk).transpose(0, 3, 1, 2, 4)
    kc = k.reshape(b, nc, c, nh, dk).transpose(0, 3, 1, 2, 4)
    vc = v.reshape(b, nc, c, nh, dv).transpose(0, 3, 1, 2, 4)
    idx = jnp.arange(c, dtype=f32)
    lg = log_g[:, None]
    intra_decay = jnp.exp(lg[:, :, None] * jnp.abs(idx[:, None] - idx[None, :]))
    scores = jnp.einsum('bhnid,bhnjd->bhnij', qc, kc) * intra_decay[None, :, None]
    y = jnp.einsum('bhnij,bhnje->bhnie', scores, vc)
    k_to_end = kc * jnp.exp(lg * (c - 1 - idx))[None, :, None, :, None]
    k_to_start = kc * jnp.exp(lg * idx)[None, :, None, :, None]
    kv_fwd = jnp.einsum('bhncd,bhnce->nbhde', k_to_end, vc)
    kv_bwd = jnp.einsum('bhncd,bhnce->nbhde', k_to_start, vc)
    chunk_decay = jnp.exp(log_g * c)[None, :, None, None]

    def step(state, kv):
        return chunk_decay * state + kv, state

    init = jnp.zeros((b, nh, dk, dv), f32)
    _, s_prev = lax.scan(step, init, kv_fwd)
    _, s_next = lax.scan(step, init, kv_bwd, reverse=True)
    q_fwd = qc * jnp.exp(lg * (idx + 1.0))[None, :, None, :, None]
    q_bwd = qc * jnp.exp(lg * (c - idx))[None, :, None, :, None]
    y = y + jnp.einsum('bhnid,nbhde->bhnie', q_fwd, s_prev) \
          + jnp.einsum('bhnid,nbhde->bhnie', q_bwd, s_next)
    return y.transpose(0, 2, 3, 1, 4).reshape(b, s, nh * dv)


def hybrid_mixer(h, w_in, lru_conv_w, lru_conv_b, lru_wr, lru_br, lru_wi, lru_bi, lru_lambda,
                 lru_norm, hy_conv_w, hy_conv_b, hy_f_w1, hy_f_b1, hy_f_w2, hy_f_b2, hy_f_w3,
                 hy_freq, hy_decay, hy_skip, hy_norm, ret_norm, w_out):
    b, s, _ = h.shape
    f32 = jnp.float32
    proj = (h @ w_in).astype(f32)
    lru_gate, lru_x, hy_u, q, k, v, g = jnp.split(proj, IN_SPLITS, axis=-1)
    xc = centred_dwconv(lru_x, lru_conv_w, lru_conv_b)
    h_lru = rg_lru_bidir(xc, lru_wr, lru_br, lru_wi, lru_bi, lru_lambda)
    y_a = group_rms_norm(jax.nn.gelu(lru_gate, approximate=True) * h_lru, lru_norm, LRU_HEADS)
    y_b = group_rms_norm(
        hyena_bidir(hy_u, hy_conv_w, hy_conv_b, hy_f_w1, hy_f_b1, hy_f_w2, hy_f_b2, hy_f_w3,
                    hy_freq, hy_decay, hy_skip),
        hy_norm, HYENA_GROUPS)
    pos = jnp.arange(s, dtype=f32)
    q = rotary(q.reshape(b, s, RET_HEADS, RET_KEY_DIM), pos)
    k = rotary(k.reshape(b, s, RET_HEADS, RET_KEY_DIM), pos) * (RET_KEY_DIM ** -0.5)
    y_ret = retention_bidir(q, k, v.reshape(b, s, RET_HEADS, RET_VAL_DIM))
    y_c = jax.nn.silu(g) * group_rms_norm(y_ret, ret_norm, RET_HEADS)
    mix = jnp.concatenate([y_a, y_b, y_c], axis=-1).astype(h.dtype)
    return mix @ w_out


def swiglu(h, w_gate, w_up, w_down):
    return (jax.nn.silu(h @ w_gate) * (h @ w_up)) @ w_down


def setup_inputs(seed: int = 0) -> dict:
    f32 = jnp.float32
    key = jax.random.key(seed)
    keys = list(jax.random.split(key, 32))
    L = DEPTH

    def nrm(shape, scale):
        return jax.random.normal(keys.pop(), shape, f32) * scale

    def gain(shape):
        return 1.0 + nrm(shape, 0.01)

    def lru_lambda_init():
        u = jax.random.uniform(keys.pop(), (L, 2, D_LRU), f32, 0.9, 0.999)
        a = u ** (1.0 / LRU_C)
        return jnp.log(a) - jnp.log1p(-a)

    base_decay = jnp.linspace(HYENA_MIN_DECAY, HYENA_MAX_DECAY, D_HYENA, dtype=f32)
    return {
        "x": nrm((BATCH, SEQ, D_MODEL), 1.0),
        "norm_mix": gain((L, D_MODEL)),
        "w_in": nrm((L, D_MODEL, IN_WIDTH), D_MODEL ** -0.5),
        "lru_conv_w": nrm((L, LRU_CONV, D_LRU), LRU_CONV ** -0.5),
        "lru_conv_b": nrm((L, D_LRU), 0.01),
        "lru_wr": nrm((L, 2, LRU_HEADS, LRU_HEAD_DIM, LRU_HEAD_DIM), LRU_HEAD_DIM ** -0.5),
        "lru_br": nrm((L, 2, D_LRU), 0.01),
        "lru_wi": nrm((L, 2, LRU_HEADS, LRU_HEAD_DIM, LRU_HEAD_DIM), LRU_HEAD_DIM ** -0.5),
        "lru_bi": nrm((L, 2, D_LRU), 0.01),
        "lru_lambda": lru_lambda_init(),
        "lru_norm": gain((L, D_LRU)),
        "hy_conv_w": nrm((L, HYENA_CONV, 3 * D_HYENA), HYENA_CONV ** -0.5),
        "hy_conv_b": nrm((L, 3 * D_HYENA), 0.01),
        "hy_f_w1": nrm((L, HYENA_EMB, HYENA_FILTER_HIDDEN), HYENA_EMB ** -0.5),
        "hy_f_b1": nrm((L, HYENA_FILTER_HIDDEN), 0.02),
        "hy_f_w2": nrm((L, HYENA_FILTER_HIDDEN, HYENA_FILTER_HIDDEN), HYENA_FILTER_HIDDEN ** -0.5),
        "hy_f_b2": nrm((L, HYENA_FILTER_HIDDEN), 0.02),
        "hy_f_w3": nrm((L, HYENA_FILTER_HIDDEN, HYENA_N_FILTERS * D_HYENA), HYENA_FILTER_HIDDEN ** -0.5),
        "hy_freq": gain((L, HYENA_FILTER_HIDDEN)),
        "hy_decay": base_decay[None, None, :] * (1.0 + nrm((L, HYENA_N_FILTERS, D_HYENA), 0.05)),
        "hy_skip": nrm((L, HYENA_ORDER, D_HYENA), 1.0),
        "hy_norm": gain((L, D_HYENA)),
        "ret_norm": gain((L, D_RET)),
        "w_out": nrm((L, MIX_WIDTH, D_MODEL), MIX_WIDTH ** -0.5),
        "norm_ffn": gain((L, D_MODEL)),
        "w_gate": nrm((L, D_MODEL, D_FF), D_MODEL ** -0.5),
        "w_up": nrm((L, D_MODEL, D_FF), D_MODEL ** -0.5),
        "w_down": nrm((L, D_FF, D_MODEL), D_FF ** -0.5),
        "norm_final": gain((D_MODEL,)),
    }


def reference(x, norm_mix, w_in, lru_conv_w, lru_conv_b, lru_wr, lru_br, lru_wi, lru_bi,
              lru_lambda, lru_norm, hy_conv_w, hy_conv_b, hy_f_w1, hy_f_b1, hy_f_w2, hy_f_b2,
              hy_f_w3, hy_freq, hy_decay, hy_skip, hy_norm, ret_norm, w_out, norm_ffn,
              w_gate, w_up, w_down, norm_final):
    for l in range(DEPTH):
        h = rms_norm(x, norm_mix[l])
        x = x + hybrid_mixer(h, w_in[l], lru_conv_w[l], lru_conv_b[l], lru_wr[l], lru_br[l],
                             lru_wi[l], lru_bi[l], lru_lambda[l], lru_norm[l], hy_conv_w[l],
                             hy_conv_b[l], hy_f_w1[l], hy_f_b1[l], hy_f_w2[l], hy_f_b2[l],
                             hy_f_w3[l], hy_freq[l], hy_decay[l], hy_skip[l], hy_norm[l],
                             ret_norm[l], w_out[l])
        h = rms_norm(x, norm_ffn[l])
        x = x + swiglu(h, w_gate[l], w_up[l], w_down[l])
    return rms_norm(x, norm_final)
```

```cpp
#include <hip/hip_runtime.h>
#include <cstdio>
#include <cstdint>

#define DEV __device__ __forceinline__
#define GAS __attribute__((address_space(1)))
#define LAS __attribute__((address_space(3)))
typedef unsigned short bf16;
typedef unsigned v4u __attribute__((ext_vector_type(4)));
typedef unsigned v2u __attribute__((ext_vector_type(2)));
typedef float f32x4 __attribute__((ext_vector_type(4)));
typedef float f32x2 __attribute__((ext_vector_type(2)));
typedef short bf16x8 __attribute__((ext_vector_type(8)));

constexpr int M = 16384, D = 4096, DL = 1024, DH = 1024, DR = 2048, NIN = 11264, DFF = 11008, NGU = 22016, NLAYER = 2;
constexpr float EPS = 1e-6f;

DEV float bflo(unsigned w) { return __uint_as_float(w << 16); }
DEV float bfhi(unsigned w) { return __uint_as_float(w & 0xffff0000u); }
DEV float bf2f(bf16 v) { return __uint_as_float(((unsigned)v) << 16); }
DEV unsigned pk2(float lo, float hi) { unsigned r; asm volatile("v_cvt_pk_bf16_f32 %0, %1, %2" : "=v"(r) : "v"(lo), "v"(hi)); return r; }
DEV bf16 f2bf(float f) { return (bf16)(pk2(f, 0.f) & 0xffffu); }
DEV float sigmoidf_(float x) { return 1.f / (1.f + __expf(-x)); }
DEV float siluf_(float x) { return x / (1.f + __expf(-x)); }
DEV float gelu_tanh_(float x) { const float u = 0.7978845608028654f * (x + 0.044715f * x * x * x); return x - x / (1.f + __expf(2.f * u)); }

namespace pg8 {
#define PG8_LAS __attribute__((address_space(3)))
typedef unsigned short bf16_t;
typedef short bf16x8 __attribute__((ext_vector_type(8)));
typedef float f32x4 __attribute__((ext_vector_type(4)));
typedef unsigned u32x4 __attribute__((ext_vector_type(4)));
constexpr int BM = 256, BK = 64, HALF = 128, HTB = HALF * BK * 2  , STAGE_BYTES = 8 * HTB, NXCD = 8, WGM = 8;

__host__ __device__ __forceinline__ int lds_byte(int r, int c) { const int st = (r >> 4) * 2 + (c >> 5), rr = r & 15, cc = c & 31, ob = rr * 64 + cc * 2; return st * 1024 + (ob ^ (((ob >> 9) & 1) << 5)); }
__host__ __device__ __forceinline__ void stage_rc(int b, int& R, int& C) { const int st = b / 1024, sb = b % 1024, swz = sb ^ (((sb >> 9) & 1) << 5); R = (st >> 1) * 16 + swz / 64; C = (st & 1) * 32 + (swz % 64) / 2; }
__host__ __device__ __forceinline__ int perm32(int rho) { const int n = rho >> 4, i = rho & 15; return 8 * (i >> 2) + 4 * n + (i & 3); }

struct Unit { int pm, pn; };
struct Gemm { const bf16_t* A; const bf16_t* Bt; int M, N, K; };

struct StaticOrder {
    int nM, nN, nwg, G, c;
    __host__ __device__ void init(int M, int N, int G_, int c_) { nM = M / BM; nN = N / BM; nwg = nM * nN; G = G_; c = c_; }
    __host__ __device__ bool next(int i, Unit& u) const {
        const long L = (long)i * G + c; if (L >= nwg) return false;
        int wgid = (int)L; { const int q = nwg / NXCD, r = nwg % NXCD, xcd = wgid % NXCD, off = wgid / NXCD; wgid = (xcd < r ? xcd * (q + 1) : r * (q + 1) + (xcd - r) * q) + off; }
        const int nig = WGM * nN, gid = wgid / nig, fm = gid * WGM, gsz = (nM - fm) < WGM ? (nM - fm) : WGM;
        u.pm = fm + ((wgid % nig) % gsz); u.pn = (wgid % nig) / gsz; return true;
    }
    __device__ __forceinline__ void a_ready(const Unit&) const {}
    __device__ __forceinline__ void done(const Unit&) const {}
};
template <class Epi, class Sched, bool ALIGN_EPI = false, bool SP2 = false>
__device__ __forceinline__ void gemm_phase(PG8_LAS unsigned char* lds, const Gemm g, const Sched& S, const Epi& E) {
    int tid = threadIdx.x; asm volatile("" : "+v"(tid));
    const int wid = __builtin_amdgcn_readfirstlane(tid >> 6), lane = tid & 63, wr = wid >> 2, wc = wid & 3, fr = lane & 15, fq = lane >> 4;
    const int K = g.K, nt = K / BK;
    unsigned voffA[2], voffB[2];
#pragma unroll
    for (int i = 0; i < 2; ++i) { int R, C; stage_rc(tid * 16 + i * 8192, R, C); const int Rb = Epi::PERM ? ((R & ~31) + perm32(R & 31)) : R;
        voffA[i] = (unsigned)(R * K + C) * 2u; voffB[i] = (unsigned)(Rb * K + C) * 2u; }
    const size_t kstep = (size_t)(BK * 2);
    const size_t hstep = (size_t)HALF * K * 2;
    const size_t tstep = 2 * hstep;
    const unsigned ldsw = (unsigned)wid * 1024u;
    const int aoff = lds_byte(wr * 64 + fr, fq * 8), boff = lds_byte(wc * 32 + fr, fq * 8);
#define PG8_SA(b, h) (((b) * 2 + (h)) * HTB)
#define PG8_SB(b, h) ((4 + (b) * 2 + (h)) * HTB)
#define PG8_STAGE(bufoff, gbase, voff) do { _Pragma("unroll") for (int _i = 0; _i < 2; ++_i) \
        __builtin_amdgcn_global_load_lds((const unsigned*)((const char*)(gbase) + (voff)[_i]), (PG8_LAS unsigned*)(lds + (bufoff) + ldsw + _i * 8192), 16, 0, 0); } while (0)
#define PG8_LDA(dst, b, h) do { _Pragma("unroll") for (int m = 0; m < 4; ++m) _Pragma("unroll") for (int k = 0; k < 2; ++k) dst[m][k] = *(const PG8_LAS bf16x8*)(lds + PG8_SA(b, h) + aoff + m * 2048 + k * 1024); } while (0)
#define PG8_LDB(dst, b, h) do { _Pragma("unroll") for (int n = 0; n < 2; ++n) _Pragma("unroll") for (int k = 0; k < 2; ++k) dst[n][k] = *(const PG8_LAS bf16x8*)(lds + PG8_SB(b, h) + boff + n * 2048 + k * 1024); } while (0)
#define PG8_MMA(ai, bj, At, Bt) do { __builtin_amdgcn_s_setprio(1); _Pragma("unroll") for (int m = 0; m < 4; ++m) _Pragma("unroll") for (int n = 0; n < 2; ++n) _Pragma("unroll") for (int k = 0; k < 2; ++k) \
        acc[ai][bj][m][n] = __builtin_amdgcn_mfma_f32_16x16x32_bf16(Bt[n][k], At[m][k], acc[ai][bj][m][n], 0, 0, 0); __builtin_amdgcn_s_setprio(0); } while (0)
#define PG8_WAIT_V(n) asm volatile("s_waitcnt vmcnt(" #n ")" ::: "memory")
#define PG8_WAIT_L(n) asm volatile("s_waitcnt lgkmcnt(" #n ")" ::: "memory")
#define PG8_BAR __builtin_amdgcn_s_barrier()
#define PG8_SCHED __builtin_amdgcn_sched_barrier(0)
    Unit cur, nxt; int ui = 0;
    if (!S.next(0, cur)) return;
    f32x4 acc[2][2][4][2];
#pragma unroll
    for (int a = 0; a < 2; ++a)
#pragma unroll
        for (int b = 0; b < 2; ++b)
#pragma unroll
            for (int m = 0; m < 4; ++m)
#pragma unroll
                for (int n = 0; n < 2; ++n) acc[a][b][m][n] = (f32x4){0.f, 0.f, 0.f, 0.f};
    bf16x8 At[4][2], B0[2][2], B1[2][2];
    const char* cA = (const char*)g.A + (size_t)cur.pm * tstep; const char* cB = (const char*)g.Bt + (size_t)cur.pn * tstep;
    S.a_ready(cur);
    if constexpr (SP2) {
        PG8_STAGE(PG8_SB(0, 0), cB, voffB); PG8_STAGE(PG8_SB(0, 1), cB + hstep, voffB); PG8_STAGE(PG8_SA(0, 0), cA, voffA); PG8_STAGE(PG8_SA(0, 1), cA + hstep, voffA);
        if (wr == 1) PG8_BAR;
        PG8_WAIT_V(2); PG8_BAR;
        PG8_STAGE(PG8_SB(1, 0), cB + kstep, voffB); PG8_STAGE(PG8_SA(1, 0), cA + kstep, voffA); PG8_STAGE(PG8_SB(1, 1), cB + hstep + kstep, voffB);
        PG8_WAIT_V(6); PG8_BAR;
    } else {
        PG8_STAGE(PG8_SB(0, 0), cB, voffB); PG8_STAGE(PG8_SA(0, 0), cA, voffA); PG8_STAGE(PG8_SB(0, 1), cB + hstep, voffB); PG8_STAGE(PG8_SA(0, 1), cA + hstep, voffA);
        if (wr == 1) PG8_BAR;
        PG8_WAIT_V(4); PG8_BAR;
        PG8_STAGE(PG8_SB(1, 0), cB + kstep, voffB); PG8_STAGE(PG8_SA(1, 0), cA + kstep, voffA); PG8_STAGE(PG8_SB(1, 1), cB + hstep + kstep, voffB);
        PG8_WAIT_V(6); PG8_BAR;
    }
    for (;;) {
        const bool has_next = S.next(ui + 1, nxt);
        const char* nA = has_next ? (const char*)g.A + (size_t)nxt.pm * tstep : cA; const char* nB = has_next ? (const char*)g.Bt + (size_t)nxt.pn * tstep : cB;
        for (int t = 0; t < nt; t += 2) {
            const bool last = (t == nt - 2);
            const char* a1 = cA + (size_t)(t + 1) * kstep;
            const char* a2 = last ? nA : cA + (size_t)(t + 2) * kstep; const char* b2 = last ? nB : cB + (size_t)(t + 2) * kstep;
            const char* a3 = a2 + kstep; const char* b3 = b2 + kstep;
            if (last && has_next) S.a_ready(nxt);
            if constexpr (SP2) {
            PG8_LDB(B0, 0, 0); PG8_LDB(B1, 0, 1); PG8_SCHED; PG8_LDA(At, 0, 0); PG8_STAGE(PG8_SA(1, 1), a1 + hstep, voffA);
            PG8_WAIT_V(8); PG8_WAIT_L(0); PG8_BAR; PG8_MMA(0, 0, At, B0); PG8_MMA(0, 1, At, B1); PG8_BAR; PG8_SCHED;
            PG8_LDA(At, 0, 1); PG8_STAGE(PG8_SB(0, 0), b2, voffB); PG8_STAGE(PG8_SB(0, 1), b2 + hstep, voffB); PG8_STAGE(PG8_SA(0, 0), a2, voffA);
            PG8_WAIT_V(8); PG8_WAIT_L(0); PG8_BAR; PG8_MMA(1, 0, At, B0); PG8_MMA(1, 1, At, B1); PG8_BAR; PG8_SCHED;
            PG8_LDB(B0, 1, 0); PG8_LDB(B1, 1, 1); PG8_SCHED; PG8_LDA(At, 1, 0); PG8_STAGE(PG8_SA(0, 1), a2 + hstep, voffA);
            PG8_WAIT_V(8); PG8_WAIT_L(0); PG8_BAR; PG8_MMA(0, 0, At, B0); PG8_MMA(0, 1, At, B1); PG8_BAR; PG8_SCHED;
            PG8_LDA(At, 1, 1); PG8_STAGE(PG8_SB(1, 0), b3, voffB); PG8_STAGE(PG8_SB(1, 1), b3 + hstep, voffB); PG8_STAGE(PG8_SA(1, 0), a3, voffA);
            PG8_WAIT_V(8); PG8_WAIT_L(0); PG8_BAR; PG8_MMA(1, 0, At, B0); PG8_MMA(1, 1, At, B1); PG8_BAR; PG8_SCHED;
            } else {
            PG8_LDB(B0, 0, 0); PG8_SCHED; PG8_LDA(At, 0, 0); PG8_STAGE(PG8_SA(1, 1), a1 + hstep, voffA);
            PG8_WAIT_L(8); PG8_BAR; PG8_WAIT_L(0); PG8_MMA(0, 0, At, B0); PG8_BAR; PG8_SCHED;
            PG8_LDB(B1, 0, 1); PG8_STAGE(PG8_SB(0, 0), b2, voffB);
            PG8_BAR; PG8_WAIT_L(0); PG8_MMA(0, 1, At, B1); PG8_BAR;
            PG8_LDA(At, 0, 1); PG8_STAGE(PG8_SA(0, 0), a2, voffA);
            PG8_BAR; PG8_WAIT_L(0); PG8_MMA(1, 0, At, B0); PG8_BAR; PG8_SCHED;
            PG8_STAGE(PG8_SB(0, 1), b2 + hstep, voffB);
            PG8_WAIT_V(6); PG8_BAR; PG8_MMA(1, 1, At, B1); PG8_BAR;
            PG8_LDB(B0, 1, 0); PG8_SCHED; PG8_LDA(At, 1, 0); PG8_STAGE(PG8_SA(0, 1), a2 + hstep, voffA);
            PG8_WAIT_L(8); PG8_BAR; PG8_WAIT_L(0); PG8_MMA(0, 0, At, B0); PG8_BAR; PG8_SCHED;
            PG8_LDB(B1, 1, 1); PG8_STAGE(PG8_SB(1, 0), b3, voffB);
            PG8_BAR; PG8_WAIT_L(0); PG8_MMA(0, 1, At, B1); PG8_BAR;
            PG8_LDA(At, 1, 1); PG8_STAGE(PG8_SA(1, 0), a3, voffA);
            PG8_BAR; PG8_WAIT_L(0); PG8_MMA(1, 0, At, B0); PG8_BAR; PG8_SCHED;
            PG8_STAGE(PG8_SB(1, 1), b3 + hstep, voffB);
            PG8_WAIT_V(6); PG8_BAR; PG8_MMA(1, 1, At, B1); PG8_BAR;
            }
        }
        if constexpr (ALIGN_EPI) { if (wr == 0) PG8_BAR; }
        if constexpr (!Epi::AFTER_DRAIN) { E(acc, cur, wr, wc, fr, fq); S.done(cur); }
        if (!has_next) break;
#pragma unroll
        for (int a = 0; a < 2; ++a)
#pragma unroll
            for (int b = 0; b < 2; ++b)
#pragma unroll
                for (int m = 0; m < 4; ++m)
#pragma unroll
                    for (int n = 0; n < 2; ++n) acc[a][b][m][n] = (f32x4){0.f, 0.f, 0.f, 0.f};
        cur = nxt; cA = nA; cB = nB; ++ui;
        if constexpr (ALIGN_EPI) { if (wr == 1) PG8_BAR; }
    }
    PG8_WAIT_V(0);
    if constexpr (!ALIGN_EPI) { if (wr == 0) PG8_BAR; }
    PG8_BAR;
    if constexpr (Epi::AFTER_DRAIN) { E.fused(acc, cur, wr, wc, fr, fq, lds, wid, lane); S.done(cur); }
#undef PG8_SA
#undef PG8_SB
#undef PG8_STAGE
#undef PG8_LDA
#undef PG8_LDB
#undef PG8_MMA
#undef PG8_WAIT_V
#undef PG8_WAIT_L
#undef PG8_BAR
#undef PG8_SCHED
}
}

DEV float rstd_of(const float* ssq, int row) { return rsqrtf(((const GAS float*)ssq)[row] * (1.f / 4096.f) + EPS); }

struct EpiIn {
    static constexpr bool PERM = true, AFTER_DRAIN = false;
    bf16 *LG, *LX, *HU, *Q, *Kr, *V, *Gs; const float* ssq; const float* rot;
    DEV void operator()(const f32x4 (&acc)[2][2][4][2], const pg8::Unit& u, int wr, int wc, int fr, int fq) const {
        const int row0 = u.pm * 256 + wr * 64 + fr, cc0 = wc * 32 + 8 * fq, pn = u.pn;
        if (pn >= 20 && pn < 28) {
            const bool isk = pn >= 24; const int P = pn - (isk ? 24 : 20); bf16* dst = isk ? Kr : Q; const float sc = isk ? 0.08838834764831845f : 1.f;
            const int hh = wc >> 1, jj0 = 32 * (wc & 1) + 8 * fq, ocol = (2 * P + hh) * 128 + jj0;
#pragma unroll
            for (int ai = 0; ai < 2; ++ai)
#pragma unroll
                for (int m = 0; m < 4; ++m) {
                    const int row = row0 + ai * 128 + m * 16; const float rs = rstd_of(ssq, row) * sc;
                    const GAS f32x4* rp = (const GAS f32x4*)(rot + ((size_t)row * 64 + jj0) * 2);
                    const f32x4 t0 = rp[0], t1 = rp[1], t2 = rp[2], t3 = rp[3];
                    const f32x4 a0 = acc[ai][0][m][0] * rs, a1 = acc[ai][0][m][1] * rs, b0 = acc[ai][1][m][0] * rs, b1 = acc[ai][1][m][1] * rs;
                    v4u o1, o2;
                    o1.x = pk2(a0[0] * t0[0] - b0[0] * t0[1], a0[1] * t0[2] - b0[1] * t0[3]); o2.x = pk2(a0[0] * t0[1] + b0[0] * t0[0], a0[1] * t0[3] + b0[1] * t0[2]);
                    o1.y = pk2(a0[2] * t1[0] - b0[2] * t1[1], a0[3] * t1[2] - b0[3] * t1[3]); o2.y = pk2(a0[2] * t1[1] + b0[2] * t1[0], a0[3] * t1[3] + b0[3] * t1[2]);
                    o1.z = pk2(a1[0] * t2[0] - b1[0] * t2[1], a1[1] * t2[2] - b1[1] * t2[3]); o2.z = pk2(a1[0] * t2[1] + b1[0] * t2[0], a1[1] * t2[3] + b1[1] * t2[2]);
                    o1.w = pk2(a1[2] * t3[0] - b1[2] * t3[1], a1[3] * t3[2] - b1[3] * t3[3]); o2.w = pk2(a1[2] * t3[1] + b1[2] * t3[0], a1[3] * t3[3] + b1[3] * t3[2]);
                    bf16* rowp = dst + (size_t)row * 1024 + ocol;
                    *(GAS v4u*)rowp = o1; *(GAS v4u*)(rowp + 64) = o2;
                }
        } else {
            bf16* dst; int ldc, colt, act = 0;
            if (pn < 4) { dst = LG; ldc = 1024; colt = pn * 256; act = 1; }
            else if (pn < 8) { dst = LX; ldc = 1024; colt = (pn - 4) * 256; }
            else if (pn < 20) { dst = HU; ldc = 3072; colt = (pn - 8) * 256; }
            else if (pn < 36) { dst = V; ldc = 2048; colt = (pn - 28) * 256; }
            else { dst = Gs; ldc = 2048; colt = (pn - 36) * 256; act = 2; }
#pragma unroll
            for (int ai = 0; ai < 2; ++ai)
#pragma unroll
                for (int m = 0; m < 4; ++m) {
                    const int row = row0 + ai * 128 + m * 16; const float rs = rstd_of(ssq, row);
                    bf16* rowp = dst + (size_t)row * ldc + colt + cc0;
#pragma unroll
                    for (int bj = 0; bj < 2; ++bj) {
                        f32x4 v0 = acc[ai][bj][m][0] * rs, v1 = acc[ai][bj][m][1] * rs;
                        if (act == 1) {
#pragma unroll
                            for (int e = 0; e < 4; ++e) { v0[e] = gelu_tanh_(v0[e]); v1[e] = gelu_tanh_(v1[e]); }
                        } else if (act == 2) {
#pragma unroll
                            for (int e = 0; e < 4; ++e) { v0[e] = siluf_(v0[e]); v1[e] = siluf_(v1[e]); }
                        }
                        v4u w; w.x = pk2(v0[0], v0[1]); w.y = pk2(v0[2], v0[3]); w.z = pk2(v1[0], v1[1]); w.w = pk2(v1[2], v1[3]);
                        *(GAS v4u*)(rowp + bj * 128) = w;
                    }
                }
        }
    }
};
struct EpiRes {
    static constexpr bool PERM = false, AFTER_DRAIN = false;
    const float* resid; float* out; bf16* xb; float* ssq;
    DEV void operator()(const f32x4 (&acc)[2][2][4][2], const pg8::Unit& u, int wr, int wc, int fr, int fq) const {
        const int row0 = u.pm * 256 + wr * 64 + fr, col0 = u.pn * 256 + wc * 32 + 4 * fq;
#pragma unroll
        for (int ai = 0; ai < 2; ++ai)
#pragma unroll
            for (int m = 0; m < 4; ++m) {
                const int row = row0 + ai * 128 + m * 16; const size_t off = (size_t)row * 4096 + col0; float ss = 0.f;
#pragma unroll
                for (int bj = 0; bj < 2; ++bj)
#pragma unroll
                    for (int n = 0; n < 2; ++n) {
                        const f32x4 bs = *(const GAS f32x4*)(resid + off + bj * 128 + n * 16); const f32x4 o = bs + acc[ai][bj][m][n];
                        *(GAS f32x4*)(out + off + bj * 128 + n * 16) = o; ss += (o[0] * o[0] + o[1] * o[1]) + (o[2] * o[2] + o[3] * o[3]);
                        v2u w; w.x = pk2(o[0], o[1]); w.y = pk2(o[2], o[3]); *(GAS v2u*)(xb + off + bj * 128 + n * 16) = w;
                    }
                ss += __shfl_xor(ss, 16); ss += __shfl_xor(ss, 32);
                if (fq == 0) __hip_atomic_fetch_add((GAS float*)ssq + row, ss, __ATOMIC_RELAXED, __HIP_MEMORY_SCOPE_AGENT);
                asm volatile("" ::: "memory");
            }
    }
};
struct EpiGU {
    static constexpr bool PERM = true, AFTER_DRAIN = false;
    bf16* U; const float* ssq;
    DEV void operator()(const f32x4 (&acc)[2][2][4][2], const pg8::Unit& u, int wr, int wc, int fr, int fq) const {
        const int row0 = u.pm * 256 + wr * 64 + fr, col = u.pn * 128 + wc * 32 + 8 * fq;
#pragma unroll
        for (int ai = 0; ai < 2; ++ai)
#pragma unroll
            for (int m = 0; m < 4; ++m) {
                const int row = row0 + ai * 128 + m * 16; const float rs = rstd_of(ssq, row);
                const f32x4 g0 = acc[ai][0][m][0] * rs, g1 = acc[ai][0][m][1] * rs, u0 = acc[ai][1][m][0] * rs, u1 = acc[ai][1][m][1] * rs;
                v4u w; w.x = pk2(siluf_(g0[0]) * u0[0], siluf_(g0[1]) * u0[1]); w.y = pk2(siluf_(g0[2]) * u0[2], siluf_(g0[3]) * u0[3]);
                w.z = pk2(siluf_(g1[0]) * u1[0], siluf_(g1[1]) * u1[1]); w.w = pk2(siluf_(g1[2]) * u1[2], siluf_(g1[3]) * u1[3]);
                *(GAS v4u*)(U + (size_t)row * DFF + col) = w;
            }
    }
};
#define XB_TMO      128
#define XB_XCNT(j)  (256  + 64 * (j))
#define XB_XSUB(j)  (1280 + 64 * (j))
#define XB_XGEN(j)  (2304 + 64 * (j))
#define XB_TOP      3328
#define XB_TOPGEN   3392
#define XCD_BAR_WORDS 3456
#define XB_SPIN_CAP (1u << 18)
__device__ __forceinline__ unsigned xb_ld(unsigned* p)              { return __hip_atomic_load(p, __ATOMIC_RELAXED, __HIP_MEMORY_SCOPE_AGENT); }
__device__ __forceinline__ unsigned xb_add(unsigned* p, unsigned v) { return __hip_atomic_fetch_add(p, v, __ATOMIC_RELAXED, __HIP_MEMORY_SCOPE_AGENT); }
__device__ __forceinline__ unsigned xb_xcc_id() { return (unsigned)__builtin_amdgcn_s_getreg((3 << 11) | 20) & 0xFu; }
#define XB_SPIN(cond, bar) do { unsigned _sp = 0; while (cond) { __builtin_amdgcn_s_sleep(1); \
    if ((++_sp & 255u) == 0u) { if (xb_ld(&(bar)[XB_TMO])) break; if (_sp > XB_SPIN_CAP) { atomicAdd(&(bar)[XB_TMO], 1u); break; } } } } while (0)

struct XcdBarrier {
    unsigned* bar; unsigned x;
    volatile LAS unsigned* st;
};

__device__ __forceinline__ XcdBarrier xcd_barrier_post(unsigned* bar, volatile LAS unsigned* st) {
    XcdBarrier b; b.bar = bar; b.x = xb_xcc_id(); b.st = st;
    if (threadIdx.x == 0) (void)xb_add(&bar[XB_XCNT(b.x)], 1u);
    return b;
}
__device__ __forceinline__ void xcd_barrier_complete(unsigned* bar, unsigned x, unsigned& nloc, unsigned& nx) {
    const unsigned G = gridDim.x * gridDim.y * gridDim.z;
    unsigned sum, cnt, mine, sp = 0u;
    for (;;) {
        sum = 0u; cnt = 0u; mine = 0u;
#pragma unroll
        for (unsigned j = 0; j < 16; ++j) { const unsigned c = xb_ld(&bar[XB_XCNT(j)]); sum += c; cnt += (c > 0u) ? 1u : 0u; mine = (j == x) ? c : mine; }
        if (sum == G) break;
        __builtin_amdgcn_s_sleep(1);
        if ((++sp & 255u) == 0u) { if (xb_ld(&bar[XB_TMO])) break; if (sp > XB_SPIN_CAP) { atomicAdd(&bar[XB_TMO], 1u); break; } }
    }
    nloc = mine > 0u ? mine : 1u; nx = cnt > 0u ? cnt : 1u;
}

__device__ __forceinline__ void xcd_barrier(const XcdBarrier& b) {
    asm volatile("s_waitcnt vmcnt(0)" ::: "memory");
    __syncthreads();
    if (threadIdx.x == 0) {
        unsigned* bar = b.bar;
        __builtin_amdgcn_s_waitcnt(0);
        unsigned nloc = b.st[0], nx = b.st[1];
        if (nloc == 0u) { xcd_barrier_complete(bar, b.x, nloc, nx); b.st[0] = nloc; b.st[1] = nx; }
        const unsigned old = xb_add(&bar[XB_XSUB(b.x)], 1u);
        const unsigned gen = old / nloc;
        if (old + 1u == (gen + 1u) * nloc) {
            __builtin_amdgcn_fence(__ATOMIC_RELEASE, "agent");
            asm volatile("s_waitcnt vmcnt(0)" ::: "memory");
            const unsigned og = xb_add(&bar[XB_TOP], 1u);
            const unsigned tg = og / nx;
            if (og + 1u == (tg + 1u) * nx) xb_add(&bar[XB_TOPGEN], 1u);
            else XB_SPIN(xb_ld(&bar[XB_TOPGEN]) == tg, bar);
            __builtin_amdgcn_fence(__ATOMIC_ACQUIRE, "agent");
            xb_add(&bar[XB_XGEN(b.x)], 1u);
            asm volatile("s_waitcnt vmcnt(0)" ::: "memory");
        } else {
            XB_SPIN(xb_ld(&bar[XB_XGEN(b.x)]) == gen, bar);
            __builtin_amdgcn_fence(__ATOMIC_ACQUIRE, "agent");
            asm volatile("s_waitcnt vmcnt(0)" ::: "memory");
        }
    }
    __syncthreads();
}

constexpr size_t MiB = 1u << 20;
constexpr size_t WS_CTL = 0, CTL_BYTES = 1 * MiB;
constexpr int CW_BAR = 4096;
constexpr size_t CTL_SSQ_OFF = 128 * 1024;
constexpr size_t WS_WIN = 1 * MiB;
constexpr size_t WS_WOUT = WS_WIN + 2 * 88 * MiB;
constexpr size_t WS_WGU = WS_WOUT + 2 * 32 * MiB;
constexpr size_t WS_WDN = WS_WGU + 2 * 172 * MiB;
constexpr size_t WS_XB = WS_WDN + 2 * 86 * MiB;
constexpr size_t WS_MIX = WS_XB + 128 * MiB;
constexpr size_t WS_PROJ = WS_MIX + 128 * MiB;
constexpr size_t WS_KV = WS_PROJ + 352 * MiB;
constexpr size_t WS_HYT = WS_KV + 128 * MiB;
constexpr size_t WS_HYO = WS_HYT + 96 * MiB;
constexpr size_t WS_GSCR = WS_HYO + 32 * MiB;
constexpr size_t WS_ROT = WS_GSCR + 96 * MiB;
constexpr size_t WS_HDN = WS_ROT + 8 * MiB;
constexpr size_t WS_LRUC = WS_HDN + 8 * MiB;
constexpr size_t WS_WGT = WS_LRUC + 3 * MiB;
constexpr size_t WS_END = WS_WGT + 2 * MiB;

constexpr int LDS_BYTES = 160 * 1024;
constexpr int MISC_OFF = LDS_BYTES - 256;
constexpr int NPH = 16;

#define LDS_WAIT() asm volatile("s_waitcnt lgkmcnt(0)" ::: "memory")
#define VM_WAIT() asm volatile("s_waitcnt vmcnt(0)" ::: "memory")

struct Args { const float* in[29]; float* out; unsigned char* ws; int ph_lo, ph_hi; };

struct Frame {
    LAS unsigned char* lds; int tid, lane, wave, vcu, G;
    const float* const* in;
    float* out; unsigned char* ws;
    DEV const float* I(int k) const { return (const float*)(const GAS float*)in[k]; }
    template <class T> DEV T* W(size_t off) const { return (T*)(GAS T*)(ws + off); }
    DEV float* O() const { return (float*)(GAS float*)out; }
};

DEV float wave_sum(float v) {
#pragma unroll
    for (int o = 1; o < 64; o <<= 1) v += __shfl_xor(v, o);
    return v;
}
DEV f32x2 cmul(f32x2 a, f32x2 b) { return (f32x2){a.x * b.x - a.y * b.y, a.x * b.y + a.y * b.x}; }
DEV bf16x8 lfrag(const LAS unsigned char* base, int row0, int s, int stride, int fr, int fq) { return *(const LAS bf16x8*)(base + (row0 + fr) * stride + s * 64 + fq * 16); }
DEV f32x4 mfma16(bf16x8 a, bf16x8 b, f32x4 c) { return __builtin_amdgcn_mfma_f32_16x16x32_bf16(a, b, c, 0, 0, 0); }
template <int E> DEV float bfe(const v4u& v) { const unsigned w = E < 2 ? v.x : E < 4 ? v.y : E < 6 ? v.z : v.w; return (E & 1) ? bfhi(w) : bflo(w); }

DEV int map_win(int n) {
    if (n < 5120 || n >= 7168) return n;
    const int base = n < 6144 ? 5120 : 6144, r = n - base, h = r >> 7, j = r & 127;
    return base + 256 * (h >> 1) + 128 * (j >> 6) + 64 * (h & 1) + (j & 63);
}
DEV void tr_item(const float* W, int K, int N, bf16* WT, LAS float* scr, int item, int lane, const float* gain, int mode) {
    const int nblk = N / 32, kb = item / nblk, nb = item - kb * nblk, k0 = 64 * kb, n0 = 32 * nb;
#pragma unroll 8
    for (int i = 0; i < 32; ++i) { const int kk = 2 * i + (lane >> 5); float v = W[(size_t)(k0 + kk) * N + n0 + (lane & 31)]; if (gain) v *= gain[k0 + kk]; scr[kk * 33 + (lane & 31)] = v; }
    LDS_WAIT();
    const int c = lane & 7;
#pragma unroll
    for (int j = 0; j < 4; ++j) { const int n = (lane >> 3) + 8 * j; const LAS float* s = scr + (8 * c) * 33 + n;
        int nd = n0 + n; if (mode == 1) nd = map_win(nd); else if (mode == 2) nd = 256 * (nd >> 7) + (nd & 127); else if (mode == 3) nd = 256 * (nd >> 7) + 128 + (nd & 127);
        v4u o; o.x = pk2(s[0 * 33], s[1 * 33]); o.y = pk2(s[2 * 33], s[3 * 33]); o.z = pk2(s[4 * 33], s[5 * 33]); o.w = pk2(s[6 * 33], s[7 * 33]);
        *(v4u*)(WT + (size_t)nd * K + k0 + 8 * c) = o; }
    LDS_WAIT();
}
DEV void p0_prologue(const Frame& F) {
    LAS float* scr = (LAS float*)(F.lds + F.wave * 16384);
    const int gw = F.vcu * 8 + F.wave, NGW = F.G * 8, lane = F.lane;
    constexpr int I_IN = 64 * 352, I_OUT = 64 * 128, I_G = 64 * 344, I_DN = 172 * 128, I_L = I_IN + I_OUT + 2 * I_G + I_DN;
    for (int it = gw; it < 2 * I_L; it += NGW) {
        const int l = it >= I_L ? 1 : 0; int r = it - l * I_L;
        if (r < I_IN) { tr_item(F.I(2) + (size_t)l * D * NIN, D, NIN, F.W<bf16>(WS_WIN + (size_t)l * 88 * MiB), scr, r, lane, F.I(1) + l * D, 1); continue; } r -= I_IN;
        if (r < I_OUT) { tr_item(F.I(23) + (size_t)l * D * D, D, D, F.W<bf16>(WS_WOUT + (size_t)l * 32 * MiB), scr, r, lane, nullptr, 0); continue; } r -= I_OUT;
        if (r < I_G) { tr_item(F.I(25) + (size_t)l * D * DFF, D, DFF, F.W<bf16>(WS_WGU + (size_t)l * 172 * MiB), scr, r, lane, F.I(24) + l * D, 2); continue; } r -= I_G;
        if (r < I_G) { tr_item(F.I(26) + (size_t)l * D * DFF, D, DFF, F.W<bf16>(WS_WGU + (size_t)l * 172 * MiB), scr, r, lane, F.I(24) + l * D, 3); continue; } r -= I_G;
        tr_item(F.I(27) + (size_t)l * DFF * D, DFF, D, F.W<bf16>(WS_WDN + (size_t)l * 86 * MiB), scr, r, lane, nullptr, 0);
    }
    { const float* x = F.I(0); bf16* xb = F.W<bf16>(WS_XB); float* ssq = F.W<float>(CTL_SSQ_OFF);
      for (int m = gw; m < M; m += NGW) { const f32x4* xr = (const f32x4*)(x + (size_t)m * D) + lane; v2u* o = (v2u*)(xb + (size_t)m * D) + lane; float s = 0.f;
#pragma unroll
          for (int j = 0; j < 16; ++j) { const f32x4 v = xr[64 * j]; s += (v[0] * v[0] + v[1] * v[1]) + (v[2] * v[2] + v[3] * v[3]); v2u w; w.x = pk2(v[0], v[1]); w.y = pk2(v[2], v[3]); o[64 * j] = w; }
          s = wave_sum(s); if (lane == 0) ssq[m] = s; } }
    { float* rot = F.W<float>(WS_ROT);
      for (int idx = gw * 64 + lane; idx < M * 64; idx += NGW * 64) { const int pos = idx >> 6, j = idx & 63;
          const double inv = exp(-(double)j * (9.210340371976184 / 64.0)); double xx = (double)pos * inv * 0.3183098861837907; xx -= 2.0 * floor(xx * 0.5); const float xf = (float)xx;
          rot[2 * idx] = cospif(xf); rot[2 * idx + 1] = sinpif(xf); } }
    { float* hdn = F.W<float>(WS_HDN);
      for (int it = gw; it < 2 * M; it += NGW) { const int l = it >> 14, t = it & (M - 1);
          float feat = (float)t * (1.0f / 16383.0f);
          if (lane >= 1 && lane < 33) { const int b = (lane - 1) & 15; const double fb = 1e-4 + (double)b * ((15.0 - 1e-4) / 15.0); double xx = 2.0 * fb * (double)t * (1.0 / 16384.0); xx -= 2.0 * floor(xx * 0.5);
              const float xf = (float)xx; feat = lane <= 16 ? cospif(xf) : -sinpif(xf); }
          const float* w1 = F.I(13) + l * 33 * 64; const float* w2 = F.I(15) + l * 64 * 64; const float fq_ = F.I(18)[l * 64 + lane];
          float h1 = F.I(14)[l * 64 + lane];
#pragma unroll
          for (int i = 0; i < 33; ++i) h1 += __shfl(feat, i) * w1[i * 64 + lane];
          h1 = __sinf(fq_ * h1);
          float h2 = F.I(16)[l * 64 + lane];
#pragma unroll
          for (int i = 0; i < 64; ++i) h2 += __shfl(h1, i) * w2[i * 64 + lane];
          hdn[(size_t)it * 64 + lane] = __sinf(fq_ * h2); } }
    { bf16* wgt = F.W<bf16>(WS_WGT);
      for (int idx = gw * 64 + lane; idx < 2 * 2 * 2 * 8 * 16384; idx += NGW * 64) { const int i = idx & 127, j = (idx >> 7) & 127, h = (idx >> 14) & 7, g = (idx >> 17) & 1, ld = idx >> 18;
          const float* src = g ? F.I(7) : F.I(5); wgt[idx] = f2bf(src[((size_t)(ld * 8 + h) * 128 + i) * 128 + j]); } }
}

DEV void hyt_unit(const Frame& F, int l, int unit) {
    int tid = F.tid; asm volatile("" : "+v"(tid)); const int tb = unit / 24, cb = unit - tb * 24, t0 = tb * 128, c0 = cb * 128;
    LAS float* S = (LAS float*)F.lds;
    const bf16* HU = F.W<bf16>(WS_PROJ + 64 * MiB);
    for (int task = tid; task < 130 * 16; task += 512) { const int r = task >> 4, ch = task & 15, t = t0 - 1 + r; v4u v = (v4u){0u, 0u, 0u, 0u};
        if (t >= 0 && t < M) v = *(const v4u*)(HU + (size_t)t * 3072 + c0 + ch * 8);
        LAS float* d = S + r * 129 + ch * 8; d[0] = bflo(v.x); d[1] = bfhi(v.x); d[2] = bflo(v.y); d[3] = bfhi(v.y); d[4] = bflo(v.z); d[5] = bfhi(v.z); d[6] = bflo(v.w); d[7] = bfhi(v.w); }
    __syncthreads();
    { const int cc = tid & 127, tq = tid >> 7, c = c0 + cc; const float* cw = F.I(11) + l * 3 * 3072; const float w0 = cw[c], w1 = cw[3072 + c], w2 = cw[2 * 3072 + c], b = F.I(12)[l * 3072 + c];
      bf16* dst = F.W<bf16>(WS_HYT) + (size_t)c * M + t0 + tq * 32;
#pragma unroll
      for (int k = 0; k < 4; ++k) { float y[8];
#pragma unroll
          for (int e = 0; e < 8; ++e) { const int t = tq * 32 + k * 8 + e; y[e] = b + w0 * S[t * 129 + cc] + w1 * S[(t + 1) * 129 + cc] + w2 * S[(t + 2) * 129 + cc]; }
          v4u o; o.x = pk2(y[0], y[1]); o.y = pk2(y[2], y[3]); o.z = pk2(y[4], y[5]); o.w = pk2(y[6], y[7]); *(v4u*)(dst + k * 8) = o; } }
    __syncthreads();
}
DEV void hyf_item(const Frame& F, int l, int item) {
    int lane = F.lane; asm volatile("" : "+v"(lane)); const int cg = item >> 5, tr = item & 31, fr = lane & 15, fq = lane >> 4;
    const float* w3 = F.I(17) + (size_t)l * 64 * 4096; const float* hdn = F.W<float>(WS_HDN) + (size_t)l * M * 64; bf16* filt = F.W<bf16>(WS_XB);
    float bv[4][16]; float rate[4];
#pragma unroll
    for (int ct = 0; ct < 4; ++ct) { const int col = 64 * cg + 16 * ct + fr; rate[ct] = -fabsf(F.I(19)[l * 4096 + col]) * (1.0f / 16383.0f);
#pragma unroll
        for (int s = 0; s < 16; ++s) bv[ct][s] = w3[(size_t)(16 * fq + s) * 4096 + col]; }
    for (int tt = 0; tt < 32; ++tt) { const int tb = tr * 512 + tt * 16; const f32x4* ap = (const f32x4*)(hdn + (size_t)(tb + fr) * 64 + 16 * fq);
        const f32x4 a0 = ap[0], a1 = ap[1], a2 = ap[2], a3 = ap[3]; float av[16];
#pragma unroll
        for (int e = 0; e < 4; ++e) { av[e] = a0[e]; av[4 + e] = a1[e]; av[8 + e] = a2[e]; av[12 + e] = a3[e]; }
#pragma unroll
        for (int ct = 0; ct < 4; ++ct) { f32x4 acc = (f32x4){0.f, 0.f, 0.f, 0.f};
#pragma unroll
            for (int s = 0; s < 16; ++s) acc = __builtin_amdgcn_mfma_f32_16x16x4f32(av[s], bv[ct][s], acc, 0, 0, 0);
            const int t = tb + 4 * fq; float y[4];
#pragma unroll
            for (int e = 0; e < 4; ++e) y[e] = acc[e] * __expf((float)(t + e) * rate[ct]);
            v2u o; o.x = pk2(y[0], y[1]); o.y = pk2(y[2], y[3]); *(v2u*)(filt + (size_t)(64 * cg + 16 * ct + fr) * M + t) = o; } }
}
template <bool PHASE_C> DEV void lru_unit(const Frame& F, int l, int n, int h) {
    int tid = F.tid; asm volatile("" : "+v"(tid)); const int t0 = n * 128, lane = tid & 63, w = F.wave, fr = lane & 15, fq = lane >> 4;
    LAS unsigned char* RAW = F.lds; LAS unsigned char* XCF = F.lds + 33792; LAS unsigned char* XCB = F.lds + 33792 + 67584;
    const bf16* LX = F.W<bf16>(WS_PROJ + 32 * MiB);
    for (int task = tid; task < 131 * 16; task += 512) { const int r = task >> 4, ch = task & 15, t = t0 - 2 + r; v4u v = (v4u){0u, 0u, 0u, 0u};
        if (t >= 0 && t < M) v = *(const v4u*)(LX + (size_t)t * 1024 + h * 128 + ch * 8);
        *(LAS v4u*)(RAW + r * 256 + ch * 16) = v; }
    __syncthreads();
    { const float* cw = F.I(3) + l * 4 * 1024; const float* cb = F.I(4) + l * 1024;
      for (int task = tid; task < 128 * 32; task += 512) { const int t = task >> 5, c4 = task & 31, c = h * 128 + c4 * 4; f32x4 a = *(const f32x4*)(cb + c);
#pragma unroll
          for (int j = 0; j < 4; ++j) { const f32x4 wj = *(const f32x4*)(cw + j * 1024 + c); const v2u rv = *(const LAS v2u*)(RAW + (t + j) * 256 + c4 * 8);
              a[0] += wj[0] * bflo(rv.x); a[1] += wj[1] * bfhi(rv.x); a[2] += wj[2] * bflo(rv.y); a[3] += wj[3] * bfhi(rv.y); }
          *(LAS f32x4*)(XCF + t * 528 + c4 * 16) = a; v2u pb; pb.x = pk2(a[0], a[1]); pb.y = pk2(a[2], a[3]); *(LAS v2u*)(XCB + t * 272 + c4 * 8) = pb; } }
    __syncthreads();
    const int cw16 = 16 * w + fr, cg = h * 128 + cw16;
    float* AP = F.W<float>(WS_LRUC); float* BE = AP + 2 * 128 * 1024; const float* CIN = AP + 4 * 128 * 1024;
    float hs[8][4];
#pragma unroll
    for (int d = 0; d < 2; ++d) {
        const bf16* wg = F.W<bf16>(WS_WGT) + ((((size_t)(l * 2 + d) * 2) * 8 + h) * 128 + cw16) * 128;
        bf16x8 br_[4], bi_[4];
#pragma unroll
        for (int s = 0; s < 4; ++s) { br_[s] = *(const bf16x8*)(wg + 32 * s + 8 * fq); bi_[s] = *(const bf16x8*)(wg + (size_t)8 * 128 * 128 + 32 * s + 8 * fq); }
        const int pidx = (l * 2 + d) * 1024 + cg;
        const float brv = F.I(6)[pidx], biv = F.I(8)[pidx], sp = log1pf(__expf(-F.I(9)[pidx]));
        float hin = PHASE_C ? CIN[(d * 128 + n) * 1024 + cg] : 0.f, CA = 1.f, CB = 0.f;
#pragma unroll
        for (int mm = 0; mm < 8; ++mm) { const int m = d == 0 ? mm : 7 - mm;
            f32x4 pr = (f32x4){0.f, 0.f, 0.f, 0.f}, pi = (f32x4){0.f, 0.f, 0.f, 0.f};
#pragma unroll
            for (int s = 0; s < 4; ++s) { const bf16x8 a = lfrag(XCB, 16 * m, s, 272, fr, fq); pr = mfma16(a, br_[s], pr); pi = mfma16(a, bi_[s], pi); }
#pragma unroll
            for (int e = 0; e < 4; ++e) { const int tk = 16 * m + 4 * fq + e; const float xc = *(const LAS float*)(XCF + tk * 528 + cw16 * 4);
                const float r = sigmoidf_(pr[e] + brv), ig = sigmoidf_(pi[e] + biv), la = -8.f * r * sp;
                pr[e] = __expf(la); pi[e] = sqrtf(-expm1f(2.f * la)) * ig * xc; }
            float A = 1.f, B = 0.f;
#pragma unroll
            for (int rr = 0; rr < 4; ++rr) { const int e = d == 0 ? rr : 3 - rr; B = pr[e] * B + pi[e]; A = A * pr[e]; }
            float EA, EB, TA, TB;
            if (d == 0) { float A1 = __shfl_up(A, 16), B1 = __shfl_up(B, 16); if (fq >= 1) { B = A * B1 + B; A = A1 * A; }
                A1 = __shfl_up(A, 32); B1 = __shfl_up(B, 32); if (fq >= 2) { B = A * B1 + B; A = A1 * A; }
                EA = __shfl_up(A, 16); EB = __shfl_up(B, 16); if (fq == 0) { EA = 1.f; EB = 0.f; }
                TA = __shfl(A, fr + 48); TB = __shfl(B, fr + 48); }
            else { float A1 = __shfl_down(A, 16), B1 = __shfl_down(B, 16); if (fq <= 2) { B = A * B1 + B; A = A1 * A; }
                A1 = __shfl_down(A, 32); B1 = __shfl_down(B, 32); if (fq <= 1) { B = A * B1 + B; A = A1 * A; }
                EA = __shfl_down(A, 16); EB = __shfl_down(B, 16); if (fq == 3) { EA = 1.f; EB = 0.f; }
                TA = __shfl(A, fr); TB = __shfl(B, fr); }
            if (PHASE_C) { float hc = EA * hin + EB;
#pragma unroll
                for (int rr = 0; rr < 4; ++rr) { const int e = d == 0 ? rr : 3 - rr; hc = pr[e] * hc + pi[e]; if (d == 0) hs[m][e] = hc; else hs[m][e] += hc; } }
            hin = TA * hin + TB; CB = TA * CB + TB; CA = CA * TA;
            __builtin_amdgcn_sched_barrier(0); }
        if (!PHASE_C && fq == 0) { AP[(d * 128 + n) * 1024 + cg] = CA; BE[(d * 128 + n) * 1024 + cg] = CB; }
    }
    if (PHASE_C) {
        const bf16* LG = F.W<bf16>(WS_PROJ); bf16* MIX = F.W<bf16>(WS_MIX);
        __syncthreads();
#pragma unroll
        for (int m = 0; m < 8; ++m)
#pragma unroll
            for (int e = 0; e < 4; ++e) *(LAS float*)(XCF + (16 * m + 4 * fq + e) * 528 + cw16 * 4) = hs[m][e];
        __syncthreads();
        const float* gn = F.I(10) + l * 1024 + h * 128;
        for (int task = tid; task < 2048; task += 512) { const int t = task >> 4, ch = task & 15;
            const f32x4 h0 = *(const LAS f32x4*)(XCF + t * 528 + ch * 32), h1 = *(const LAS f32x4*)(XCF + t * 528 + ch * 32 + 16);
            const v4u lg = *(const v4u*)(LG + (size_t)(t0 + t) * 1024 + h * 128 + ch * 8);
            float y[8]; y[0] = bflo(lg.x) * h0[0]; y[1] = bfhi(lg.x) * h0[1]; y[2] = bflo(lg.y) * h0[2]; y[3] = bfhi(lg.y) * h0[3];
            y[4] = bflo(lg.z) * h1[0]; y[5] = bfhi(lg.z) * h1[1]; y[6] = bflo(lg.w) * h1[2]; y[7] = bfhi(lg.w) * h1[3];
            float ss = 0.f;
#pragma unroll
            for (int e = 0; e < 8; ++e) ss += y[e] * y[e];
            ss += __shfl_xor(ss, 1); ss += __shfl_xor(ss, 2); ss += __shfl_xor(ss, 4); ss += __shfl_xor(ss, 8);
            const float rinv = rsqrtf(ss * (1.f / 128.f) + EPS); const f32x4 g0 = *(const f32x4*)(gn + ch * 8), g1 = *(const f32x4*)(gn + ch * 8 + 4);
            v4u o; o.x = pk2(y[0] * rinv * g0[0], y[1] * rinv * g0[1]); o.y = pk2(y[2] * rinv * g0[2], y[3] * rinv * g0[3]);
            o.z = pk2(y[4] * rinv * g1[0], y[5] * rinv * g1[1]); o.w = pk2(y[6] * rinv * g1[2], y[7] * rinv * g1[3]);
            *(v4u*)(MIX + (size_t)(t0 + t) * 4096 + h * 128 + ch * 8) = o; }
    }
    __syncthreads();
}
DEV void reta_unit(const Frame& F, int n, int h) {
    int tid = F.tid; asm volatile("" : "+v"(tid)); const int t0 = n * 128, lane = tid & 63, w = F.wave, fr = lane & 15, fq = lane >> 4;
    LAS unsigned char* KTF = F.lds; LAS unsigned char* KTB = F.lds + 34816; LAS unsigned char* VT = F.lds + 69632;
    const bf16* Kr = F.W<bf16>(WS_PROJ + 192 * MiB); const bf16* V = F.W<bf16>(WS_PROJ + 224 * MiB); bf16* KV = F.W<bf16>(WS_KV);
    const float l2g = log2f(1.f - exp2f(-5.f - (float)h));
    for (int task = tid; task < 1024; task += 512) { const int p = task & 63, ch = task >> 6, c0 = 2 * p;
        const v4u r0 = *(const v4u*)(Kr + (size_t)(t0 + c0) * 1024 + h * 128 + ch * 8), r1 = *(const v4u*)(Kr + (size_t)(t0 + c0 + 1) * 1024 + h * 128 + ch * 8);
        const float ff0 = exp2f((float)(127 - c0) * l2g), ff1 = exp2f((float)(126 - c0) * l2g), fb0 = exp2f((float)c0 * l2g), fb1 = exp2f((float)(c0 + 1) * l2g);
#define KT_ST(E) { const float k0 = bfe<E>(r0), k1 = bfe<E>(r1); *(LAS unsigned*)(KTF + (ch * 8 + E) * 272 + c0 * 2) = pk2(k0 * ff0, k1 * ff1); *(LAS unsigned*)(KTB + (ch * 8 + E) * 272 + c0 * 2) = pk2(k0 * fb0, k1 * fb1); }
        KT_ST(0) KT_ST(1) KT_ST(2) KT_ST(3) KT_ST(4) KT_ST(5) KT_ST(6) KT_ST(7)
#undef KT_ST
    }
    for (int task = tid; task < 2048; task += 512) { const int p = task & 63, ch = task >> 6, c0 = 2 * p;
        const v4u r0 = *(const v4u*)(V + (size_t)(t0 + c0) * 2048 + h * 256 + ch * 8), r1 = *(const v4u*)(V + (size_t)(t0 + c0 + 1) * 2048 + h * 256 + ch * 8);
#define VT_ST(E) { *(LAS unsigned*)(VT + (ch * 8 + E) * 272 + c0 * 2) = pk2(bfe<E>(r0), bfe<E>(r1)); }
        VT_ST(0) VT_ST(1) VT_ST(2) VT_ST(3) VT_ST(4) VT_ST(5) VT_ST(6) VT_ST(7)
#undef VT_ST
    }
    __syncthreads();
    f32x4 acc[2][8][2];
#pragma unroll
    for (int a = 0; a < 2; ++a)
#pragma unroll
        for (int b = 0; b < 8; ++b)
#pragma unroll
            for (int c = 0; c < 2; ++c) acc[a][b][c] = (f32x4){0.f, 0.f, 0.f, 0.f};
#pragma unroll
    for (int s = 0; s < 4; ++s) { const bf16x8 bv0 = lfrag(VT, 32 * w, s, 272, fr, fq), bv1 = lfrag(VT, 32 * w + 16, s, 272, fr, fq);
#pragma unroll
        for (int dt = 0; dt < 8; ++dt) { const bf16x8 af = lfrag(KTF, 16 * dt, s, 272, fr, fq), ab = lfrag(KTB, 16 * dt, s, 272, fr, fq);
            acc[0][dt][0] = mfma16(af, bv0, acc[0][dt][0]); acc[0][dt][1] = mfma16(af, bv1, acc[0][dt][1]);
            acc[1][dt][0] = mfma16(ab, bv0, acc[1][dt][0]); acc[1][dt][1] = mfma16(ab, bv1, acc[1][dt][1]); } }
#pragma unroll
    for (int dir = 0; dir < 2; ++dir)
#pragma unroll
        for (int dt = 0; dt < 8; ++dt)
#pragma unroll
            for (int et = 0; et < 2; ++et) { const f32x4 a = acc[dir][dt][et]; v2u o; o.x = pk2(a[0], a[1]); o.y = pk2(a[2], a[3]);
                *(v2u*)(KV + ((size_t)(dir * 128 + n) * 8 + h) * 32768 + (32 * w + 16 * et + fr) * 128 + 16 * dt + 4 * fq) = o; }
    __syncthreads();
}

DEV void lrub_all(const Frame& F) {
    const float* AP = F.W<float>(WS_LRUC); const float* BE = AP + 2 * 128 * 1024; float* CIN = F.W<float>(WS_LRUC) + 4 * 128 * 1024;
    for (int idx = F.vcu * 512 + F.tid; idx < 2048; idx += F.G * 512) { const int d = idx >> 10, c = idx & 1023; float s = 0.f;
        for (int it = 0; it < 128; ++it) { const int n = d ? 127 - it : it, o = (d * 128 + n) * 1024 + c; CIN[o] = s; s = AP[o] * s + BE[o]; } }
}
DEV void retb_all(const Frame& F) {
    bf16* KV = F.W<bf16>(WS_KV);
    for (int idx = F.vcu * 512 + F.tid; idx < 131072; idx += F.G * 512) { const int dir = idx >> 16, h = (idx >> 13) & 7, off = (idx & 8191) * 4;
        const float dec = exp2f(128.f * log2f(1.f - exp2f(-5.f - (float)h))); float s0 = 0.f, s1 = 0.f, s2 = 0.f, s3 = 0.f;
#pragma unroll 4
        for (int it = 0; it < 128; ++it) { const int n = dir ? 127 - it : it; v2u* p = (v2u*)(KV + ((size_t)(dir * 128 + n) * 8 + h) * 32768 + off); const v2u v = *p;
            v2u o; o.x = pk2(s0, s1); o.y = pk2(s2, s3); *p = o;
            s0 = dec * s0 + bflo(v.x); s1 = dec * s1 + bfhi(v.x); s2 = dec * s2 + bflo(v.y); s3 = dec * s3 + bfhi(v.y); } }
}
DEV int rev14(int p) { const unsigned r = __builtin_bitreverse32((unsigned)p) >> 18; return (int)(((r & 0x1555u) << 1) | ((r >> 1) & 0x1555u)); }
DEV f32x2 twid(const LAS f32x2* TH, const LAS f32x2* TL, int e) { return cmul(TH[e >> 7], TL[e & 127]); }
DEV void fft_dif(LAS f32x2* FB, const LAS f32x2* TH, const LAS f32x2* TL, int tid) {
    for (int s = 0; s < 7; ++s) { const int lq = 12 - 2 * s, q = 1 << lq;
        for (int j = tid; j < 4096; j += 512) { const int i = j & (q - 1), base = ((j >> lq) << (lq + 2)) + i;
            const f32x2 a0 = FB[base], a1 = FB[base + q], a2 = FB[base + 2 * q], a3 = FB[base + 3 * q];
            const f32x2 b0 = a0 + a2, b1 = a0 - a2, b2 = a1 + a3, t = a1 - a3, b3 = (f32x2){t.y, -t.x};
            const f32x2 w1 = twid(TH, TL, i << (2 * s)), w2 = cmul(w1, w1), w3 = cmul(w2, w1);
            FB[base] = b0 + b2; FB[base + q] = cmul(b1 + b3, w1); FB[base + 2 * q] = cmul(b0 - b2, w2); FB[base + 3 * q] = cmul(b1 - b3, w3); }
        __syncthreads(); }
}
DEV void fft_dit(LAS f32x2* FB, const LAS f32x2* TH, const LAS f32x2* TL, int tid) {
    for (int s = 6; s >= 0; --s) { const int lq = 12 - 2 * s, q = 1 << lq;
        for (int j = tid; j < 4096; j += 512) { const int i = j & (q - 1), base = ((j >> lq) << (lq + 2)) + i;
            const f32x2 w1 = twid(TH, TL, i << (2 * s)), w2 = cmul(w1, w1), w3 = cmul(w2, w1);
            const f32x2 c0 = FB[base], c1 = cmul(FB[base + q], w1), c2 = cmul(FB[base + 2 * q], w2), c3 = cmul(FB[base + 3 * q], w3);
            const f32x2 b0 = c0 + c2, b1 = c0 - c2, b2 = c1 + c3, t = c1 - c3, b3 = (f32x2){t.y, -t.x};
            FB[base] = b0 + b2; FB[base + q] = b1 + b3; FB[base + 2 * q] = b0 - b2; FB[base + 3 * q] = b1 - b3; }
        __syncthreads(); }
}
DEV void hy_pointwise(LAS f32x2* FB, const f32x2* GS, const LAS f32x2* T2H, const LAS f32x2* T2L, int tid) {
    const float invN = 1.0f / 16384.0f;
    for (int p = tid; p < 16384; p += 512) { const int k = rev14(p); if (k > 8192) continue;
        const int pp = rev14((16384 - k) & 16383);
        const f32x2 Z = FB[p], Zp = FB[pp], G = GS[p], Gp = GS[pp], w = cmul(T2H[k >> 7], T2L[k & 127]);
        const f32x2 Ze = (f32x2){0.5f * (Z.x + Zp.x), 0.5f * (Z.y - Zp.y)}, Zo = (f32x2){0.5f * (Z.y + Zp.y), -0.5f * (Z.x - Zp.x)};
        const f32x2 Ge = (f32x2){0.5f * (G.x + Gp.x), 0.5f * (G.y - Gp.y)}, Go = (f32x2){0.5f * (G.y + Gp.y), -0.5f * (G.x - Gp.x)};
        const f32x2 wZo = cmul(w, Zo), wGo = cmul(w, Go), U = cmul(Ze + wZo, Ge + wGo), V = cmul(Ze - wZo, Ge - wGo);
        const f32x2 Ye = 0.5f * (U + V), Yo = 0.5f * cmul(U - V, (f32x2){w.x, -w.y});
        FB[p] = (f32x2){(Ye.x - Yo.y) * invN, -(Ye.y + Yo.x) * invN}; FB[pp] = (f32x2){(Ye.x + Yo.y) * invN, (Ye.y - Yo.x) * invN}; }
    __syncthreads();
}
DEV void hyena_unit(const Frame& F, int l, int c) {
    int tid = F.tid; asm volatile("" : "+v"(tid));
    LAS f32x2* FB = (LAS f32x2*)F.lds; LAS f32x2* TH = (LAS f32x2*)(F.lds + 131072); LAS f32x2* TL = TH + 128; LAS f32x2* T2H = TL + 128; LAS f32x2* T2L = T2H + 128;
    const bf16* FILT = F.W<bf16>(WS_XB); const bf16* HYT = F.W<bf16>(WS_HYT); bf16* HYO = F.W<bf16>(WS_HYO);
    f32x2* GS0 = F.W<f32x2>(WS_GSCR + (size_t)blockIdx.x * 384 * 1024); f32x2* GS1 = GS0 + 16384; f32x2* Z1 = GS1 + 16384;
    for (int o = 0; o < 2; ++o) {
        const bf16* hf = FILT + (size_t)((2 * o) * 1024 + c) * M; const bf16* hb = FILT + (size_t)((2 * o + 1) * 1024 + c) * M;
        for (int m = tid; m < 16384; m += 512) { f32x2 v;
            if (m < 8192) { const unsigned w = *(const unsigned*)(hf + 2 * m); v = (f32x2){bflo(w), bfhi(w)}; if (m == 0) v.x += bf2f(hb[0]); }
            else { const int mp = m - 8192; v.x = mp == 0 ? 0.f : bf2f(hb[16384 - 2 * mp]); v.y = bf2f(hb[16383 - 2 * mp]); }
            FB[m] = v; }
        __syncthreads();
        fft_dif(FB, TH, TL, tid);
        f32x2* gs = o ? GS1 : GS0;
        for (int m = tid; m < 16384; m += 512) gs[m] = FB[m];
        __syncthreads();
    }
    const bf16* zv = HYT + (size_t)c * M; const bf16* g0 = HYT + (size_t)(1024 + c) * M; const bf16* g1 = HYT + (size_t)(2048 + c) * M;
    const float sk0 = F.I(20)[l * 2048 + c], sk1 = F.I(20)[l * 2048 + 1024 + c];
    for (int m = tid; m < 16384; m += 512) { f32x2 v = (f32x2){0.f, 0.f}; if (m < 8192) { const unsigned w = *(const unsigned*)(zv + 2 * m); v = (f32x2){bflo(w), bfhi(w)}; } FB[m] = v; }
    VM_WAIT();
    __syncthreads();
    fft_dif(FB, TH, TL, tid); hy_pointwise(FB, GS0, T2H, T2L, tid); fft_dit(FB, TH, TL, tid);
    for (int m = tid; m < 16384; m += 512) { f32x2 v = (f32x2){0.f, 0.f};
        if (m < 8192) { const f32x2 y = FB[m]; const unsigned wz = *(const unsigned*)(zv + 2 * m), wg = *(const unsigned*)(g0 + 2 * m);
            v = (f32x2){bflo(wg) * (y.x + sk0 * bflo(wz)), bfhi(wg) * (-y.y + sk0 * bfhi(wz))}; Z1[m] = v; }
        FB[m] = v; }
    __syncthreads();
    fft_dif(FB, TH, TL, tid); hy_pointwise(FB, GS1, T2H, T2L, tid); fft_dit(FB, TH, TL, tid);
    VM_WAIT();
    for (int m = tid; m < 8192; m += 512) { const f32x2 y = FB[m], z1 = Z1[m]; const unsigned wg = *(const unsigned*)(g1 + 2 * m);
        *(unsigned*)(HYO + (size_t)c * M + 2 * m) = pk2(bflo(wg) * (y.x + sk1 * z1.x), bfhi(wg) * (-y.y + sk1 * z1.y)); }
    __syncthreads();
}
DEV void retc_unit(const Frame& F, int l, int n, int h) {
    int tid = F.tid; asm volatile("" : "+v"(tid)); const int t0 = n * 128, lane = tid & 63, w = F.wave, fr = lane & 15, fq = lane >> 4;
    LAS unsigned char* QS = F.lds; LAS unsigned char* KS = F.lds + 34816; LAS unsigned char* BIG = F.lds + 69632;
    const bf16* Qr = F.W<bf16>(WS_PROJ + 160 * MiB); const bf16* Kr = F.W<bf16>(WS_PROJ + 192 * MiB); const bf16* V = F.W<bf16>(WS_PROJ + 224 * MiB);
    const bf16* Gs = F.W<bf16>(WS_PROJ + 288 * MiB); const bf16* KV = F.W<bf16>(WS_KV); bf16* MIX = F.W<bf16>(WS_MIX);
    const float l2g = log2f(1.f - exp2f(-5.f - (float)h));
    for (int task = tid; task < 2048; task += 512) { const int r = task >> 4, ch = task & 15;
        *(LAS v4u*)(QS + r * 272 + ch * 16) = *(const v4u*)(Qr + (size_t)(t0 + r) * 1024 + h * 128 + ch * 8);
        *(LAS v4u*)(KS + r * 272 + ch * 16) = *(const v4u*)(Kr + (size_t)(t0 + r) * 1024 + h * 128 + ch * 8); }
    for (int task = tid; task < 2048; task += 512) { const int p = task & 63, ch = task >> 6, c0 = 2 * p;
        const v4u r0 = *(const v4u*)(V + (size_t)(t0 + c0) * 2048 + h * 256 + ch * 8), r1 = *(const v4u*)(V + (size_t)(t0 + c0 + 1) * 2048 + h * 256 + ch * 8);
#define VT_ST(E) { *(LAS unsigned*)(BIG + (ch * 8 + E) * 272 + c0 * 2) = pk2(bfe<E>(r0), bfe<E>(r1)); }
        VT_ST(0) VT_ST(1) VT_ST(2) VT_ST(3) VT_ST(4) VT_ST(5) VT_ST(6) VT_ST(7)
#undef VT_ST
    }
    __syncthreads();
    bf16x8 aq[4];
#pragma unroll
    for (int s = 0; s < 4; ++s) aq[s] = lfrag(QS, 16 * w, s, 272, fr, fq);
    f32x4 S[8];
#pragma unroll
    for (int jt = 0; jt < 8; ++jt) { S[jt] = (f32x4){0.f, 0.f, 0.f, 0.f};
#pragma unroll
        for (int s = 0; s < 4; ++s) S[jt] = mfma16(aq[s], lfrag(KS, 16 * jt, s, 272, fr, fq), S[jt]);
#pragma unroll
        for (int e = 0; e < 4; ++e) { const int i = 16 * w + 4 * fq + e, j = 16 * jt + fr; S[jt][e] *= exp2f(l2g * fabsf((float)(i - j))); } }
    __syncthreads();
#pragma unroll
    for (int jt = 0; jt < 8; ++jt)
#pragma unroll
        for (int e = 0; e < 4; ++e) *(LAS bf16*)(KS + (16 * w + 4 * fq + e) * 272 + (16 * jt + fr) * 2) = f2bf(S[jt][e]);
    LDS_WAIT();
    __syncthreads();
    f32x4 y[16];
    { bf16x8 ap[4];
#pragma unroll
      for (int s = 0; s < 4; ++s) ap[s] = lfrag(KS, 16 * w, s, 272, fr, fq);
#pragma unroll
      for (int et = 0; et < 16; ++et) { y[et] = (f32x4){0.f, 0.f, 0.f, 0.f};
#pragma unroll
          for (int s = 0; s < 4; ++s) y[et] = mfma16(ap[s], lfrag(BIG, 16 * et, s, 272, fr, fq), y[et]);
          __builtin_amdgcn_sched_barrier(0); } }
    __syncthreads();
#pragma unroll
    for (int dir = 0; dir < 2; ++dir) {
        const bf16* st = KV + ((size_t)(dir * 128 + n) * 8 + h) * 32768;
        for (int task = tid; task < 4096; task += 512) { const int r = task >> 4, ch = task & 15; *(LAS v4u*)(BIG + r * 272 + ch * 16) = *(const v4u*)(st + r * 128 + ch * 8); }
        __syncthreads();
        float fac[4];
#pragma unroll
        for (int e = 0; e < 4; ++e) { const int i = 16 * w + 4 * fq + e; fac[e] = exp2f(l2g * (dir == 0 ? (float)(i + 1) : (float)(128 - i))); }
#pragma unroll
        for (int et = 0; et < 16; ++et) { f32x4 t = (f32x4){0.f, 0.f, 0.f, 0.f};
#pragma unroll
            for (int s = 0; s < 4; ++s) t = mfma16(aq[s], lfrag(BIG, 16 * et, s, 272, fr, fq), t);
#pragma unroll
            for (int e = 0; e < 4; ++e) y[et][e] += fac[e] * t[e];
            __builtin_amdgcn_sched_barrier(0); }
        __syncthreads();
    }
    float rinv[4];
#pragma unroll
    for (int e = 0; e < 4; ++e) { float ss = 0.f;
#pragma unroll
        for (int et = 0; et < 16; ++et) ss += y[et][e] * y[et][e];
        ss += __shfl_xor(ss, 1); ss += __shfl_xor(ss, 2); ss += __shfl_xor(ss, 4); ss += __shfl_xor(ss, 8); rinv[e] = rsqrtf(ss * (1.f / 256.f) + EPS); }
#pragma unroll
    for (int et = 0; et < 16; ++et)
#pragma unroll
        for (int e = 0; e < 4; ++e) *(LAS bf16*)(BIG + (16 * w + 4 * fq + e) * 528 + (16 * et + fr) * 2) = f2bf(y[et][e] * rinv[e]);
    __syncthreads();
    const float* gn = F.I(22) + l * 2048 + h * 256;
    for (int task = tid; task < 4096; task += 512) { const int t = task >> 5, ch = task & 31;
        const v4u yv = *(const LAS v4u*)(BIG + t * 528 + ch * 16); const v4u gv = *(const v4u*)(Gs + (size_t)(t0 + t) * 2048 + h * 256 + ch * 8);
        const f32x4 g0 = *(const f32x4*)(gn + ch * 8), g1 = *(const f32x4*)(gn + ch * 8 + 4);
        v4u o; o.x = pk2(bflo(yv.x) * g0[0] * bflo(gv.x), bfhi(yv.x) * g0[1] * bfhi(gv.x)); o.y = pk2(bflo(yv.y) * g0[2] * bflo(gv.y), bfhi(yv.y) * g0[3] * bfhi(gv.y));
        o.z = pk2(bflo(yv.z) * g1[0] * bflo(gv.z), bfhi(yv.z) * g1[1] * bfhi(gv.z)); o.w = pk2(bflo(yv.w) * g1[2] * bflo(gv.w), bfhi(yv.w) * g1[3] * bfhi(gv.w));
        *(v4u*)(MIX + (size_t)(t0 + t) * 4096 + 2048 + h * 256 + ch * 8) = o; }
}
DEV void hyn_unit(const Frame& F, int l, int unit) {
    int tid = F.tid; asm volatile("" : "+v"(tid)); const int g = unit >> 7, t0 = (unit & 127) * 128;
    LAS float* S = (LAS float*)F.lds; LAS float* RED = S + 128 * 129;
    const bf16* HYO = F.W<bf16>(WS_HYO); bf16* MIX = F.W<bf16>(WS_MIX);
    for (int task = tid; task < 2048; task += 512) { const int cc = task >> 4, ch = task & 15; const v4u v = *(const v4u*)(HYO + (size_t)(128 * g + cc) * M + t0 + ch * 8);
        LAS float* d = S + cc * 129 + ch * 8; d[0] = bflo(v.x); d[1] = bfhi(v.x); d[2] = bflo(v.y); d[3] = bfhi(v.y); d[4] = bflo(v.z); d[5] = bfhi(v.z); d[6] = bflo(v.w); d[7] = bfhi(v.w); }
    __syncthreads();
    { const int t = tid & 127, part = tid >> 7; float ss = 0.f;
#pragma unroll 8
      for (int cc = 0; cc < 32; ++cc) { const float v = S[(32 * part + cc) * 129 + t]; ss += v * v; }
      RED[part * 128 + t] = ss; }
    __syncthreads();
    const float* gn = F.I(21) + l * 1024 + 128 * g;
    for (int task = tid; task < 2048; task += 512) { const int t = task >> 4, ch = task & 15;
        const float rinv = rsqrtf((RED[t] + RED[128 + t] + RED[256 + t] + RED[384 + t]) * (1.f / 128.f) + EPS); float y[8];
#pragma unroll
        for (int e = 0; e < 8; ++e) y[e] = S[(8 * ch + e) * 129 + t] * rinv * gn[8 * ch + e];
        v4u o; o.x = pk2(y[0], y[1]); o.y = pk2(y[2], y[3]); o.z = pk2(y[4], y[5]); o.w = pk2(y[6], y[7]);
        *(v4u*)(MIX + (size_t)(t0 + t) * 4096 + 1024 + 128 * g + 8 * ch) = o; }
    __syncthreads();
}
DEV void final_norm(const Frame& F) {
    const float* ssq = F.W<float>(CTL_SSQ_OFF) + 4 * M; const float* gn = F.I(28); const int gw = F.vcu * 8 + F.wave, NGW = F.G * 8, lane = F.lane;
    for (int m = gw; m < M; m += NGW) { const float rs = rstd_of(ssq, m); f32x4* xr = (f32x4*)(F.O() + (size_t)m * D) + lane; const f32x4* gr = (const f32x4*)gn + lane;
#pragma unroll
        for (int j = 0; j < 16; ++j) xr[64 * j] = xr[64 * j] * rs * gr[64 * j]; }
}

__global__ void __launch_bounds__(512, 2) fwd_kernel(Args args) {
    extern __shared__ __attribute__((aligned(16))) unsigned char lds_raw[];
    Frame F; F.lds = (LAS unsigned char*)lds_raw; F.tid = threadIdx.x; F.lane = F.tid & 63; F.wave = __builtin_amdgcn_readfirstlane(F.tid >> 6);
    F.G = gridDim.x; { const int bx = blockIdx.x; F.vcu = (F.G % 8 == 0) ? (bx % 8) * (F.G / 8) + bx / 8 : bx; }
    F.in = args.in; F.out = args.out; F.ws = args.ws;
    volatile LAS unsigned* MISC = (volatile LAS unsigned*)(F.lds + MISC_OFF);
    if (F.tid < 64) MISC[F.tid] = 0u;
    __syncthreads();
    const int lo = args.ph_lo, hi = args.ph_hi;
    unsigned* barw = F.W<unsigned>(WS_CTL) + CW_BAR;
    XcdBarrier bar; bar.bar = barw; bar.x = 0; bar.st = nullptr;
    if (hi - lo > 1) bar = xcd_barrier_post(barw, MISC + 8);
#ifndef PHASE_EN
#define PHASE_EN 0xffffffffu
#endif
#define EN(b) ((PHASE_EN >> (b)) & 1u)
#define IN(k) (lo <= (k) && (k) < hi)
#define SEAM(k) do { if (IN(k) && IN((k) + 1)) xcd_barrier(bar); FENCE(); } while (0)
#define FENCE() do { asm volatile("" : "+s"(F.ws), "+s"(F.out), "+v"(F.tid)); F.lane = F.tid & 63; } while (0)
    FENCE();
    if (EN(0) && IN(0)) { p0_prologue(F); }
    SEAM(0);
    for (int l = 0; l < NLAYER; ++l) {
        const int pb = 1 + 7 * l;
        if (EN(1) && IN(pb + 0)) {
            bf16* XB = F.W<bf16>(WS_XB); bf16* PR = F.W<bf16>(WS_PROJ);
            pg8::Gemm g{XB, F.W<bf16>(WS_WIN + (size_t)l * 88 * MiB), M, NIN, D}; pg8::StaticOrder S; S.init(M, NIN, F.G, (int)blockIdx.x);
            EpiIn E{PR, F.W<bf16>(WS_PROJ + 32 * MiB), F.W<bf16>(WS_PROJ + 64 * MiB), F.W<bf16>(WS_PROJ + 160 * MiB), F.W<bf16>(WS_PROJ + 192 * MiB), F.W<bf16>(WS_PROJ + 224 * MiB), F.W<bf16>(WS_PROJ + 288 * MiB),
                    F.W<float>(CTL_SSQ_OFF) + (2 * l) * M, F.W<float>(WS_ROT)};
            pg8::gemm_phase<EpiIn, pg8::StaticOrder, true, true>(F.lds, g, S, E);
        }
        SEAM(pb + 0);
        if (IN(pb + 1)) {
            if (EN(2)) for (int u = F.vcu; u < 3072; u += F.G) hyt_unit(F, l, u);
            if (EN(3)) for (int it = F.vcu * 8 + F.wave; it < 2048; it += F.G * 8) hyf_item(F, l, it);
            __syncthreads();
            if (EN(4)) for (int u = F.vcu; u < 1024; u += F.G) lru_unit<false>(F, l, u >> 3, u & 7);
            if (EN(5)) for (int u = F.vcu; u < 1024; u += F.G) reta_unit(F, u >> 3, u & 7);
        }
        SEAM(pb + 1);
        if (IN(pb + 2)) {
            if (EN(6)) { lrub_all(F); retb_all(F); }
            FENCE();
            { LAS f32x2* TH = (LAS f32x2*)(F.lds + 131072);
              if (F.tid < 128) { const float j = (float)F.tid; TH[F.tid] = (f32x2){cospif(j * (1.f / 64.f)), -sinpif(j * (1.f / 64.f))}; TH[128 + F.tid] = (f32x2){cospif(j * (1.f / 8192.f)), -sinpif(j * (1.f / 8192.f))};
                  TH[256 + F.tid] = (f32x2){cospif(j * (1.f / 128.f)), -sinpif(j * (1.f / 128.f))}; TH[384 + F.tid] = (f32x2){cospif(j * (1.f / 16384.f)), -sinpif(j * (1.f / 16384.f))}; }
              __syncthreads(); }
            if (EN(7)) for (int u = F.vcu; u < 1024; u += F.G) hyena_unit(F, l, u);
        }
        SEAM(pb + 2);
        if (IN(pb + 3)) {
            if (EN(8)) for (int u = F.vcu; u < 1024; u += F.G) lru_unit<true>(F, l, u >> 3, u & 7);
            if (EN(9)) for (int u = F.vcu; u < 1024; u += F.G) { retc_unit(F, l, u >> 3, u & 7); __syncthreads(); }
            if (EN(10)) for (int u = F.vcu; u < 1024; u += F.G) hyn_unit(F, l, u);
        }
        SEAM(pb + 3);
        if (EN(11) && IN(pb + 4)) {
            bf16* XB = F.W<bf16>(WS_XB); bf16* MIX = F.W<bf16>(WS_MIX);
            pg8::Gemm g{MIX, F.W<bf16>(WS_WOUT + (size_t)l * 32 * MiB), M, D, D}; pg8::StaticOrder S; S.init(M, D, F.G, (int)blockIdx.x);
            EpiRes E{l == 0 ? F.I(0) : F.O(), F.O(), XB, F.W<float>(CTL_SSQ_OFF) + (2 * l + 1) * M};
            pg8::gemm_phase<EpiRes, pg8::StaticOrder, true, true>(F.lds, g, S, E);
        }
        SEAM(pb + 4);
        if (EN(12) && IN(pb + 5)) {
            bf16* XB = F.W<bf16>(WS_XB); bf16* PR = F.W<bf16>(WS_PROJ);
            pg8::Gemm g{XB, F.W<bf16>(WS_WGU + (size_t)l * 172 * MiB), M, NGU, D}; pg8::StaticOrder S; S.init(M, NGU, F.G, (int)blockIdx.x);
            EpiGU E{PR, F.W<float>(CTL_SSQ_OFF) + (2 * l + 1) * M};
            pg8::gemm_phase<EpiGU, pg8::StaticOrder, true, true>(F.lds, g, S, E);
        }
        SEAM(pb + 5);
        if (EN(13) && IN(pb + 6)) {
            bf16* XB = F.W<bf16>(WS_XB); bf16* PR = F.W<bf16>(WS_PROJ);
            pg8::Gemm g{PR, F.W<bf16>(WS_WDN + (size_t)l * 86 * MiB), M, D, DFF}; pg8::StaticOrder S; S.init(M, D, F.G, (int)blockIdx.x);
            EpiRes E{F.O(), F.O(), XB, F.W<float>(CTL_SSQ_OFF) + (2 * l + 2) * M};
            pg8::gemm_phase<EpiRes, pg8::StaticOrder, true, true>(F.lds, g, S, E);
        }
        SEAM(pb + 6);
    }
    if (EN(14) && IN(15)) final_norm(F);
#undef IN
#undef SEAM
}

#ifndef MK_PER_PHASE
#define MK_PER_PHASE 1
#endif
extern "C" void kernel_launch(void* const* d_in, const int* in_sizes, int n_in, void* d_out, int out_size, void* d_ws, size_t ws_size, hipStream_t stream) {
    static int grid = 0;
    if (grid == 0) {
        if (n_in != 29 || in_sizes[0] != M * D || out_size != M * D || ws_size < WS_END) { fprintf(stderr, "kernel_launch: unexpected shapes / workspace (n_in %d, ws %zu < %zu); nothing launched\n", n_in, ws_size, (size_t)WS_END); grid = -1; return; }
        int dev = 0, cus = 0, per_cu = 0;
        if (hipGetDevice(&dev) != hipSuccess || hipDeviceGetAttribute(&cus, hipDeviceAttributeMultiprocessorCount, dev) != hipSuccess) { grid = -1; return; }
        if (hipFuncSetAttribute((const void*)fwd_kernel, hipFuncAttributeMaxDynamicSharedMemorySize, LDS_BYTES) != hipSuccess) { fprintf(stderr, "kernel_launch: hipFuncSetAttribute failed\n"); grid = -1; return; }
        if (hipOccupancyMaxActiveBlocksPerMultiprocessor(&per_cu, (const void*)fwd_kernel, 512, LDS_BYTES) != hipSuccess || per_cu < 1) { fprintf(stderr, "kernel_launch: occupancy query says %d blocks per CU\n", per_cu); }
        (void)hipGetLastError();
        grid = cus;
    }
    if (grid < 0) return;
    if (hipMemsetAsync((char*)d_ws + WS_CTL, 0, CTL_BYTES, stream) != hipSuccess) return;
    Args a{};
    for (int i = 0; i < 29; ++i) a.in[i] = (const float*)d_in[i];
    a.out = (float*)d_out; a.ws = (unsigned char*)d_ws;
#if MK_PER_PHASE
    for (int p = 0; p < NPH; ++p) { a.ph_lo = p; a.ph_hi = p + 1; hipLaunchKernelGGL(fwd_kernel, dim3(grid), dim3(512), LDS_BYTES, stream, a); }
#else
    a.ph_lo = 0; a.ph_hi = NPH; hipLaunchKernelGGL(fwd_kernel, dim3(grid), dim3(512), LDS_BYTES, stream, a);
#endif
}
```

```cpp
#include <hip/hip_runtime.h>
#include <cstdio>
#include <cstdint>

#define DEV __device__ __forceinline__
#define GAS __attribute__((address_space(1)))
#define LAS __attribute__((address_space(3)))
typedef unsigned short bf16;
typedef unsigned v4u __attribute__((ext_vector_type(4)));
typedef unsigned v2u __attribute__((ext_vector_type(2)));
typedef float f32x4 __attribute__((ext_vector_type(4)));
typedef float f32x2 __attribute__((ext_vector_type(2)));
typedef short bf16x8 __attribute__((ext_vector_type(8)));
typedef int v8i __attribute__((ext_vector_type(8)));
typedef int v4i __attribute__((ext_vector_type(4)));

constexpr int M = 16384, D = 4096, DL = 1024, DH = 1024, DR = 2048, NIN = 11264, DFF = 11008, NGU = 22016, NLAYER = 2;
constexpr float EPS = 1e-6f;

DEV float bflo(unsigned w) { return __uint_as_float(w << 16); }
DEV float bfhi(unsigned w) { return __uint_as_float(w & 0xffff0000u); }
DEV float bf2f(bf16 v) { return __uint_as_float(((unsigned)v) << 16); }
DEV unsigned pk2(float lo, float hi) { unsigned r; asm volatile("v_cvt_pk_bf16_f32 %0, %1, %2" : "=v"(r) : "v"(lo), "v"(hi)); return r; }
DEV unsigned pk4_fp8(float a, float b, float c, float d) {
    a = __builtin_amdgcn_fmed3f(a, -448.f, 448.f); b = __builtin_amdgcn_fmed3f(b, -448.f, 448.f); c = __builtin_amdgcn_fmed3f(c, -448.f, 448.f); d = __builtin_amdgcn_fmed3f(d, -448.f, 448.f);
    int w = 0; w = __builtin_amdgcn_cvt_pk_fp8_f32(a, b, w, false); w = __builtin_amdgcn_cvt_pk_fp8_f32(c, d, w, true); return (unsigned)w; }
DEV unsigned pk4_i8(float a, float b, float c, float d) {
    const int ia = (int)__builtin_rintf(__builtin_amdgcn_fmed3f(a, -127.f, 127.f)), ib = (int)__builtin_rintf(__builtin_amdgcn_fmed3f(b, -127.f, 127.f)), ic = (int)__builtin_rintf(__builtin_amdgcn_fmed3f(c, -127.f, 127.f)), id = (int)__builtin_rintf(__builtin_amdgcn_fmed3f(d, -127.f, 127.f));
    return (unsigned)(ia & 255) | ((unsigned)(ib & 255) << 8) | ((unsigned)(ic & 255) << 16) | ((unsigned)id << 24); }
constexpr float XQ_CLIP = 5.f;
DEV bf16 f2bf(float f) { return (bf16)(pk2(f, 0.f) & 0xffffu); }
DEV float shx(float x, int mask, int lane) { return __builtin_bit_cast(float, __builtin_amdgcn_ds_bpermute((lane ^ mask) << 2, __builtin_bit_cast(int, x))); }
DEV float sigmoidf_(float x) { return __builtin_amdgcn_rcpf(1.f + __expf(-x)); }
DEV float siluf_(float x) { return x * __builtin_amdgcn_rcpf(1.f + __expf(-x)); }
DEV float gelu_tanh_(float x) { const float u = 0.7978845608028654f * (x + 0.044715f * x * x * x); return x - x * __builtin_amdgcn_rcpf(1.f + __expf(2.f * u)); }

#ifndef GEMM_WGM
#define GEMM_WGM 4
#endif
namespace pg8 {
#define PG8_LAS __attribute__((address_space(3)))
typedef unsigned short bf16_t;
typedef short bf16x8 __attribute__((ext_vector_type(8)));
typedef float f32x4 __attribute__((ext_vector_type(4)));
typedef unsigned u32x4 __attribute__((ext_vector_type(4)));
constexpr int BM = 256, BK = 64, HALF = 128, HTB = HALF * BK * 2  , STAGE_BYTES = 8 * HTB, NXCD = 8, WGM = GEMM_WGM;

__host__ __device__ __forceinline__ int lds_byte(int r, int c) { const int st = (r >> 4) * 2 + (c >> 5), rr = r & 15, cc = c & 31, ob = rr * 64 + cc * 2; return st * 1024 + (ob ^ (((ob >> 9) & 1) << 5)); }
__host__ __device__ __forceinline__ void stage_rc(int b, int& R, int& C) { const int st = b / 1024, sb = b % 1024, swz = sb ^ (((sb >> 9) & 1) << 5); R = (st >> 1) * 16 + swz / 64; C = (st & 1) * 32 + (swz % 64) / 2; }
__host__ __device__ __forceinline__ int perm32(int rho) { const int n = rho >> 4, i = rho & 15; return 8 * (i >> 2) + 4 * n + (i & 3); }

struct Unit { int pm, pn; };
struct Gemm { const bf16_t* A; const bf16_t* Bt; int M, N, K; int lda = 0, ldb = 0; };

struct StaticOrder {
    int nM, nN, nwg, G, c;
    __host__ __device__ void init(int M, int N, int G_, int c_) { nM = M / BM; nN = N / BM; nwg = nM * nN; G = G_; c = c_; }
    __host__ __device__ bool next(int i, Unit& u) const {
        const long L = (long)i * G + c; if (L >= nwg) return false;
        int wgid = (int)L; { const int q = nwg / NXCD, r = nwg % NXCD, xcd = wgid % NXCD, off = wgid / NXCD; wgid = (xcd < r ? xcd * (q + 1) : r * (q + 1) + (xcd - r) * q) + off; }
        const int nig = WGM * nN, gid = wgid / nig, fm = gid * WGM, gsz = (nM - fm) < WGM ? (nM - fm) : WGM;
        u.pm = fm + ((wgid % nig) % gsz); u.pn = (wgid % nig) / gsz; return true;
    }
    __device__ __forceinline__ void a_ready(const Unit&) const {}
    __device__ __forceinline__ void done(const Unit&) const {}
};
template <class Epi, class Sched, bool ALIGN_EPI = false, bool SP2 = false, int QT = 0>
__device__ __forceinline__ void gemm_phase(PG8_LAS unsigned char* lds, const Gemm g, const Sched& S, const Epi& E, int tid) {
    asm volatile("" : "+v"(tid));
    const int wid = __builtin_amdgcn_readfirstlane(tid >> 6), lane = tid & 63, wr = wid >> 2, wc = wid & 3, fr = lane & 15, fq = lane >> 4;
    constexpr bool FP8 = QT == 1, I8 = QT == 2;
    const int KA = g.lda ? g.lda : g.K, KB = g.ldb ? g.ldb : g.K, nt = g.K / BK;
    unsigned voffA[2], voffB[2];
#pragma unroll
    for (int i = 0; i < 2; ++i) { int R, C; stage_rc(tid * 16 + i * 8192, R, C); const int Rb = Epi::PERM ? ((R & ~31) + perm32(R & 31)) : R;
        voffA[i] = (unsigned)(R * KA + C) * 2u; voffB[i] = (unsigned)(Rb * KB + C) * 2u; }
    const size_t kstep = (size_t)(BK * 2);
    const size_t hstepA = (size_t)HALF * KA * 2, hstepB = (size_t)HALF * KB * 2;
    const size_t tstepA = 2 * hstepA, tstepB = 2 * hstepB;
    const unsigned ldsw = (unsigned)wid * 1024u;
    const int aoff = lds_byte(wr * 64 + fr, fq * 8), boff = lds_byte(wc * 32 + fr, fq * 8);
#define PG8_SA(b, h) (((b) * 2 + (h)) * HTB)
#define PG8_SB(b, h) ((4 + (b) * 2 + (h)) * HTB)
#define PG8_STAGE(bufoff, gbase, voff) do { _Pragma("unroll") for (int _i = 0; _i < 2; ++_i) \
        __builtin_amdgcn_global_load_lds((const unsigned*)((const char*)(gbase) + (voff)[_i]), (PG8_LAS unsigned*)(lds + (bufoff) + ldsw + _i * 8192), 16, 0, 0); } while (0)
#define PG8_LDA(dst, b, h) do { _Pragma("unroll") for (int m = 0; m < 4; ++m) _Pragma("unroll") for (int k = 0; k < 2; ++k) dst[m][k] = *(const PG8_LAS bf16x8*)(lds + PG8_SA(b, h) + aoff + m * 2048 + k * 1024); } while (0)
#define PG8_LDB(dst, b, h) do { _Pragma("unroll") for (int n = 0; n < 2; ++n) _Pragma("unroll") for (int k = 0; k < 2; ++k) dst[n][k] = *(const PG8_LAS bf16x8*)(lds + PG8_SB(b, h) + boff + n * 2048 + k * 1024); } while (0)
#define PG8_CAT(x, y) __builtin_bit_cast(v8i, __builtin_shufflevector(x, y, 0, 1, 2, 3, 4, 5, 6, 7, 8, 9, 10, 11, 12, 13, 14, 15))
#define PG8_MMA(ai, bj, At, Bt) do { __builtin_amdgcn_s_setprio(1); if constexpr (FP8) { _Pragma("unroll") for (int m = 0; m < 4; ++m) _Pragma("unroll") for (int n = 0; n < 2; ++n) \
        { const v8i b8_ = PG8_CAT(Bt[n][0], Bt[n][1]), a8_ = PG8_CAT(At[m][0], At[m][1]); asm volatile("v_mfma_scale_f32_16x16x128_f8f6f4 %0, %1, %2, %0, %3, %3 op_sel_hi:[0,0,0]" : "+v"(acc[ai][bj][m][n]) : "v"(b8_), "v"(a8_), "v"(one_scales)); } } else if constexpr (I8) { \
        _Pragma("unroll") for (int m = 0; m < 4; ++m) _Pragma("unroll") for (int n = 0; n < 2; ++n) _Pragma("unroll") for (int k = 0; k < 2; ++k) \
        acc[ai][bj][m][n] = __builtin_bit_cast(f32x4, __builtin_amdgcn_mfma_i32_16x16x64_i8(__builtin_bit_cast(v4i, Bt[n][k]), __builtin_bit_cast(v4i, At[m][k]), __builtin_bit_cast(v4i, acc[ai][bj][m][n]), 0, 0, 0)); } else { \
        _Pragma("unroll") for (int m = 0; m < 4; ++m) _Pragma("unroll") for (int n = 0; n < 2; ++n) _Pragma("unroll") for (int k = 0; k < 2; ++k) \
        acc[ai][bj][m][n] = __builtin_amdgcn_mfma_f32_16x16x32_bf16(Bt[n][k], At[m][k], acc[ai][bj][m][n], 0, 0, 0); } __builtin_amdgcn_s_setprio(0); } while (0)
#define PG8_WAIT_V(n) asm volatile("s_waitcnt vmcnt(" #n ")" ::: "memory")
#define PG8_WAIT_L(n) asm volatile("s_waitcnt lgkmcnt(" #n ")" ::: "memory")
#define PG8_BAR __builtin_amdgcn_s_barrier()
#define PG8_SCHED __builtin_amdgcn_sched_barrier(0)
    const int one_scales = 0x7f7f7f7f;
    Unit cur, nxt; int ui = 0;
    if (!S.next(0, cur)) return;
    f32x4 acc[2][2][4][2];
#pragma unroll
    for (int a = 0; a < 2; ++a)
#pragma unroll
        for (int b = 0; b < 2; ++b)
#pragma unroll
            for (int m = 0; m < 4; ++m)
#pragma unroll
                for (int n = 0; n < 2; ++n) acc[a][b][m][n] = (f32x4){0.f, 0.f, 0.f, 0.f};
    bf16x8 At[4][2], B0[2][2], B1[2][2];
    const char* cA = (const char*)g.A + (size_t)cur.pm * tstepA; const char* cB = (const char*)g.Bt + (size_t)cur.pn * tstepB;
    S.a_ready(cur);
    if constexpr (SP2) {
        PG8_STAGE(PG8_SB(0, 0), cB, voffB); PG8_STAGE(PG8_SB(0, 1), cB + hstepB, voffB); PG8_STAGE(PG8_SA(0, 0), cA, voffA); PG8_STAGE(PG8_SA(0, 1), cA + hstepA, voffA);
        if (wr == 1) PG8_BAR;
        PG8_WAIT_V(2); PG8_BAR;
        PG8_STAGE(PG8_SB(1, 0), cB + kstep, voffB); PG8_STAGE(PG8_SA(1, 0), cA + kstep, voffA); PG8_STAGE(PG8_SB(1, 1), cB + hstepB + kstep, voffB);
        PG8_WAIT_V(6); PG8_BAR;
    } else {
        PG8_STAGE(PG8_SB(0, 0), cB, voffB); PG8_STAGE(PG8_SA(0, 0), cA, voffA); PG8_STAGE(PG8_SB(0, 1), cB + hstepB, voffB); PG8_STAGE(PG8_SA(0, 1), cA + hstepA, voffA);
        if (wr == 1) PG8_BAR;
        PG8_WAIT_V(4); PG8_BAR;
        PG8_STAGE(PG8_SB(1, 0), cB + kstep, voffB); PG8_STAGE(PG8_SA(1, 0), cA + kstep, voffA); PG8_STAGE(PG8_SB(1, 1), cB + hstepB + kstep, voffB);
        PG8_WAIT_V(6); PG8_BAR;
    }
    for (;;) {
        const bool has_next = S.next(ui + 1, nxt);
        const char* nA = has_next ? (const char*)g.A + (size_t)nxt.pm * tstepA : cA; const char* nB = has_next ? (const char*)g.Bt + (size_t)nxt.pn * tstepB : cB;
        for (int t = 0; t < nt; t += 2) {
            const bool last = (t == nt - 2);
            const char* a1 = cA + (size_t)(t + 1) * kstep;
            const char* a2 = last ? nA : cA + (size_t)(t + 2) * kstep; const char* b2 = last ? nB : cB + (size_t)(t + 2) * kstep;
            const char* a3 = a2 + kstep; const char* b3 = b2 + kstep;
            if (last && has_next) S.a_ready(nxt);
            if constexpr (SP2) {
            PG8_LDB(B0, 0, 0); PG8_LDB(B1, 0, 1); PG8_SCHED; PG8_LDA(At, 0, 0); PG8_STAGE(PG8_SA(1, 1), a1 + hstepA, voffA);
            PG8_WAIT_V(8); PG8_WAIT_L(0); PG8_BAR; PG8_MMA(0, 0, At, B0); PG8_MMA(0, 1, At, B1); PG8_BAR; PG8_SCHED;
            PG8_LDA(At, 0, 1); PG8_STAGE(PG8_SB(0, 0), b2, voffB); PG8_STAGE(PG8_SB(0, 1), b2 + hstepB, voffB); PG8_STAGE(PG8_SA(0, 0), a2, voffA);
            PG8_WAIT_V(8); PG8_WAIT_L(0); PG8_BAR; PG8_MMA(1, 0, At, B0); PG8_MMA(1, 1, At, B1); PG8_BAR; PG8_SCHED;
            PG8_LDB(B0, 1, 0); PG8_LDB(B1, 1, 1); PG8_SCHED; PG8_LDA(At, 1, 0); PG8_STAGE(PG8_SA(0, 1), a2 + hstepA, voffA);
            PG8_WAIT_V(8); PG8_WAIT_L(0); PG8_BAR; PG8_MMA(0, 0, At, B0); PG8_MMA(0, 1, At, B1); PG8_BAR; PG8_SCHED;
            PG8_LDA(At, 1, 1); PG8_STAGE(PG8_SB(1, 0), b3, voffB); PG8_STAGE(PG8_SB(1, 1), b3 + hstepB, voffB); PG8_STAGE(PG8_SA(1, 0), a3, voffA);
            PG8_WAIT_V(8); PG8_WAIT_L(0); PG8_BAR; PG8_MMA(1, 0, At, B0); PG8_MMA(1, 1, At, B1); PG8_BAR; PG8_SCHED;
            } else {
            PG8_LDB(B0, 0, 0); PG8_SCHED; PG8_LDA(At, 0, 0); PG8_STAGE(PG8_SA(1, 1), a1 + hstepA, voffA);
            PG8_WAIT_L(8); PG8_BAR; PG8_WAIT_L(0); PG8_MMA(0, 0, At, B0); PG8_BAR; PG8_SCHED;
            PG8_LDB(B1, 0, 1); PG8_STAGE(PG8_SB(0, 0), b2, voffB);
            PG8_BAR; PG8_WAIT_L(0); PG8_MMA(0, 1, At, B1); PG8_BAR;
            PG8_LDA(At, 0, 1); PG8_STAGE(PG8_SA(0, 0), a2, voffA);
            PG8_BAR; PG8_WAIT_L(0); PG8_MMA(1, 0, At, B0); PG8_BAR; PG8_SCHED;
            PG8_STAGE(PG8_SB(0, 1), b2 + hstepB, voffB);
            PG8_WAIT_V(6); PG8_BAR; PG8_MMA(1, 1, At, B1); PG8_BAR;
            PG8_LDB(B0, 1, 0); PG8_SCHED; PG8_LDA(At, 1, 0); PG8_STAGE(PG8_SA(0, 1), a2 + hstepA, voffA);
            PG8_WAIT_L(8); PG8_BAR; PG8_WAIT_L(0); PG8_MMA(0, 0, At, B0); PG8_BAR; PG8_SCHED;
            PG8_LDB(B1, 1, 1); PG8_STAGE(PG8_SB(1, 0), b3, voffB);
            PG8_BAR; PG8_WAIT_L(0); PG8_MMA(0, 1, At, B1); PG8_BAR;
            PG8_LDA(At, 1, 1); PG8_STAGE(PG8_SA(1, 0), a3, voffA);
            PG8_BAR; PG8_WAIT_L(0); PG8_MMA(1, 0, At, B0); PG8_BAR; PG8_SCHED;
            PG8_STAGE(PG8_SB(1, 1), b3 + hstepB, voffB);
            PG8_WAIT_V(6); PG8_BAR; PG8_MMA(1, 1, At, B1); PG8_BAR;
            }
        }
        if constexpr (FP8) asm volatile("s_nop 15\n\ts_nop 15" ::: "memory");
        if constexpr (ALIGN_EPI) { if (wr == 0) PG8_BAR; }
        if constexpr (!Epi::AFTER_DRAIN) { E(acc, cur, wr, wc, fr, fq); S.done(cur); }
        if (!has_next) break;
#pragma unroll
        for (int a = 0; a < 2; ++a)
#pragma unroll
            for (int b = 0; b < 2; ++b)
#pragma unroll
                for (int m = 0; m < 4; ++m)
#pragma unroll
                    for (int n = 0; n < 2; ++n) acc[a][b][m][n] = (f32x4){0.f, 0.f, 0.f, 0.f};
        cur = nxt; cA = nA; cB = nB; ++ui;
        if constexpr (ALIGN_EPI) { if (wr == 1) PG8_BAR; }
    }
    PG8_WAIT_V(0);
    if constexpr (!ALIGN_EPI) { if (wr == 0) PG8_BAR; }
    PG8_BAR;
    if constexpr (Epi::AFTER_DRAIN) { E.fused(acc, cur, wr, wc, fr, fq, lds, wid, lane); S.done(cur); }
#undef PG8_SA
#undef PG8_SB
#undef PG8_STAGE
#undef PG8_LDA
#undef PG8_LDB
#undef PG8_MMA
#undef PG8_CAT
#undef PG8_WAIT_V
#undef PG8_WAIT_L
#undef PG8_BAR
#undef PG8_SCHED
}
}

typedef long long ssq_t;
DEV float rstd_of(const ssq_t* ssq, int row) { return __builtin_amdgcn_rsqf((float)((const GAS ssq_t*)ssq)[row] * (1.f / (4096.f * 16777216.f)) + EPS); }
DEV void ssq_add(ssq_t* ssq, int row, float ss) { __hip_atomic_fetch_add((GAS ssq_t*)ssq + row, (ssq_t)(ss * 16777216.f), __ATOMIC_RELAXED, __HIP_MEMORY_SCOPE_AGENT); }

struct EpiIn {
    static constexpr bool PERM = true, AFTER_DRAIN = false;
    bf16 *LG, *LX, *HU, *Q, *Kr, *V, *Gs; const ssq_t* ssq; const float* rot;
    DEV void operator()(const f32x4 (&acc)[2][2][4][2], const pg8::Unit& u, int wr, int wc, int fr, int fq) const {
        const int row0 = u.pm * 256 + wr * 64 + fr, cc0 = wc * 32 + 8 * fq, pn = u.pn;
        if (pn >= 20 && pn < 28) {
            const bool isk = pn >= 24; const int P = pn - (isk ? 24 : 20); bf16* dst = isk ? Kr : Q; const float sc = isk ? 0.08838834764831845f : 1.f;
            const int hh = wc >> 1, jj0 = 32 * (wc & 1) + 8 * fq, ocol = (2 * P + hh) * 128 + jj0;
#pragma unroll
            for (int ai = 0; ai < 2; ++ai)
#pragma unroll
                for (int m = 0; m < 4; ++m) {
                    const int row = row0 + ai * 128 + m * 16; const float rs = rstd_of(ssq, row) * sc;
                    const GAS f32x4* rp = (const GAS f32x4*)(rot + ((size_t)row * 64 + jj0) * 2);
                    const f32x4 t0 = rp[0], t1 = rp[1], t2 = rp[2], t3 = rp[3];
                    const f32x4 a0 = acc[ai][0][m][0] * rs, a1 = acc[ai][0][m][1] * rs, b0 = acc[ai][1][m][0] * rs, b1 = acc[ai][1][m][1] * rs;
                    v4u o1, o2;
                    o1.x = pk2(a0[0] * t0[0] - b0[0] * t0[1], a0[1] * t0[2] - b0[1] * t0[3]); o2.x = pk2(a0[0] * t0[1] + b0[0] * t0[0], a0[1] * t0[3] + b0[1] * t0[2]);
                    o1.y = pk2(a0[2] * t1[0] - b0[2] * t1[1], a0[3] * t1[2] - b0[3] * t1[3]); o2.y = pk2(a0[2] * t1[1] + b0[2] * t1[0], a0[3] * t1[3] + b0[3] * t1[2]);
                    o1.z = pk2(a1[0] * t2[0] - b1[0] * t2[1], a1[1] * t2[2] - b1[1] * t2[3]); o2.z = pk2(a1[0] * t2[1] + b1[0] * t2[0], a1[1] * t2[3] + b1[1] * t2[2]);
                    o1.w = pk2(a1[2] * t3[0] - b1[2] * t3[1], a1[3] * t3[2] - b1[3] * t3[3]); o2.w = pk2(a1[2] * t3[1] + b1[2] * t3[0], a1[3] * t3[3] + b1[3] * t3[2]);
                    bf16* rowp = dst + (size_t)row * 1024 + ocol;
                    *(GAS v4u*)rowp = o1; *(GAS v4u*)(rowp + 64) = o2;
                }
        } else {
            bf16* dst; int ldc, colt, act = 0;
            if (pn < 4) { dst = LG; ldc = 1024; colt = pn * 256; act = 1; }
            else if (pn < 8) { dst = LX; ldc = 1024; colt = (pn - 4) * 256; }
            else if (pn < 20) { dst = HU; ldc = 3072; colt = (pn - 8) * 256; }
            else if (pn < 36) { dst = V; ldc = 2048; colt = (pn - 28) * 256; }
            else { dst = Gs; ldc = 2048; colt = (pn - 36) * 256; act = 2; }
#pragma unroll
            for (int ai = 0; ai < 2; ++ai)
#pragma unroll
                for (int m = 0; m < 4; ++m) {
                    const int row = row0 + ai * 128 + m * 16; const float rs = rstd_of(ssq, row);
                    bf16* rowp = dst + (size_t)row * ldc + colt + cc0;
#pragma unroll
                    for (int bj = 0; bj < 2; ++bj) {
                        f32x4 v0 = acc[ai][bj][m][0] * rs, v1 = acc[ai][bj][m][1] * rs;
                        if (act == 1) {
#pragma unroll
                            for (int e = 0; e < 4; ++e) { v0[e] = gelu_tanh_(v0[e]); v1[e] = gelu_tanh_(v1[e]); }
                        } else if (act == 2) {
#pragma unroll
                            for (int e = 0; e < 4; ++e) { v0[e] = siluf_(v0[e]); v1[e] = siluf_(v1[e]); }
                        }
                        v4u w; w.x = pk2(v0[0], v0[1]); w.y = pk2(v0[2], v0[3]); w.z = pk2(v1[0], v1[1]); w.w = pk2(v1[2], v1[3]);
                        *(GAS v4u*)(rowp + bj * 128) = w;
                    }
                }
        }
    }
};
struct EpiRes {
    static constexpr bool PERM = true, AFTER_DRAIN = false;
    bf16* xb; ssq_t* ssq; float sc; unsigned char* xq; const ssq_t* ssq_old;
    DEV void operator()(const f32x4 (&acc)[2][2][4][2], const pg8::Unit& u, int wr, int wc, int fr, int fq) const {
        const int row0 = u.pm * 256 + wr * 64 + fr, col0 = u.pn * 256 + wc * 32 + 8 * fq;
#pragma unroll
        for (int ai = 0; ai < 2; ++ai)
#pragma unroll
            for (int m = 0; m < 4; ++m) {
                const int row = row0 + ai * 128 + m * 16; const size_t off = (size_t)row * 4096 + col0; float ss = 0.f;
                const float qs = xq ? (127.f / XQ_CLIP) * rstd_of(ssq_old, row) : 0.f;
                v4u rv[2];
#pragma unroll
                for (int bj = 0; bj < 2; ++bj) rv[bj] = *(const GAS v4u*)(xb + off + bj * 128);
#pragma unroll
                for (int bj = 0; bj < 2; ++bj) {
                    const f32x4 a0 = acc[ai][bj][m][0], a1 = acc[ai][bj][m][1];
                    const float o0 = fmaf(a0[0], sc, bflo(rv[bj].x)), o1 = fmaf(a0[1], sc, bfhi(rv[bj].x)), o2 = fmaf(a0[2], sc, bflo(rv[bj].y)), o3 = fmaf(a0[3], sc, bfhi(rv[bj].y));
                    const float o4 = fmaf(a1[0], sc, bflo(rv[bj].z)), o5 = fmaf(a1[1], sc, bfhi(rv[bj].z)), o6 = fmaf(a1[2], sc, bflo(rv[bj].w)), o7 = fmaf(a1[3], sc, bfhi(rv[bj].w));
                    ss += ((o0 * o0 + o1 * o1) + (o2 * o2 + o3 * o3)) + ((o4 * o4 + o5 * o5) + (o6 * o6 + o7 * o7));
                    v4u w; w.x = pk2(o0, o1); w.y = pk2(o2, o3); w.z = pk2(o4, o5); w.w = pk2(o6, o7); *(GAS v4u*)(xb + off + bj * 128) = w;
                    if (xq) { v2u q; q.x = pk4_i8(o0 * qs, o1 * qs, o2 * qs, o3 * qs); q.y = pk4_i8(o4 * qs, o5 * qs, o6 * qs, o7 * qs); *(GAS v2u*)(xq + off + bj * 128) = q; }
                }
                { const int ln = fq * 16 + fr; ss += shx(ss, 16, ln); ss += shx(ss, 32, ln); }
                if (fq == 0) ssq_add(ssq, row, ss);
                if (m & 1) asm volatile("" ::: "memory");
            }
    }
};
struct EpiHuT {
    static constexpr bool PERM = true, AFTER_DRAIN = false;
    bf16* HYT; const ssq_t* ssq;
    DEV void operator()(const f32x4 (&acc)[2][2][4][2], const pg8::Unit& u, int wr, int wc, int fr, int fq) const {
        const int row0 = u.pm * 256 + wr * 64 + fr, col0 = u.pn * 256 + wc * 32 + 8 * fq;
        float rs[2][8];
#pragma unroll
        for (int bj = 0; bj < 2; ++bj)
#pragma unroll
            for (int e = 0; e < 8; ++e) rs[bj][e] = rstd_of(ssq, col0 + bj * 128 + e);
#pragma unroll
        for (int ai = 0; ai < 2; ++ai)
#pragma unroll
            for (int m = 0; m < 4; ++m) { bf16* rowp = HYT + (size_t)(row0 + ai * 128 + m * 16) * M + col0;
#pragma unroll
                for (int bj = 0; bj < 2; ++bj) { const f32x4 v0 = acc[ai][bj][m][0], v1 = acc[ai][bj][m][1];
                    v4u w; w.x = pk2(v0[0] * rs[bj][0], v0[1] * rs[bj][1]); w.y = pk2(v0[2] * rs[bj][2], v0[3] * rs[bj][3]); w.z = pk2(v1[0] * rs[bj][4], v1[1] * rs[bj][5]); w.w = pk2(v1[2] * rs[bj][6], v1[3] * rs[bj][7]);
                    *(GAS v4u*)(rowp + bj * 128) = w; } }
    }
};
template <int QT> struct EpiGU_ {
    static constexpr bool PERM = true, AFTER_DRAIN = false;
    unsigned char* U; const ssq_t* ssq; int f8; const ssq_t* ssq_old; const unsigned* amax;
    DEV void operator()(const f32x4 (&acc)[2][2][4][2], const pg8::Unit& u, int wr, int wc, int fr, int fq) const {
        const int row0 = u.pm * 256 + wr * 64 + fr, col = u.pn * 128 + wc * 32 + 8 * fq;
        f32x4 cg0, cg1, cu0, cu1;
        if constexpr (QT == 2) { const GAS f32x4* ap = (const GAS f32x4*)((const GAS float*)amax + u.pn * 256 + wc * 32 + 8 * fq); cg0 = ap[0] * (1.f / 127.f); cg1 = ap[1] * (1.f / 127.f); cu0 = ap[32] * (1.f / 127.f); cu1 = ap[33] * (1.f / 127.f); }
#pragma unroll
        for (int ai = 0; ai < 2; ++ai)
#pragma unroll
            for (int m = 0; m < 4; ++m) {
                const int row = row0 + ai * 128 + m * 16; float rs = rstd_of(ssq, row);
                f32x4 g0, g1, u0, u1;
                if constexpr (QT == 2) {
                    rs *= (XQ_CLIP / 127.f) * __builtin_amdgcn_rcpf(rstd_of(ssq_old, row));
                    g0 = __builtin_convertvector(__builtin_bit_cast(v4i, acc[ai][0][m][0]), f32x4) * cg0; g1 = __builtin_convertvector(__builtin_bit_cast(v4i, acc[ai][0][m][1]), f32x4) * cg1;
                    u0 = __builtin_convertvector(__builtin_bit_cast(v4i, acc[ai][1][m][0]), f32x4) * cu0; u1 = __builtin_convertvector(__builtin_bit_cast(v4i, acc[ai][1][m][1]), f32x4) * cu1;
                } else { g0 = acc[ai][0][m][0]; g1 = acc[ai][0][m][1]; u0 = acc[ai][1][m][0]; u1 = acc[ai][1][m][1]; }
                const float rsu = f8 ? 8.f * rs : rs;
                g0 *= rs; g1 *= rs; u0 *= rsu; u1 *= rsu;
                const float y0 = siluf_(g0[0]) * u0[0], y1 = siluf_(g0[1]) * u0[1], y2 = siluf_(g0[2]) * u0[2], y3 = siluf_(g0[3]) * u0[3];
                const float y4 = siluf_(g1[0]) * u1[0], y5 = siluf_(g1[1]) * u1[1], y6 = siluf_(g1[2]) * u1[2], y7 = siluf_(g1[3]) * u1[3];
                if (f8) { v2u w; w.x = pk4_fp8(y0, y1, y2, y3); w.y = pk4_fp8(y4, y5, y6, y7); *(GAS v2u*)(U + (size_t)row * DFF + col) = w; }
                else { v4u w; w.x = pk2(y0, y1); w.y = pk2(y2, y3); w.z = pk2(y4, y5); w.w = pk2(y6, y7); *(GAS v4u*)((bf16*)U + (size_t)row * DFF + col) = w; }
            }
    }
};
typedef EpiGU_<0> EpiGU;
#define XB_TMO      128
#define XB_XCNT(j)  (256  + 64 * (j))
#define XB_XSUB(j)  (1280 + 64 * (j))
#define XB_XGEN(j)  (2304 + 64 * (j))
#define XB_TOP      3328
#define XB_TOPGEN   3392
#define XCD_BAR_WORDS 3456
#define XB_SPIN_CAP (1u << 18)
__device__ __forceinline__ unsigned xb_ld(unsigned* p)              { return __hip_atomic_load(p, __ATOMIC_RELAXED, __HIP_MEMORY_SCOPE_AGENT); }
__device__ __forceinline__ unsigned xb_add(unsigned* p, unsigned v) { return __hip_atomic_fetch_add(p, v, __ATOMIC_RELAXED, __HIP_MEMORY_SCOPE_AGENT); }
__device__ __forceinline__ unsigned xb_xcc_id() { return (unsigned)__builtin_amdgcn_s_getreg((3 << 11) | 20) & 0xFu; }
#define XB_SPIN(cond, bar) do { unsigned _sp = 0; while (cond) { __builtin_amdgcn_s_sleep(1); \
    if ((++_sp & 255u) == 0u) { if (xb_ld(&(bar)[XB_TMO])) break; if (_sp > XB_SPIN_CAP) { atomicAdd(&(bar)[XB_TMO], 1u); break; } } } } while (0)

struct XcdBarrier {
    unsigned* bar; unsigned x;
    volatile LAS unsigned* st;
};

__device__ __forceinline__ XcdBarrier xcd_barrier_post(unsigned* bar, volatile LAS unsigned* st) {
    XcdBarrier b; b.bar = bar; b.x = xb_xcc_id(); b.st = st;
    if (threadIdx.x == 0) (void)xb_add(&bar[XB_XCNT(b.x)], 1u);
    return b;
}
__device__ __forceinline__ void xcd_barrier_complete(unsigned* bar, unsigned x, unsigned& nloc, unsigned& nx) {
    const unsigned G = gridDim.x * gridDim.y * gridDim.z;
    unsigned sum, cnt, mine, sp = 0u;
    for (;;) {
        sum = 0u; cnt = 0u; mine = 0u;
#pragma unroll
        for (unsigned j = 0; j < 16; ++j) { const unsigned c = xb_ld(&bar[XB_XCNT(j)]); sum += c; cnt += (c > 0u) ? 1u : 0u; }
        if (sum == G) { mine = xb_ld(&bar[XB_XCNT(x)]); break; }
        __builtin_amdgcn_s_sleep(1);
        if ((++sp & 255u) == 0u) { if (xb_ld(&bar[XB_TMO])) break; if (sp > XB_SPIN_CAP) { atomicAdd(&bar[XB_TMO], 1u); break; } }
    }
    nloc = mine > 0u ? mine : 1u; nx = cnt > 0u ? cnt : 1u;
}

__device__ __forceinline__ void xcd_barrier(const XcdBarrier& b, const bool leader  ) {
    asm volatile("s_waitcnt vmcnt(0)" ::: "memory");
    __syncthreads();
    if (leader) {
        unsigned* bar = b.bar;
        __builtin_amdgcn_s_waitcnt(0);
        unsigned nloc = b.st[0], nx = b.st[1];
        if (nloc == 0u) { xcd_barrier_complete(bar, b.x, nloc, nx); b.st[0] = nloc; b.st[1] = nx; }
        const unsigned old = xb_add(&bar[XB_XSUB(b.x)], 1u);
        const unsigned gen = old / nloc;
        if (old + 1u == (gen + 1u) * nloc) {
            __builtin_amdgcn_fence(__ATOMIC_RELEASE, "agent");
            asm volatile("s_waitcnt vmcnt(0)" ::: "memory");
            const unsigned og = xb_add(&bar[XB_TOP], 1u);
            const unsigned tg = og / nx;
            if (og + 1u == (tg + 1u) * nx) xb_add(&bar[XB_TOPGEN], 1u);
            else XB_SPIN(xb_ld(&bar[XB_TOPGEN]) == tg, bar);
            __builtin_amdgcn_fence(__ATOMIC_ACQUIRE, "agent");
            xb_add(&bar[XB_XGEN(b.x)], 1u);
            asm volatile("s_waitcnt vmcnt(0)" ::: "memory");
        } else {
            XB_SPIN(xb_ld(&bar[XB_XGEN(b.x)]) == gen, bar);
            __builtin_amdgcn_fence(__ATOMIC_ACQUIRE, "agent");
            asm volatile("s_waitcnt vmcnt(0)" ::: "memory");
        }
    }
    __syncthreads();
}

constexpr size_t MiB = 1u << 20;
constexpr size_t WS_CTL = 0, CTL_BYTES = 1 * MiB;
constexpr int CW_BAR = 4096;
constexpr size_t CTL_SSQ_OFF = 128 * 1024;
constexpr size_t CTL_AMAX_OFF = 832 * 1024;
constexpr size_t WS_WIN = 1 * MiB;
constexpr size_t WS_WOUT = WS_WIN + 2 * 88 * MiB;
constexpr size_t WS_WGU = WS_WOUT + 2 * 32 * MiB;
constexpr size_t WS_WDN = WS_WGU + 2 * 172 * MiB;
constexpr size_t WS_XB = WS_WDN + 2 * 86 * MiB;
constexpr size_t WS_MIX = WS_XB + 128 * MiB;
constexpr size_t WS_PROJ = WS_MIX + 128 * MiB;
constexpr size_t WS_KV = WS_PROJ + 352 * MiB;
constexpr size_t WS_HYT = WS_KV + 128 * MiB;
constexpr size_t WS_HYO = WS_HYT + 96 * MiB;
constexpr size_t WS_GSCR = WS_HYO + 32 * MiB;
constexpr size_t WS_ROT = WS_GSCR + 96 * MiB;
constexpr size_t WS_HDN = WS_ROT + 8 * MiB;
constexpr size_t WS_LRUC = WS_HDN + 8 * MiB;
constexpr size_t WS_WGT = WS_LRUC + 3 * MiB;
constexpr size_t WS_END = WS_WGT + 2 * MiB;

constexpr int LDS_BYTES = 160 * 1024;
constexpr int MISC_OFF = LDS_BYTES - 256;
#ifndef FP8_MASK
#define FP8_MASK 2
#endif
#ifndef PROBE_P0
#define PROBE_P0 0
#endif
#ifndef I8_MASK
#define I8_MASK 3
#endif
#define I8_GU(l) ((I8_MASK >> (l)) & 1)
#define FP8_DOWN(l) ((FP8_MASK >> (l)) & 1)
constexpr int NPH = 16;

#define LDS_WAIT() asm volatile("s_waitcnt lgkmcnt(0)" ::: "memory")
#define VM_WAIT() asm volatile("s_waitcnt vmcnt(0)" ::: "memory")

struct Args { const float* in[29]; float* out; unsigned char* ws; int ph_lo, ph_hi; };

struct Frame {
    LAS unsigned char* lds; int tid, lane, wave, vcu, G;
    const float* const* in;
    float* out; unsigned char* ws;
    DEV const float* I(int k) const { return (const float*)(const GAS float*)in[k]; }
    template <class T> DEV T* W(size_t off) const { return (T*)(GAS T*)(ws + off); }
    DEV float* O() const { return (float*)(GAS float*)out; }
};

DEV float wave_sum(float v, int lane) {
#pragma unroll
    for (int o = 1; o < 64; o <<= 1) v += shx(v, o, lane);
    return v;
}
DEV f32x2 cmul(f32x2 a, f32x2 b) { return (f32x2){a.x * b.x - a.y * b.y, a.x * b.y + a.y * b.x}; }
DEV bf16x8 lfrag(const LAS unsigned char* base, int row0, int s, int stride, int fr, int fq) { return *(const LAS bf16x8*)(base + (row0 + fr) * stride + s * 64 + fq * 16); }
DEV f32x4 mfma16(bf16x8 a, bf16x8 b, f32x4 c) { return __builtin_amdgcn_mfma_f32_16x16x32_bf16(a, b, c, 0, 0, 0); }
template <int E> DEV float bfe(const v4u& v) { const unsigned w = E < 2 ? v.x : E < 4 ? v.y : E < 6 ? v.z : v.w; return (E & 1) ? bfhi(w) : bflo(w); }

DEV int map_win(int n) {
    if (n < 5120 || n >= 7168) return n;
    const int base = n < 6144 ? 5120 : 6144, r = n - base, h = r >> 7, j = r & 127;
    return base + 256 * (h >> 1) + 128 * (j >> 6) + 64 * (h & 1) + (j & 63);
}
template <int CTRL> DEV float dpp_f(float x) { return __builtin_bit_cast(float, __builtin_amdgcn_update_dpp(0, __builtin_bit_cast(int, x), CTRL, 0xf, 0xf, true)); }
DEV void tr_item(const float* W, int K, int N, bf16* WT, LAS float* scr, int item, int lane, const float* gain, int mode, unsigned* amax = nullptr) {
    const int nblk = N / 64, kb = item / nblk, nb = item - kb * nblk, k0 = 64 * kb, n0 = 64 * nb;
    const int l16 = lane & 15, kq = lane >> 4;
    f32x4 v[16];
#pragma unroll
    for (int i = 0; i < 16; ++i) v[i] = __builtin_nontemporal_load((const GAS f32x4*)(W + (size_t)(k0 + 4 * i + kq) * N + n0 + 4 * l16));
#pragma unroll
    for (int i = 0; i < 16; ++i) { LAS float* d = scr + (4 * l16) * 65 + 4 * i + kq; d[0] = v[i][0]; d[65] = v[i][1]; d[130] = v[i][2]; d[195] = v[i][3]; }
    LDS_WAIT();
    const int kc = lane & 7, nr = lane >> 3;
    f32x4 g0 = (f32x4){1.f, 1.f, 1.f, 1.f}, g1 = g0;
    if (gain) { g0 = *(const GAS f32x4*)(gain + k0 + 8 * kc); g1 = *(const GAS f32x4*)(gain + k0 + 8 * kc + 4); }
    float mine = 0.f;
#pragma unroll
    for (int j = 0; j < 8; ++j) { const int n = 8 * j + nr; const LAS float* s = scr + n * 65 + 8 * kc;
        int nd = n0 + n; if (mode == 1) nd = map_win(nd); else if (mode == 2) nd = 256 * (nd >> 7) + (nd & 127); else if (mode == 3) nd = 256 * (nd >> 7) + 128 + (nd & 127);
        if (mode == 4) { v2u o; o.x = pk4_fp8(s[0] * 1024.f, s[1] * 1024.f, s[2] * 1024.f, s[3] * 1024.f); o.y = pk4_fp8(s[4] * 1024.f, s[5] * 1024.f, s[6] * 1024.f, s[7] * 1024.f);
            *(GAS v2u*)((unsigned char*)WT + (size_t)nd * K + k0 + 8 * kc) = o; continue; }
        const float p0 = s[0] * g0[0], p1 = s[1] * g0[1], p2 = s[2] * g0[2], p3 = s[3] * g0[3], p4 = s[4] * g1[0], p5 = s[5] * g1[1], p6 = s[6] * g1[2], p7 = s[7] * g1[3];
        v4u o; o.x = pk2(p0, p1); o.y = pk2(p2, p3); o.z = pk2(p4, p5); o.w = pk2(p6, p7);
        *(GAS v4u*)(WT + (size_t)nd * K + k0 + 8 * kc) = o;
        if (amax) { float mx = fmaxf(fmaxf(fmaxf(fabsf(p0), fabsf(p1)), fmaxf(fabsf(p2), fabsf(p3))), fmaxf(fmaxf(fabsf(p4), fabsf(p5)), fmaxf(fabsf(p6), fabsf(p7))));
            mx = fmaxf(mx, dpp_f<0xB1>(mx)); mx = fmaxf(mx, dpp_f<0x4E>(mx)); mx = fmaxf(mx, dpp_f<0x141>(mx));
            mine = kc == j ? mx : mine; } }
    if (amax) {
        int nd = n0 + 8 * kc + nr; if (mode == 1) nd = map_win(nd); else if (mode == 2) nd = 256 * (nd >> 7) + (nd & 127); else if (mode == 3) nd = 256 * (nd >> 7) + 128 + (nd & 127);
        __hip_atomic_fetch_max((GAS unsigned*)amax + nd, __float_as_uint(mine), __ATOMIC_RELAXED, __HIP_MEMORY_SCOPE_AGENT); }
    LDS_WAIT();
}
DEV void p0_weights(const Frame& F, int gw, int NGW, int lane, int rep = 0) {
    LAS float* scr = (LAS float*)(F.lds + F.wave * 16896);
    constexpr int I_IN = 64 * 176, I_OUT = 64 * 64, I_G = 64 * 172, I_DN = 172 * 64, I_L = I_IN + I_OUT + 2 * I_G + I_DN;
    for (int it = gw; it < 2 * I_L; it += NGW) {
        const int itr = 2 * I_L - 1 - it;
        const int l = itr >= I_L ? 1 : 0; int r = itr - l * I_L;
        if (r < I_IN) { tr_item(F.I(2) + (size_t)l * D * NIN, D, NIN, F.W<bf16>(WS_WIN + (size_t)l * 88 * MiB), scr, r, lane, F.I(1) + l * D, 1); continue; } r -= I_IN;
        if (r < I_OUT) { tr_item(F.I(23) + (size_t)l * D * D, D, D, F.W<bf16>(WS_WOUT + (size_t)l * 32 * MiB), scr, r, lane, nullptr, 0); continue; } r -= I_OUT;
        unsigned* am = nullptr;
        if (r < I_G) { tr_item(F.I(25) + (size_t)l * D * DFF, D, DFF, F.W<bf16>(WS_WGU + (size_t)l * 172 * MiB), scr, r, lane, F.I(24) + l * D, 2, am); continue; } r -= I_G;
        if (r < I_G) { tr_item(F.I(26) + (size_t)l * D * DFF, D, DFF, F.W<bf16>(WS_WGU + (size_t)l * 172 * MiB), scr, r, lane, F.I(24) + l * D, 3, am); continue; } r -= I_G;
        tr_item(F.I(27) + (size_t)l * DFF * D, DFF, D, F.W<bf16>(WS_WDN + (size_t)l * 86 * MiB), scr, r, lane, nullptr, FP8_DOWN(l) ? 4 : 0);
    }
}
DEV void wq_rows(const Frame& F, int l) {
    unsigned char* base = F.W<unsigned char>(WS_WGU + (size_t)l * 172 * MiB); const unsigned* am = F.W<unsigned>(CTL_AMAX_OFF) + l * NGU;
    for (int r = F.vcu * 8 + F.wave; r < NGU; r += F.G * 8) {
        const GAS v4u* rp = (const GAS v4u*)(base + (size_t)r * 8192) + F.lane; v4u v[8];
#pragma unroll
        for (int i = 0; i < 8; ++i) v[i] = rp[i * 64];
        float a = 0.f;
#pragma unroll
        for (int i = 0; i < 8; ++i) a = fmaxf(fmaxf(fmaxf(a, fmaxf(fabsf(bflo(v[i].x)), fabsf(bfhi(v[i].x)))), fmaxf(fabsf(bflo(v[i].y)), fabsf(bfhi(v[i].y)))), fmaxf(fmaxf(fabsf(bflo(v[i].z)), fabsf(bfhi(v[i].z))), fmaxf(fabsf(bflo(v[i].w)), fabsf(bfhi(v[i].w)))));
#pragma unroll
        for (int o = 1; o < 64; o <<= 1) a = fmaxf(a, shx(a, o, F.lane));
        if (F.lane == 0) ((GAS unsigned*)am)[r] = __float_as_uint(a);
        const float qs = a > 0.f ? 127.f * __builtin_amdgcn_rcpf(a) : 0.f;
#pragma unroll
        for (int i = 0; i < 8; ++i) { v2u o; o.x = pk4_i8(bflo(v[i].x) * qs, bfhi(v[i].x) * qs, bflo(v[i].y) * qs, bfhi(v[i].y) * qs); o.y = pk4_i8(bflo(v[i].z) * qs, bfhi(v[i].z) * qs, bflo(v[i].w) * qs, bfhi(v[i].w) * qs);
            *(GAS v2u*)(base + (size_t)r * 8192 + i * 512 + F.lane * 8) = o; }
    }
}
DEV void p0_small(const Frame& F, int gw, int NGW, int lane) {
    { const float* x = F.I(0); bf16* xb = F.W<bf16>(WS_XB); ssq_t* ssq = F.W<ssq_t>(CTL_SSQ_OFF);
      for (int m = gw; m < M; m += NGW) { const GAS f32x4* xr = (const GAS f32x4*)(x + (size_t)m * D) + lane; GAS v2u* o = (GAS v2u*)(xb + (size_t)m * D) + lane; float s = 0.f;
#pragma unroll
          for (int j = 0; j < 16; ++j) { const f32x4 v = xr[64 * j]; s += (v[0] * v[0] + v[1] * v[1]) + (v[2] * v[2] + v[3] * v[3]); v2u w; w.x = pk2(v[0], v[1]); w.y = pk2(v[2], v[3]); o[64 * j] = w; }
          s = wave_sum(s, lane); if (lane == 0) ((GAS ssq_t*)ssq)[m] = (ssq_t)(s * 16777216.f); } }
    { float* rot = F.W<float>(WS_ROT); const double inv = exp(-(double)lane * (9.210340371976184 / 64.0)) * 0.3183098861837907;
      for (int idx = gw * 64 + lane; idx < M * 64; idx += NGW * 64) { const int pos = idx >> 6;
          double xx = (double)pos * inv; xx -= 2.0 * floor(xx * 0.5); const float xf = (float)xx;
          *(GAS f32x2*)(rot + 2 * idx) = (f32x2){cospif(xf), sinpif(xf)}; } }
    { float* hdn = F.W<float>(WS_HDN);
      for (int l = 0; l < NLAYER; ++l) {
          const GAS float* w1 = (const GAS float*)F.I(13) + l * 33 * 64 + lane; const GAS float* w2 = (const GAS float*)F.I(15) + l * 64 * 64 + lane;
          float w1c[33], w2c[64];
#pragma unroll
          for (int i = 0; i < 33; ++i) w1c[i] = w1[i * 64];
#pragma unroll
          for (int i = 0; i < 64; ++i) w2c[i] = w2[i * 64];
          const float fq_ = ((const GAS float*)F.I(18))[l * 64 + lane], b1 = ((const GAS float*)F.I(14))[l * 64 + lane], b2 = ((const GAS float*)F.I(16))[l * 64 + lane];
          const int bb = (lane - 1) & 15; const double fb2 = 2.0 * (1e-4 + (double)bb * ((15.0 - 1e-4) / 15.0)) * (1.0 / 16384.0);
          for (int t = gw; t < M; t += NGW) {
              float feat = (float)t * (1.0f / 16383.0f);
              if (lane >= 1 && lane < 33) { double xx = fb2 * (double)t; xx -= 2.0 * floor(xx * 0.5); const float xf = (float)xx; feat = lane <= 16 ? cospif(xf) : -sinpif(xf); }
              float h1 = b1;
#pragma unroll
              for (int i = 0; i < 33; ++i) h1 += __builtin_bit_cast(float, __builtin_amdgcn_readlane(__builtin_bit_cast(int, feat), i)) * w1c[i];
              h1 = __sinf(fq_ * h1);
              float h2 = b2;
#pragma unroll
              for (int i = 0; i < 64; ++i) h2 += __builtin_bit_cast(float, __builtin_amdgcn_readlane(__builtin_bit_cast(int, h1), i)) * w2c[i];
              ((GAS float*)hdn)[((size_t)l * M + t) * 64 + lane] = __sinf(fq_ * h2); } } }
    { bf16* wgt = F.W<bf16>(WS_WGT);
      for (int idx = gw * 64 + lane; idx < 2 * 2 * 2 * 8 * 16384; idx += NGW * 64) { const int i = idx & 127, j = (idx >> 7) & 127, h = (idx >> 14) & 7, g = (idx >> 17) & 1, ld = idx >> 18;
          const GAS float* src = (const GAS float*)(g ? F.I(7) : F.I(5)); ((GAS bf16*)wgt)[idx] = f2bf(src[((size_t)(ld * 8 + h) * 128 + i) * 128 + j]); } }
}
DEV void p0_prologue(const Frame& F, int rep = 0) {
    const int gw = F.vcu * 8 + F.wave, NGW = F.G * 8, lane = F.lane;
    if (F.wave & 1) { p0_small(F, gw, NGW, lane); p0_weights(F, gw, NGW, lane, rep); }
    else { p0_weights(F, gw, NGW, lane, rep); p0_small(F, gw, NGW, lane); }
}

DEV void hyt_unit(const Frame& F, int l, int unit) {
    int tid = F.tid; asm volatile("" : "+v"(tid)); const int tb = unit / 24, cb = unit - tb * 24, t0 = tb * 128, c0 = cb * 128;
    LAS float* S = (LAS float*)F.lds;
    const bf16* HU = F.W<bf16>(WS_PROJ + 64 * MiB);
    { v4u vv[5];
#pragma unroll
      for (int k = 0; k < 5; ++k) { const int task = tid + 512 * k, r = task >> 4, ch = task & 15, t = t0 - 1 + r; vv[k] = (v4u){0u, 0u, 0u, 0u};
          if (task < 130 * 16 && t >= 0 && t < M) vv[k] = *(const GAS v4u*)(HU + (size_t)t * 3072 + c0 + ch * 8); }
#pragma unroll
      for (int k = 0; k < 5; ++k) { const int task = tid + 512 * k, r = task >> 4, ch = task & 15; const v4u v = vv[k];
          if (task < 130 * 16) { LAS float* d = S + r * 129 + ch * 8; d[0] = bflo(v.x); d[1] = bfhi(v.x); d[2] = bflo(v.y); d[3] = bfhi(v.y); d[4] = bflo(v.z); d[5] = bfhi(v.z); d[6] = bflo(v.w); d[7] = bfhi(v.w); } } }
    __syncthreads();
    { const int cc = tid & 127, tq = tid >> 7, c = c0 + cc; const float* cw = F.I(11) + l * 3 * 3072; const float w0 = cw[c], w1 = cw[3072 + c], w2 = cw[2 * 3072 + c], b = F.I(12)[l * 3072 + c];
      bf16* dst = F.W<bf16>(WS_HYT) + (size_t)c * M + t0 + tq * 32;
#pragma unroll
      for (int k = 0; k < 4; ++k) { float y[8];
#pragma unroll
          for (int e = 0; e < 8; ++e) { const int t = tq * 32 + k * 8 + e; y[e] = b + w0 * S[t * 129 + cc] + w1 * S[(t + 1) * 129 + cc] + w2 * S[(t + 2) * 129 + cc]; }
          v4u o; o.x = pk2(y[0], y[1]); o.y = pk2(y[2], y[3]); o.z = pk2(y[4], y[5]); o.w = pk2(y[6], y[7]); *(GAS v4u*)(dst + k * 8) = o; } }
    __syncthreads();
}
DEV void split_bf16(const float (&x)[8], bf16x8& hi, bf16x8& lo) {
    unsigned h[4], l[4];
#pragma unroll
    for (int j = 0; j < 4; ++j) { h[j] = pk2(x[2 * j], x[2 * j + 1]); l[j] = pk2(x[2 * j] - bflo(h[j]), x[2 * j + 1] - bfhi(h[j])); }
    const v4u hv = (v4u){h[0], h[1], h[2], h[3]}, lv = (v4u){l[0], l[1], l[2], l[3]};
    hi = __builtin_bit_cast(bf16x8, hv); lo = __builtin_bit_cast(bf16x8, lv);
}
DEV void hyf_item(const Frame& F, int l, int item) {
    int lane = F.lane; asm volatile("" : "+v"(lane)); const int cg = item >> 5, tr = item & 31, fr = lane & 15, fq = lane >> 4;
    const float* w3 = F.I(17) + (size_t)l * 64 * 4096; const float* hdn = F.W<float>(WS_HDN) + (size_t)l * M * 64; bf16* filt = F.W<bf16>(WS_MIX);
    bf16x8 bh[4][2], bl[4][2]; float rate[4];
#pragma unroll
    for (int ct = 0; ct < 4; ++ct) { const int col = 64 * cg + 16 * ct + fr; rate[ct] = -fabsf(((const GAS float*)F.I(19))[l * 4096 + col]) * (1.0f / 16383.0f);
#pragma unroll
        for (int s = 0; s < 2; ++s) { float x[8];
#pragma unroll
            for (int j = 0; j < 8; ++j) x[j] = ((const GAS float*)w3)[(size_t)(32 * s + 8 * fq + j) * 4096 + col];
            split_bf16(x, bh[ct][s], bl[ct][s]); } }
    LAS unsigned char* wt = F.lds + F.wave * 9216;
    for (int tg = 0; tg < 8; ++tg) {
#pragma unroll
      for (int t4 = 0; t4 < 4; ++t4) { const int tb = tr * 512 + (tg * 4 + t4) * 16; const GAS f32x4* ap = (const GAS f32x4*)(hdn + (size_t)(tb + fr) * 64 + 8 * fq);
        bf16x8 ah[2], al[2];
#pragma unroll
        for (int s = 0; s < 2; ++s) { const f32x4 a0 = ap[8 * s], a1 = ap[8 * s + 1]; const float x[8] = {a0[0], a0[1], a0[2], a0[3], a1[0], a1[1], a1[2], a1[3]}; split_bf16(x, ah[s], al[s]); }
#pragma unroll
        for (int ct = 0; ct < 4; ++ct) { f32x4 acc = (f32x4){0.f, 0.f, 0.f, 0.f};
#pragma unroll
            for (int s = 0; s < 2; ++s) { acc = mfma16(al[s], bh[ct][s], acc); acc = mfma16(ah[s], bl[ct][s], acc); acc = mfma16(ah[s], bh[ct][s], acc); }
            const int t = tb + 4 * fq; float y[4];
#pragma unroll
            for (int e = 0; e < 4; ++e) y[e] = acc[e] * __expf((float)(t + e) * rate[ct]);
            v2u o; o.x = pk2(y[0], y[1]); o.y = pk2(y[2], y[3]); *(LAS v2u*)(wt + ct * 2304 + fr * 144 + t4 * 32 + fq * 8) = o; } }
      LDS_WAIT();
#pragma unroll
      for (int ct = 0; ct < 4; ++ct)
#pragma unroll
          for (int it = 0; it < 2; ++it) { const int row = lane >> 2, ch = (lane & 3) + 4 * it; const v4u v = *(const LAS v4u*)(wt + ct * 2304 + row * 144 + ch * 16);
              *(GAS v4u*)(filt + (size_t)(64 * cg + 16 * ct + row) * M + tr * 512 + tg * 64 + ch * 8) = v; }
      LDS_WAIT();
    }
}
template <bool PHASE_C> DEV void lru_unit(const Frame& F, int l, int n, int h) {
    int tid = F.tid; asm volatile("" : "+v"(tid)); const int t0 = n * 128, lane = tid & 63, w = F.wave, fr = lane & 15, fq = lane >> 4;
    LAS unsigned char* RAW = F.lds; LAS unsigned char* XCF = F.lds + 33792; LAS unsigned char* XCB = F.lds + 33792 + 67584;
    const bf16* LX = F.W<bf16>(WS_PROJ + 32 * MiB);
    const int cw16 = 16 * w + fr, cg = h * 128 + cw16;
    const float* CIN = F.W<float>(WS_LRUC) + 4 * 128 * 1024;
    const float* cw = F.I(3) + l * 4 * 1024; const float* cb = F.I(4) + l * 1024; const int c4 = tid & 31, c = h * 128 + c4 * 4;
    v4u vv[5];
#pragma unroll
    for (int k = 0; k < 5; ++k) { const int task = tid + 512 * k, r = (task >> 4) > 130 ? 130 : (task >> 4), ch = task & 15, t = t0 - 2 + r, tc = t < 0 ? 0 : (t > M - 1 ? M - 1 : t);
        vv[k] = *(const GAS v4u*)(LX + (size_t)tc * 1024 + h * 128 + ch * 8); if (t != tc) vv[k] = (v4u){0u, 0u, 0u, 0u}; }
    const f32x4 bias = *(const GAS f32x4*)(cb + c), w0 = *(const GAS f32x4*)(cw + c), w1 = *(const GAS f32x4*)(cw + 1024 + c), w2 = *(const GAS f32x4*)(cw + 2048 + c), w3 = *(const GAS f32x4*)(cw + 3072 + c);
    float brv2[2], biv2[2], lam2[2], cin2[2];
#pragma unroll
    for (int d = 0; d < 2; ++d) {
        const int pidx = (l * 2 + d) * 1024 + cg; brv2[d] = ((const GAS float*)F.I(6))[pidx]; biv2[d] = ((const GAS float*)F.I(8))[pidx]; lam2[d] = ((const GAS float*)F.I(9))[pidx];
        cin2[d] = PHASE_C ? ((const GAS float*)CIN)[(d * 128 + n) * 1024 + cg] : 0.f; }
#pragma unroll
    for (int k = 0; k < 5; ++k) { const int task = tid + 512 * k, r = task >> 4, ch = task & 15; if (task < 131 * 16) *(LAS v4u*)(RAW + r * 256 + ch * 16) = vv[k]; }
    __syncthreads();
    {
#pragma unroll
      for (int k = 0; k < 8; ++k) { const int t = (tid >> 5) + 16 * k; f32x4 a = bias;
          const v2u r0 = *(const LAS v2u*)(RAW + (t + 0) * 256 + c4 * 8), r1 = *(const LAS v2u*)(RAW + (t + 1) * 256 + c4 * 8), r2 = *(const LAS v2u*)(RAW + (t + 2) * 256 + c4 * 8), r3 = *(const LAS v2u*)(RAW + (t + 3) * 256 + c4 * 8);
          a[0] += w0[0] * bflo(r0.x) + w1[0] * bflo(r1.x) + w2[0] * bflo(r2.x) + w3[0] * bflo(r3.x); a[1] += w0[1] * bfhi(r0.x) + w1[1] * bfhi(r1.x) + w2[1] * bfhi(r2.x) + w3[1] * bfhi(r3.x);
          a[2] += w0[2] * bflo(r0.y) + w1[2] * bflo(r1.y) + w2[2] * bflo(r2.y) + w3[2] * bflo(r3.y); a[3] += w0[3] * bfhi(r0.y) + w1[3] * bfhi(r1.y) + w2[3] * bfhi(r2.y) + w3[3] * bfhi(r3.y);
          *(LAS f32x4*)(XCF + t * 528 + c4 * 16) = a; v2u pb; pb.x = pk2(a[0], a[1]); pb.y = pk2(a[2], a[3]); *(LAS v2u*)(XCB + t * 272 + c4 * 8) = pb; } }
    __syncthreads();
    float* AP = F.W<float>(WS_LRUC); float* BE = AP + 2 * 128 * 1024;
    float hs[8][4];
#pragma unroll
    for (int d = 0; d < 2; ++d) {
        const bf16* wg = F.W<bf16>(WS_WGT) + ((((size_t)(l * 2 + d) * 2) * 8 + h) * 128 + cw16) * 128;
        bf16x8 br_[4], bi_[4];
#pragma unroll
        for (int s = 0; s < 4; ++s) { br_[s] = *(const GAS bf16x8*)(wg + 32 * s + 8 * fq); bi_[s] = *(const GAS bf16x8*)(wg + (size_t)8 * 128 * 128 + 32 * s + 8 * fq); }
        const float brv = brv2[d], biv = biv2[d], sp = log1pf(__expf(-lam2[d]));
        const int bp16 = 4 * (d == 0 ? (lane >= 16 ? lane - 16 : lane) : (lane < 48 ? lane + 16 : lane)), bp32 = 4 * (d == 0 ? (lane >= 32 ? lane - 32 : lane) : (lane < 32 ? lane + 32 : lane)), bpt = 4 * (d == 0 ? fr + 48 : fr);
#define BPERM(addr, x) __builtin_bit_cast(float, __builtin_amdgcn_ds_bpermute((addr), __builtin_bit_cast(int, (x))))
        float hin = cin2[d], CA = 1.f, CB = 0.f;
#pragma unroll
        for (int hf = 0; hf < 4; ++hf) { const int mb = (d == 0 ? hf : 3 - hf) * 2;
        f32x4 pra[2], pia[2];
#pragma unroll
        for (int m4 = 0; m4 < 2; ++m4) { const int m = mb + m4;
            f32x4 pr = (f32x4){0.f, 0.f, 0.f, 0.f}, pi = (f32x4){0.f, 0.f, 0.f, 0.f};
#pragma unroll
            for (int s = 0; s < 4; ++s) { const bf16x8 a = lfrag(XCB, 16 * m, s, 272, fr, fq); pr = mfma16(a, br_[s], pr); pi = mfma16(a, bi_[s], pi); }
#pragma unroll
            for (int e = 0; e < 4; ++e) { const int tk = 16 * m + 4 * fq + e; const float xc = *(const LAS float*)(XCF + tk * 528 + cw16 * 4);
                const float r = sigmoidf_(pr[e] + brv), ig = sigmoidf_(pi[e] + biv), la = -8.f * r * sp;
                const float av = __expf(la), om = (1.f - av) * (1.f + av);
                pr[e] = av; pi[e] = __builtin_amdgcn_sqrtf(om) * ig * xc; }
            pra[m4] = pr; pia[m4] = pi; }
#pragma unroll
        for (int mm = 0; mm < 2; ++mm) { const int m4 = d == 0 ? mm : 1 - mm, m = mb + m4; const f32x4 pr = pra[m4], pi = pia[m4];
            float A = 1.f, B = 0.f;
#pragma unroll
            for (int rr = 0; rr < 4; ++rr) { const int e = d == 0 ? rr : 3 - rr; B = pr[e] * B + pi[e]; A = A * pr[e]; }
            float EA, EB, TA, TB;
            { float A1 = BPERM(bp16, A), B1 = BPERM(bp16, B); if (d == 0 ? fq >= 1 : fq <= 2) { B = A * B1 + B; A = A1 * A; }
              A1 = BPERM(bp32, A); B1 = BPERM(bp32, B); if (d == 0 ? fq >= 2 : fq <= 1) { B = A * B1 + B; A = A1 * A; }
              EA = BPERM(bp16, A); EB = BPERM(bp16, B); if (d == 0 ? fq == 0 : fq == 3) { EA = 1.f; EB = 0.f; }
              TA = BPERM(bpt, A); TB = BPERM(bpt, B); }
            if (PHASE_C) { float hc = EA * hin + EB;
#pragma unroll
                for (int rr = 0; rr < 4; ++rr) { const int e = d == 0 ? rr : 3 - rr; hc = pr[e] * hc + pi[e]; if (d == 0) hs[m][e] = hc; else hs[m][e] += hc; } }
            hin = TA * hin + TB; CB = TA * CB + TB; CA = CA * TA; }
        __builtin_amdgcn_sched_barrier(0); }
#undef BPERM
        if (!PHASE_C && fq == 0) { ((GAS float*)AP)[(d * 128 + n) * 1024 + cg] = CA; ((GAS float*)BE)[(d * 128 + n) * 1024 + cg] = CB; }
    }
    if (PHASE_C) {
        bf16* MIX = F.W<bf16>(WS_MIX); const bf16* LG = F.W<bf16>(WS_PROJ); const float* gn = F.I(10) + l * 1024 + h * 128;
        v4u lgv[4];
#pragma unroll
        for (int k = 0; k < 4; ++k) { const int task = tid + 512 * k, t = task >> 4, ch = task & 15; lgv[k] = *(const GAS v4u*)(LG + (size_t)(t0 + t) * 1024 + h * 128 + ch * 8); }
        const f32x4 gn0 = *(const GAS f32x4*)(gn + (tid & 15) * 8), gn1 = *(const GAS f32x4*)(gn + (tid & 15) * 8 + 4);
        __syncthreads();
#pragma unroll
        for (int m = 0; m < 8; ++m)
#pragma unroll
            for (int e = 0; e < 4; ++e) *(LAS float*)(XCF + (16 * m + 4 * fq + e) * 528 + cw16 * 4) = hs[m][e];
        __syncthreads();
#pragma unroll
        for (int k = 0; k < 4; ++k) { const int task = tid + 512 * k, t = task >> 4, ch = task & 15;
            const f32x4 h0 = *(const LAS f32x4*)(XCF + t * 528 + ch * 32), h1 = *(const LAS f32x4*)(XCF + t * 528 + ch * 32 + 16);
            const v4u lg = lgv[k];
            float y[8]; y[0] = bflo(lg.x) * h0[0]; y[1] = bfhi(lg.x) * h0[1]; y[2] = bflo(lg.y) * h0[2]; y[3] = bfhi(lg.y) * h0[3];
            y[4] = bflo(lg.z) * h1[0]; y[5] = bfhi(lg.z) * h1[1]; y[6] = bflo(lg.w) * h1[2]; y[7] = bfhi(lg.w) * h1[3];
            float ss = 0.f;
#pragma unroll
            for (int e = 0; e < 8; ++e) ss += y[e] * y[e];
            ss += shx(ss, 1, lane); ss += shx(ss, 2, lane); ss += shx(ss, 4, lane); ss += shx(ss, 8, lane);
            const float rinv = rsqrtf(ss * (1.f / 128.f) + EPS); const f32x4 g0 = gn0, g1 = gn1;
            v4u o; o.x = pk2(y[0] * rinv * g0[0], y[1] * rinv * g0[1]); o.y = pk2(y[2] * rinv * g0[2], y[3] * rinv * g0[3]);
            o.z = pk2(y[4] * rinv * g1[0], y[5] * rinv * g1[1]); o.w = pk2(y[6] * rinv * g1[2], y[7] * rinv * g1[3]);
            *(GAS v4u*)(MIX + (size_t)(t0 + t) * 4096 + h * 128 + ch * 8) = o; }
    }
    __syncthreads();
}
DEV void reta_unit(const Frame& F, int n, int h) {
    int tid = F.tid; asm volatile("" : "+v"(tid)); const int t0 = n * 128, lane = tid & 63, w = F.wave, fr = lane & 15, fq = lane >> 4;
    LAS unsigned char* KTF = F.lds; LAS unsigned char* KTB = F.lds + 34816; LAS unsigned char* VT = F.lds + 69632;
    const bf16* Kr = F.W<bf16>(WS_PROJ + 192 * MiB); const bf16* V = F.W<bf16>(WS_PROJ + 224 * MiB); bf16* KV = F.W<bf16>(WS_KV);
    const float l2g = log2f(1.f - exp2f(-5.f - (float)h));
    v4u kr0[2], kr1[2], vr0[4], vr1[4];
#pragma unroll
    for (int k = 0; k < 2; ++k) { const int task = tid + 512 * k, p = task & 63, ch = task >> 6, c0 = 2 * p;
        kr0[k] = *(const GAS v4u*)(Kr + (size_t)(t0 + c0) * 1024 + h * 128 + ch * 8); kr1[k] = *(const GAS v4u*)(Kr + (size_t)(t0 + c0 + 1) * 1024 + h * 128 + ch * 8); }
#pragma unroll
    for (int k = 0; k < 4; ++k) { const int task = tid + 512 * k, p = task & 63, ch = task >> 6, c0 = 2 * p;
        vr0[k] = *(const GAS v4u*)(V + (size_t)(t0 + c0) * 2048 + h * 256 + ch * 8); vr1[k] = *(const GAS v4u*)(V + (size_t)(t0 + c0 + 1) * 2048 + h * 256 + ch * 8); }
#pragma unroll
    for (int k = 0; k < 2; ++k) { const int task = tid + 512 * k, p = task & 63, ch = task >> 6, c0 = 2 * p;
        const v4u r0 = kr0[k], r1 = kr1[k];
        const float ff0 = __builtin_amdgcn_exp2f((float)(127 - c0) * l2g), ff1 = __builtin_amdgcn_exp2f((float)(126 - c0) * l2g), fb0 = __builtin_amdgcn_exp2f((float)c0 * l2g), fb1 = __builtin_amdgcn_exp2f((float)(c0 + 1) * l2g);
#define KT_ST(E) { const float k0 = bfe<E>(r0), k1 = bfe<E>(r1); *(LAS unsigned*)(KTF + (ch * 8 + E) * 272 + c0 * 2) = pk2(k0 * ff0, k1 * ff1); *(LAS unsigned*)(KTB + (ch * 8 + E) * 272 + c0 * 2) = pk2(k0 * fb0, k1 * fb1); }
        KT_ST(0) KT_ST(1) KT_ST(2) KT_ST(3) KT_ST(4) KT_ST(5) KT_ST(6) KT_ST(7)
#undef KT_ST
    }
#pragma unroll
    for (int k = 0; k < 4; ++k) { const int task = tid + 512 * k, p = task & 63, ch = task >> 6, c0 = 2 * p;
        const v4u r0 = vr0[k], r1 = vr1[k];
#define VT_ST(E) { *(LAS unsigned*)(VT + (ch * 8 + E) * 272 + c0 * 2) = pk2(bfe<E>(r0), bfe<E>(r1)); }
        VT_ST(0) VT_ST(1) VT_ST(2) VT_ST(3) VT_ST(4) VT_ST(5) VT_ST(6) VT_ST(7)
#undef VT_ST
    }
    __syncthreads();
    f32x4 acc[2][8][2];
#pragma unroll
    for (int a = 0; a < 2; ++a)
#pragma unroll
        for (int b = 0; b < 8; ++b)
#pragma unroll
            for (int c = 0; c < 2; ++c) acc[a][b][c] = (f32x4){0.f, 0.f, 0.f, 0.f};
#pragma unroll
    for (int s = 0; s < 4; ++s) { const bf16x8 bv0 = lfrag(VT, 32 * w, s, 272, fr, fq), bv1 = lfrag(VT, 32 * w + 16, s, 272, fr, fq);
#pragma unroll
        for (int dt = 0; dt < 8; ++dt) { const bf16x8 af = lfrag(KTF, 16 * dt, s, 272, fr, fq), ab = lfrag(KTB, 16 * dt, s, 272, fr, fq);
            acc[0][dt][0] = mfma16(af, bv0, acc[0][dt][0]); acc[0][dt][1] = mfma16(af, bv1, acc[0][dt][1]);
            acc[1][dt][0] = mfma16(ab, bv0, acc[1][dt][0]); acc[1][dt][1] = mfma16(ab, bv1, acc[1][dt][1]); } }
#pragma unroll
    for (int dir = 0; dir < 2; ++dir)
#pragma unroll
        for (int dt = 0; dt < 8; ++dt)
#pragma unroll
            for (int et = 0; et < 2; ++et) { const f32x4 a = acc[dir][dt][et]; v2u o; o.x = pk2(a[0], a[1]); o.y = pk2(a[2], a[3]);
                *(GAS v2u*)(KV + ((size_t)(dir * 128 + n) * 8 + h) * 32768 + (32 * w + 16 * et + fr) * 128 + 16 * dt + 4 * fq) = o; }
    __syncthreads();
}

DEV void lrub_all(const Frame& F) {
    const GAS float* AP = (const GAS float*)F.W<float>(WS_LRUC); const GAS float* BE = AP + 2 * 128 * 1024; GAS float* CIN = (GAS float*)F.W<float>(WS_LRUC) + 4 * 128 * 1024;
    for (int idx = F.vcu * 512 + F.tid; idx < 2048; idx += F.G * 512) { const int d = idx >> 10, c = idx & 1023; float s = 0.f;
        for (int it0 = 0; it0 < 128; it0 += 16) { float a[16], b[16];
#pragma unroll
            for (int j = 0; j < 16; ++j) { const int it = it0 + j, n = d ? 127 - it : it, o = (d * 128 + n) * 1024 + c; a[j] = AP[o]; b[j] = BE[o]; }
#pragma unroll
            for (int j = 0; j < 16; ++j) { const int it = it0 + j, n = d ? 127 - it : it, o = (d * 128 + n) * 1024 + c; CIN[o] = s; s = a[j] * s + b[j]; } } }
}
DEV void retb_all(const Frame& F) {
    GAS bf16* KV = (GAS bf16*)F.W<bf16>(WS_KV);
    for (int idx = F.vcu * 512 + F.tid; idx < 131072; idx += F.G * 512) { const int dir = idx >> 16, h = (idx >> 13) & 7, off = (idx & 8191) * 4;
        const float dec = exp2f(128.f * log2f(1.f - exp2f(-5.f - (float)h))); float s0 = 0.f, s1 = 0.f, s2 = 0.f, s3 = 0.f;
        for (int it0 = 0; it0 < 128; it0 += 16) { v2u v[16];
#pragma unroll
            for (int j = 0; j < 16; ++j) { const int it = it0 + j, n = dir ? 127 - it : it; v[j] = *(const GAS v2u*)(KV + ((size_t)(dir * 128 + n) * 8 + h) * 32768 + off); }
#pragma unroll
            for (int j = 0; j < 16; ++j) { const int it = it0 + j, n = dir ? 127 - it : it; v2u o; o.x = pk2(s0, s1); o.y = pk2(s2, s3); *(GAS v2u*)(KV + ((size_t)(dir * 128 + n) * 8 + h) * 32768 + off) = o;
                s0 = dec * s0 + bflo(v[j].x); s1 = dec * s1 + bfhi(v[j].x); s2 = dec * s2 + bflo(v[j].y); s3 = dec * s3 + bfhi(v[j].y); } } }
}
DEV int rev14(int p) { const unsigned r = __builtin_bitreverse32((unsigned)p) >> 18; return (int)(((r & 0x1555u) << 1) | ((r >> 1) & 0x1555u)); }
DEV f32x2 twid(const LAS f32x2* TH, const LAS f32x2* TL, int e) { return cmul(TH[e >> 7], TL[e & 127]); }
constexpr int FFT_IM_OFF = 69632, FFT_TAB_OFF = 139264;
DEV int ppad(int p) { return p + 4 * (p >> 6); }
struct cpx2 { f32x2 r, i; };
DEV cpx2 cmul2(const cpx2 a, const cpx2 b) { cpx2 c; c.r = a.r * b.r - a.i * b.i; c.i = a.r * b.i + a.i * b.r; return c; }
DEV cpx2 cmulc(const cpx2 a, float cr, float ci) { cpx2 c; c.r = a.r * cr - a.i * ci; c.i = a.r * ci + a.i * cr; return c; }
DEV void r4p(cpx2& a0, cpx2& a1, cpx2& a2, cpx2& a3) {
    const f32x2 b0r = a0.r + a2.r, b0i = a0.i + a2.i, b1r = a0.r - a2.r, b1i = a0.i - a2.i, b2r = a1.r + a3.r, b2i = a1.i + a3.i, tr = a1.r - a3.r, ti = a1.i - a3.i;
    a0.r = b0r + b2r; a0.i = b0i + b2i; a1.r = b1r + ti; a1.i = b1i - tr; a2.r = b0r - b2r; a2.i = b0i - b2i; a3.r = b1r - ti; a3.i = b1i + tr;
}
template <bool DIT> DEV void r16_core(cpx2 (&e)[16], const cpx2 w) {
    const cpx2 ww = cmul2(w, w), w4 = cmul2(ww, ww), w8 = cmul2(w4, w4), w12 = cmul2(w8, w4);
    if (DIT) {
#pragma unroll
        for (int p = 0; p < 4; ++p) { e[4 * p + 1] = cmul2(e[4 * p + 1], w4); e[4 * p + 2] = cmul2(e[4 * p + 2], w8); e[4 * p + 3] = cmul2(e[4 * p + 3], w12); r4p(e[4 * p], e[4 * p + 1], e[4 * p + 2], e[4 * p + 3]); }
    }
#pragma unroll
    for (int r = 0; r < 4; ++r) {
        const cpx2 w1 = r == 0 ? w : r == 1 ? cmulc(w, 0.9238795325112867f, -0.3826834323650898f) : r == 2 ? cmulc(w, 0.7071067811865476f, -0.7071067811865476f) : cmulc(w, 0.3826834323650898f, -0.9238795325112867f);
        const cpx2 w2 = cmul2(w1, w1), w3 = cmul2(w2, w1);
        if (DIT) { e[r + 4] = cmul2(e[r + 4], w1); e[r + 8] = cmul2(e[r + 8], w2); e[r + 12] = cmul2(e[r + 12], w3); }
        r4p(e[r], e[r + 4], e[r + 8], e[r + 12]);
        if (!DIT) { e[r + 4] = cmul2(e[r + 4], w1); e[r + 8] = cmul2(e[r + 8], w2); e[r + 12] = cmul2(e[r + 12], w3); }
    }
    if (!DIT) {
#pragma unroll
        for (int p = 0; p < 4; ++p) { r4p(e[4 * p], e[4 * p + 1], e[4 * p + 2], e[4 * p + 3]); e[4 * p + 1] = cmul2(e[4 * p + 1], w4); e[4 * p + 2] = cmul2(e[4 * p + 2], w8); e[4 * p + 3] = cmul2(e[4 * p + 3], w12); }
    }
}
template <bool DIT, int LQ16> DEV void r16_pass(LAS unsigned char* lds, const LAS f32x2* TH, const LAS f32x2* TL, int tid) {
    constexpr int q16 = 1 << LQ16, sp = q16 >= 64 ? q16 + 4 * (q16 >> 6) : q16;
    asm volatile("" : "+v"(tid));
    int g, i;
    if (LQ16 == 10) { g = 0; i = 2 * tid; } else if (LQ16 == 6) { g = tid >> 5; i = 2 * (tid & 31); } else { g = tid >> 1; i = 2 * (tid & 1); }
    const int p0 = ppad((g << (LQ16 + 4)) + i);
    const LAS float* RE = (const LAS float*)lds; const LAS float* IM = (const LAS float*)(lds + FFT_IM_OFF);
    const f32x2 wA = twid(TH, TL, i << (10 - LQ16)), wB = twid(TH, TL, (i + 1) << (10 - LQ16));
    cpx2 w; w.r = (f32x2){wA.x, wB.x}; w.i = (f32x2){wA.y, wB.y};
    cpx2 e[16];
#pragma unroll
    for (int r = 0; r < 16; ++r) { e[r].r = *(const LAS f32x2*)(RE + p0 + r * sp); e[r].i = *(const LAS f32x2*)(IM + p0 + r * sp); }
    r16_core<DIT>(e, w);
#pragma unroll
    for (int r = 0; r < 16; ++r) { *(LAS f32x2*)((LAS float*)RE + p0 + r * sp) = e[r].r; *(LAS f32x2*)((LAS float*)IM + p0 + r * sp) = e[r].i; }
    __syncthreads();
}
DEV void r4_pass(LAS unsigned char* lds, int tid) {
    asm volatile("" : "+v"(tid));
    LAS float* RE = (LAS float*)lds; LAS float* IM = (LAS float*)(lds + FFT_IM_OFF);
#pragma unroll
    for (int hh = 0; hh < 2; ++hh) { f32x4 R[4], I[4];
#pragma unroll
        for (int c = 0; c < 4; ++c) { const int g = tid + 512 * (4 * hh + c), p = 4 * g + 4 * (g >> 4); R[c] = *(const LAS f32x4*)(RE + p); I[c] = *(const LAS f32x4*)(IM + p); }
#pragma unroll
        for (int c = 0; c < 4; ++c) { const int g = tid + 512 * (4 * hh + c), p = 4 * g + 4 * (g >> 4);
            const float b0r = R[c][0] + R[c][2], b0i = I[c][0] + I[c][2], b1r = R[c][0] - R[c][2], b1i = I[c][0] - I[c][2], b2r = R[c][1] + R[c][3], b2i = I[c][1] + I[c][3], tr = R[c][1] - R[c][3], ti = I[c][1] - I[c][3];
            *(LAS f32x4*)(RE + p) = (f32x4){b0r + b2r, b1r + ti, b0r - b2r, b1r - ti}; *(LAS f32x4*)(IM + p) = (f32x4){b0i + b2i, b1i - tr, b0i - b2i, b1i + tr}; } }
    __syncthreads();
}
DEV void fft_dif(LAS unsigned char* lds, const LAS f32x2* TH, const LAS f32x2* TL, int tid) {
    r16_pass<false, 10>(lds, TH, TL, tid); r16_pass<false, 6>(lds, TH, TL, tid); r16_pass<false, 2>(lds, TH, TL, tid); r4_pass(lds, tid);
}
DEV void fft_dit(LAS unsigned char* lds, const LAS f32x2* TH, const LAS f32x2* TL, int tid) {
    r4_pass(lds, tid); r16_pass<true, 2>(lds, TH, TL, tid); r16_pass<true, 6>(lds, TH, TL, tid); r16_pass<true, 10>(lds, TH, TL, tid);
}
DEV f32x2 fb_ld(const LAS unsigned char* lds, int p) { const int q = ppad(p); return (f32x2){((const LAS float*)lds)[q], ((const LAS float*)(lds + FFT_IM_OFF))[q]}; }
DEV void fb_st(LAS unsigned char* lds, int p, const f32x2 v) { const int q = ppad(p); ((LAS float*)lds)[q] = v.x; ((LAS float*)(lds + FFT_IM_OFF))[q] = v.y; }
DEV void hy_pair(const f32x2 Z, const f32x2 Zp, const f32x2 G, const f32x2 Gq, const f32x2 w, f32x2& o0, f32x2& o1) {
    const float invN = 1.0f / 16384.0f;
    const f32x2 Ze = (f32x2){0.5f * (Z.x + Zp.x), 0.5f * (Z.y - Zp.y)}, Zo = (f32x2){0.5f * (Z.y + Zp.y), -0.5f * (Z.x - Zp.x)};
    const f32x2 Ge = (f32x2){0.5f * (G.x + Gq.x), 0.5f * (G.y - Gq.y)}, Go = (f32x2){0.5f * (G.y + Gq.y), -0.5f * (G.x - Gq.x)};
    const f32x2 wZo = cmul(w, Zo), wGo = cmul(w, Go), U = cmul(Ze + wZo, Ge + wGo), V = cmul(Ze - wZo, Ge - wGo);
    const f32x2 Ye = 0.5f * (U + V), Yo = 0.5f * cmul(U - V, (f32x2){w.x, -w.y});
    o0 = (f32x2){(Ye.x - Yo.y) * invN, -(Ye.y + Yo.x) * invN}; o1 = (f32x2){(Ye.x + Yo.y) * invN, (Ye.y - Yo.x) * invN};
}
struct RetbJob { GAS bf16* p; int step; float dec, s0, s1, s2, s3; int left; };
DEV RetbJob retb_begin(const Frame& F) {
    RetbJob j; const int idx = F.vcu * 512 + F.tid; j.left = 0; j.p = (GAS bf16*)F.W<bf16>(WS_KV); j.step = 0; j.dec = 0.f; j.s0 = j.s1 = j.s2 = j.s3 = 0.f;
    if (idx < 131072 && F.G * 512 >= 131072) { const int dir = idx >> 16, h = (idx >> 13) & 7, off = (idx & 8191) * 4;
        j.p += ((size_t)(dir * 128 + (dir ? 127 : 0)) * 8 + h) * 32768 + off; j.step = dir ? -(8 * 32768) : 8 * 32768; j.dec = exp2f(128.f * log2f(1.f - exp2f(-5.f - (float)h))); j.left = 128; }
    return j;
}
template <int NB> DEV void retb_load(const RetbJob& j, v2u (&v)[NB]) {
#pragma unroll
    for (int b = 0; b < NB; ++b) v[b] = *(const GAS v2u*)(j.p + (long)b * j.step);
}
template <int NB> DEV void retb_store(RetbJob& j, const v2u (&v)[NB]) {
#pragma unroll
    for (int b = 0; b < NB; ++b) if (b < j.left) { v2u o; o.x = pk2(j.s0, j.s1); o.y = pk2(j.s2, j.s3); *(GAS v2u*)(j.p + (long)b * j.step) = o;
        j.s0 = j.dec * j.s0 + bflo(v[b].x); j.s1 = j.dec * j.s1 + bfhi(v[b].x); j.s2 = j.dec * j.s2 + bflo(v[b].y); j.s3 = j.dec * j.s3 + bfhi(v[b].y); }
    const int n = j.left < NB ? j.left : NB; j.p += (long)n * j.step; j.left -= n;
}
DEV f32x2 conv_pair(unsigned wp, unsigned wc_, unsigned wn, const f32x4 k) { const float um = bfhi(wp), u0 = bflo(wc_), u1 = bfhi(wc_), u2 = bflo(wn);
    return (f32x2){k[3] + k[0] * um + k[1] * u0 + k[2] * u1, k[3] + k[0] * u0 + k[1] * u1 + k[2] * u2}; }
#define HY_LD3(rowp, wp, wc_, wn) do { _Pragma("unroll") for (int i = 0; i < 16; ++i) { const int m = tid + 512 * i, mp = m > 0 ? m - 1 : 0, mn = m < 8191 ? m + 1 : 8191;     \
    wc_[i] = *(const GAS unsigned*)((rowp) + 2 * m); wp[i] = *(const GAS unsigned*)((rowp) + 2 * mp); wn[i] = *(const GAS unsigned*)((rowp) + 2 * mn); } \
    _Pragma("unroll") for (int i = 0; i < 16; ++i) { const int m = tid + 512 * i; wp[i] = m > 0 ? wp[i] : 0u; wn[i] = m < 8191 ? wn[i] : 0u; } } while (0)
DEV void hyena_unit(const Frame& F, int l, int c, RetbJob& job) {
    int tid = F.tid; asm volatile("" : "+v"(tid));
    LAS unsigned char* FB = F.lds; LAS f32x2* TH = (LAS f32x2*)(F.lds + FFT_TAB_OFF); LAS f32x2* TL = TH + 128; LAS f32x2* T2H = TL + 128; LAS f32x2* T2L = T2H + 128;
    const bf16* FILT = F.W<bf16>(WS_MIX); const bf16* HYT = F.W<bf16>(WS_HYT); bf16* HYO = F.W<bf16>(WS_HYO);
    const bf16* zv = HYT + (size_t)c * M;
    f32x4 kz, kg0, kg1;
    { const GAS float* cw = (const GAS float*)F.I(11) + l * 3 * 3072; const GAS float* cb = (const GAS float*)F.I(12) + l * 3072;
      kz = (f32x4){cw[c], cw[3072 + c], cw[6144 + c], cb[c]}; kg0 = (f32x4){cw[1024 + c], cw[3072 + 1024 + c], cw[6144 + 1024 + c], cb[1024 + c]}; kg1 = (f32x4){cw[2048 + c], cw[3072 + 2048 + c], cw[6144 + 2048 + c], cb[2048 + c]}; }
    f32x2 Gk[16], Gq[16], Gmid;
    f32x2* Z1 = F.W<f32x2>(WS_GSCR + (size_t)blockIdx.x * 384 * 1024);
#pragma unroll
    for (int o = 0; o < 2; ++o) {
        const bf16* hf = FILT + (size_t)((2 * o) * 1024 + c) * M; const bf16* hb = FILT + (size_t)((2 * o + 1) * 1024 + c) * M;
        { unsigned wl[16]; unsigned short ha[16], hc[16]; const float hb0 = bf2f(((const GAS bf16*)hb)[0]);
#pragma unroll
          for (int i = 0; i < 16; ++i) { const int m = tid + 512 * i; wl[i] = *(const GAS unsigned*)(hf + 2 * m); ha[i] = ((const GAS bf16*)hb)[m ? 16384 - 2 * m : 0]; hc[i] = ((const GAS bf16*)hb)[16383 - 2 * m]; }
#pragma unroll
          for (int i = 0; i < 16; ++i) { const int m = tid + 512 * i; f32x2 v = (f32x2){bflo(wl[i]), bfhi(wl[i])}; if (m == 0) v.x += hb0; fb_st(FB, m, v);
              fb_st(FB, 8192 + m, (f32x2){m ? bf2f(ha[i]) : 0.f, bf2f(hc[i])}); } }
        __syncthreads();
        { v2u jv[8]; retb_load<8>(job, jv); fft_dif(FB, TH, TL, tid); retb_store<8>(job, jv); }
        asm volatile("" : "+v"(tid));
#pragma unroll
        for (int i = 0; i < 16; ++i) { const int q = 4 * (tid >> 1) + (tid & 1) + 1024 * i, k = rev14(q); Gk[i] = fb_ld(FB, q); Gq[i] = fb_ld(FB, rev14((16384 - k) & 16383)); }
        Gmid = fb_ld(FB, rev14(8192));
        __syncthreads();
        asm volatile("" : "+v"(tid));
        if (o == 0) { unsigned wp[16], wz[16], wn[16]; HY_LD3(zv, wp, wz, wn);
#pragma unroll
            for (int i = 0; i < 16; ++i) { const int m = tid + 512 * i; fb_st(FB, m, conv_pair(wp[i], wz[i], wn[i], kz)); fb_st(FB, 8192 + m, (f32x2){0.f, 0.f}); } }
        else { f32x2 zz[16];
#pragma unroll
            for (int i = 0; i < 16; ++i) zz[i] = ((const GAS f32x2*)Z1)[tid + 512 * i];
#pragma unroll
            for (int i = 0; i < 16; ++i) { const int m = tid + 512 * i; fb_st(FB, m, zz[i]); fb_st(FB, 8192 + m, (f32x2){0.f, 0.f}); } }
        __syncthreads();
        fft_dif(FB, TH, TL, tid);
        asm volatile("" : "+v"(tid));
        {
#pragma unroll
          for (int hb_ = 0; hb_ < 2; ++hb_) { asm volatile("" : "+v"(tid)); f32x2 Z[8], Zp[8]; int kk[8], fpp[8];
#pragma unroll
              for (int ii = 0; ii < 8; ++ii) { const int q = 4 * (tid >> 1) + (tid & 1) + 1024 * (8 * hb_ + ii); kk[ii] = rev14(q); fpp[ii] = rev14((16384 - kk[ii]) & 16383); Z[ii] = fb_ld(FB, q); Zp[ii] = fb_ld(FB, fpp[ii]); }
#pragma unroll
              for (int ii = 0; ii < 8; ++ii) { const int i = 8 * hb_ + ii, q = 4 * (tid >> 1) + (tid & 1) + 1024 * i; const f32x2 w = cmul(T2H[kk[ii] >> 7], T2L[kk[ii] & 127]); f32x2 o0, o1;
                  hy_pair(Z[ii], Zp[ii], Gk[i], Gq[i], w, o0, o1); fb_st(FB, q, o0); fb_st(FB, fpp[ii], o1); } }
          if (tid == 0) { const int fm = rev14(8192); const f32x2 Zm = fb_ld(FB, fm); f32x2 o0, o1; hy_pair(Zm, Zm, Gmid, Gmid, (f32x2){0.f, -1.f}, o0, o1); fb_st(FB, fm, o0); } }
        __syncthreads();
        { v2u jv[8]; retb_load<8>(job, jv); fft_dit(FB, TH, TL, tid); retb_store<8>(job, jv); }
        asm volatile("" : "+v"(tid));
        if (o == 0) { const bf16* g0 = HYT + (size_t)(1024 + c) * M; const float sk = ((const GAS float*)F.I(20))[l * 2048 + c]; f32x2 zc[16];
            { unsigned wp[16], wz[16], wn[16]; HY_LD3(zv, wp, wz, wn);
#pragma unroll
              for (int i = 0; i < 16; ++i) zc[i] = conv_pair(wp[i], wz[i], wn[i], kz); }
            { unsigned wp[16], wg[16], wn[16]; HY_LD3(g0, wp, wg, wn);
#pragma unroll
              for (int i = 0; i < 16; ++i) { const f32x2 y = fb_ld(FB, tid + 512 * i), gg = conv_pair(wp[i], wg[i], wn[i], kg0); ((GAS f32x2*)Z1)[tid + 512 * i] = (f32x2){gg.x * (y.x + sk * zc[i].x), gg.y * (-y.y + sk * zc[i].y)}; } } }
        else { const bf16* g1 = HYT + (size_t)(2048 + c) * M; const float sk = ((const GAS float*)F.I(20))[l * 2048 + 1024 + c]; unsigned wp[16], wg[16], wn[16]; f32x2 zz[16]; HY_LD3(g1, wp, wg, wn);
#pragma unroll
            for (int i = 0; i < 16; ++i) zz[i] = ((const GAS f32x2*)Z1)[tid + 512 * i];
#pragma unroll
            for (int i = 0; i < 16; ++i) { const f32x2 y = fb_ld(FB, tid + 512 * i), gg = conv_pair(wp[i], wg[i], wn[i], kg1);
                *(GAS unsigned*)(HYO + (size_t)c * M + 2 * (tid + 512 * i)) = pk2(gg.x * (y.x + sk * zz[i].x), gg.y * (-y.y + sk * zz[i].y)); } }
        __syncthreads();
    }
}
DEV void retc_unit(const Frame& F, int l, int n, int h) {
    int tid = F.tid; asm volatile("" : "+v"(tid)); const int t0 = n * 128, lane = tid & 63, w = F.wave, fr = lane & 15, fq = lane >> 4;
    LAS unsigned char* QS = F.lds; LAS unsigned char* KS = F.lds + 34816; LAS unsigned char* BIG = F.lds + 69632;
    const bf16* Qr = F.W<bf16>(WS_PROJ + 160 * MiB); const bf16* Kr = F.W<bf16>(WS_PROJ + 192 * MiB); const bf16* V = F.W<bf16>(WS_PROJ + 224 * MiB);
    const bf16* Gs = F.W<bf16>(WS_PROJ + 288 * MiB); const bf16* KV = F.W<bf16>(WS_KV); bf16* MIX = F.W<bf16>(WS_MIX);
    const float l2g = log2f(1.f - exp2f(-5.f - (float)h));
    { v4u qv[4], kv[4], vr0[4], vr1[4];
#pragma unroll
    for (int k = 0; k < 4; ++k) { const int task = tid + 512 * k, r = task >> 4, ch = task & 15;
        qv[k] = *(const GAS v4u*)(Qr + (size_t)(t0 + r) * 1024 + h * 128 + ch * 8); kv[k] = *(const GAS v4u*)(Kr + (size_t)(t0 + r) * 1024 + h * 128 + ch * 8); }
#pragma unroll
    for (int k = 0; k < 4; ++k) { const int task = tid + 512 * k, p = task & 63, ch = task >> 6, c0 = 2 * p;
        vr0[k] = *(const GAS v4u*)(V + (size_t)(t0 + c0) * 2048 + h * 256 + ch * 8); vr1[k] = *(const GAS v4u*)(V + (size_t)(t0 + c0 + 1) * 2048 + h * 256 + ch * 8); }
#pragma unroll
    for (int k = 0; k < 4; ++k) { const int task = tid + 512 * k, r = task >> 4, ch = task & 15; *(LAS v4u*)(QS + r * 272 + ch * 16) = qv[k]; *(LAS v4u*)(KS + r * 272 + ch * 16) = kv[k]; }
#pragma unroll
    for (int k = 0; k < 4; ++k) { const int task = tid + 512 * k, p = task & 63, ch = task >> 6, c0 = 2 * p;
        const v4u r0 = vr0[k], r1 = vr1[k];
#define VT_ST(E) { *(LAS unsigned*)(BIG + (ch * 8 + E) * 272 + c0 * 2) = pk2(bfe<E>(r0), bfe<E>(r1)); }
        VT_ST(0) VT_ST(1) VT_ST(2) VT_ST(3) VT_ST(4) VT_ST(5) VT_ST(6) VT_ST(7)
#undef VT_ST
    } }
    __syncthreads();
    v4u sv[8];
    { const bf16* st = KV + ((size_t)(0 * 128 + n) * 8 + h) * 32768;
#pragma unroll
      for (int k = 0; k < 8; ++k) { const int task = tid + 512 * k, r = task >> 4, ch = task & 15; sv[k] = *(const GAS v4u*)(st + r * 128 + ch * 8); } }
    bf16x8 aq[4];
#pragma unroll
    for (int s = 0; s < 4; ++s) aq[s] = lfrag(QS, 16 * w, s, 272, fr, fq);
    f32x4 S[8];
#pragma unroll
    for (int jt = 0; jt < 8; ++jt) { S[jt] = (f32x4){0.f, 0.f, 0.f, 0.f};
#pragma unroll
        for (int s = 0; s < 4; ++s) S[jt] = mfma16(aq[s], lfrag(KS, 16 * jt, s, 272, fr, fq), S[jt]);
#pragma unroll
        for (int e = 0; e < 4; ++e) { const int i = 16 * w + 4 * fq + e, j = 16 * jt + fr; S[jt][e] *= __builtin_amdgcn_exp2f(l2g * fabsf((float)(i - j))); } }
    __syncthreads();
#pragma unroll
    for (int jt = 0; jt < 8; ++jt)
#pragma unroll
        for (int e = 0; e < 4; ++e) *(LAS bf16*)(KS + (16 * w + 4 * fq + e) * 272 + (16 * jt + fr) * 2) = f2bf(S[jt][e]);
    LDS_WAIT();
    __syncthreads();
    f32x4 y[16];
    { bf16x8 ap[4];
#pragma unroll
      for (int s = 0; s < 4; ++s) ap[s] = lfrag(KS, 16 * w, s, 272, fr, fq);
#pragma unroll
      for (int et = 0; et < 16; ++et) { y[et] = (f32x4){0.f, 0.f, 0.f, 0.f};
#pragma unroll
          for (int s = 0; s < 4; ++s) y[et] = mfma16(ap[s], lfrag(BIG, 16 * et, s, 272, fr, fq), y[et]);
          __builtin_amdgcn_sched_barrier(0); } }
    __syncthreads();
    const float* gn = F.I(22) + l * 2048 + h * 256;
    v4u gvv[8];
#pragma unroll
    for (int dir = 0; dir < 2; ++dir) {
#pragma unroll
        for (int k = 0; k < 8; ++k) { const int task = tid + 512 * k, r = task >> 4, ch = task & 15; *(LAS v4u*)(BIG + r * 272 + ch * 16) = sv[k]; }
        if (dir == 0) { const bf16* st = KV + ((size_t)(1 * 128 + n) * 8 + h) * 32768;
#pragma unroll
            for (int k = 0; k < 8; ++k) { const int task = tid + 512 * k, r = task >> 4, ch = task & 15; sv[k] = *(const GAS v4u*)(st + r * 128 + ch * 8); } }
        else {
#pragma unroll
            for (int k = 0; k < 8; ++k) { const int task = tid + 512 * k, t = task >> 5, ch = task & 31; gvv[k] = *(const GAS v4u*)(Gs + (size_t)(t0 + t) * 2048 + h * 256 + ch * 8); } }
        __syncthreads();
        float fac[4];
#pragma unroll
        for (int e = 0; e < 4; ++e) { const int i = 16 * w + 4 * fq + e; fac[e] = __builtin_amdgcn_exp2f(l2g * (dir == 0 ? (float)(i + 1) : (float)(128 - i))); }
#pragma unroll
        for (int et = 0; et < 16; ++et) { f32x4 t = (f32x4){0.f, 0.f, 0.f, 0.f};
#pragma unroll
            for (int s = 0; s < 4; ++s) t = mfma16(aq[s], lfrag(BIG, 16 * et, s, 272, fr, fq), t);
#pragma unroll
            for (int e = 0; e < 4; ++e) y[et][e] += fac[e] * t[e];
            __builtin_amdgcn_sched_barrier(0); }
        __syncthreads();
    }
    float rinv[4];
#pragma unroll
    for (int e = 0; e < 4; ++e) { float ss = 0.f;
#pragma unroll
        for (int et = 0; et < 16; ++et) ss += y[et][e] * y[et][e];
        ss += shx(ss, 1, lane); ss += shx(ss, 2, lane); ss += shx(ss, 4, lane); ss += shx(ss, 8, lane); rinv[e] = rsqrtf(ss * (1.f / 256.f) + EPS); }
#pragma unroll
    for (int et = 0; et < 16; ++et)
#pragma unroll
        for (int e = 0; e < 4; ++e) *(LAS bf16*)(BIG + (16 * w + 4 * fq + e) * 528 + (16 * et + fr) * 2) = f2bf(y[et][e] * rinv[e]);
    __syncthreads();
    const f32x4 g0 = *(const GAS f32x4*)(gn + (tid & 31) * 8), g1 = *(const GAS f32x4*)(gn + (tid & 31) * 8 + 4);
#pragma unroll
    for (int k = 0; k < 8; ++k) { const int task = tid + 512 * k, t = task >> 5, ch = task & 31;
        const v4u yv = *(const LAS v4u*)(BIG + t * 528 + ch * 16); const v4u gv = gvv[k];
        v4u o; o.x = pk2(bflo(yv.x) * g0[0] * bflo(gv.x), bfhi(yv.x) * g0[1] * bfhi(gv.x)); o.y = pk2(bflo(yv.y) * g0[2] * bflo(gv.y), bfhi(yv.y) * g0[3] * bfhi(gv.y));
        o.z = pk2(bflo(yv.z) * g1[0] * bflo(gv.z), bfhi(yv.z) * g1[1] * bfhi(gv.z)); o.w = pk2(bflo(yv.w) * g1[2] * bflo(gv.w), bfhi(yv.w) * g1[3] * bfhi(gv.w));
        *(GAS v4u*)(MIX + (size_t)(t0 + t) * 4096 + 2048 + h * 256 + ch * 8) = o; }
}
DEV void hyn_unit(const Frame& F, int l, int unit) {
    int tid = F.tid; asm volatile("" : "+v"(tid)); const int g = unit >> 7, t0 = (unit & 127) * 128;
    LAS float* S = (LAS float*)F.lds; LAS float* RED = S + 128 * 129;
    const bf16* HYO = F.W<bf16>(WS_HYO); bf16* MIX = F.W<bf16>(WS_MIX);
    v4u hv[4];
#pragma unroll
    for (int k = 0; k < 4; ++k) { const int task = tid + 512 * k, cc = task >> 4, ch = task & 15; hv[k] = *(const GAS v4u*)(HYO + (size_t)(128 * g + cc) * M + t0 + ch * 8); }
#pragma unroll
    for (int k = 0; k < 4; ++k) { const int task = tid + 512 * k, cc = task >> 4, ch = task & 15; const v4u v = hv[k];
        LAS float* d = S + cc * 129 + ch * 8; d[0] = bflo(v.x); d[1] = bfhi(v.x); d[2] = bflo(v.y); d[3] = bfhi(v.y); d[4] = bflo(v.z); d[5] = bfhi(v.z); d[6] = bflo(v.w); d[7] = bfhi(v.w); }
    __syncthreads();
    { const int t = tid & 127, part = tid >> 7; float ss = 0.f;
#pragma unroll 8
      for (int cc = 0; cc < 32; ++cc) { const float v = S[(32 * part + cc) * 129 + t]; ss += v * v; }
      RED[part * 128 + t] = ss; }
    __syncthreads();
    const float* gn = F.I(21) + l * 1024 + 128 * g;
    for (int task = tid; task < 2048; task += 512) { const int t = task >> 4, ch = task & 15;
        const float rinv = rsqrtf((RED[t] + RED[128 + t] + RED[256 + t] + RED[384 + t]) * (1.f / 128.f) + EPS); float y[8];
#pragma unroll
        for (int e = 0; e < 8; ++e) y[e] = S[(8 * ch + e) * 129 + t] * rinv * gn[8 * ch + e];
        v4u o; o.x = pk2(y[0], y[1]); o.y = pk2(y[2], y[3]); o.z = pk2(y[4], y[5]); o.w = pk2(y[6], y[7]);
        *(GAS v4u*)(MIX + (size_t)(t0 + t) * 4096 + 1024 + 128 * g + 8 * ch) = o; }
    __syncthreads();
}
DEV void final_norm(const Frame& F) {
    const ssq_t* ssq = F.W<ssq_t>(CTL_SSQ_OFF) + 4 * M; const float* gn = F.I(28); const bf16* xb = F.W<bf16>(WS_XB); const int gw = F.vcu * 8 + F.wave, NGW = F.G * 8, lane = F.lane;
    for (int m = gw; m < M; m += NGW) { const float rs = rstd_of(ssq, m); GAS f32x4* xo = (GAS f32x4*)(F.O() + (size_t)m * D) + lane; const GAS v2u* xi = (const GAS v2u*)(xb + (size_t)m * D) + lane; const GAS f32x4* gr = (const GAS f32x4*)gn + lane;
#pragma unroll
        for (int j = 0; j < 16; ++j) { const v2u v = xi[64 * j]; const f32x4 g = gr[64 * j]; xo[64 * j] = (f32x4){bflo(v.x) * rs * g[0], bfhi(v.x) * rs * g[1], bflo(v.y) * rs * g[2], bfhi(v.y) * rs * g[3]}; } }
}

DEV int bidx() { int c = (int)blockIdx.x; asm volatile("" : "+s"(c)); return c; }
DEV bool in_phase(int lo, int hi, int k) { asm volatile("" : "+s"(lo), "+s"(hi)); return lo <= k && k < hi; }
__global__ void __launch_bounds__(512, 2) fwd_kernel(Args args) {
    extern __shared__ __attribute__((aligned(16))) unsigned char lds_raw[];
    Frame F; F.lds = (LAS unsigned char*)lds_raw; F.tid = threadIdx.x; F.lane = F.tid & 63; F.wave = __builtin_amdgcn_readfirstlane(F.tid >> 6);
    F.G = gridDim.x; { const int bx = blockIdx.x; F.vcu = (F.G % 8 == 0) ? (bx % 8) * (F.G / 8) + bx / 8 : bx; }
    F.in = args.in; F.out = args.out; F.ws = args.ws;
    volatile LAS unsigned* MISC = (volatile LAS unsigned*)(F.lds + MISC_OFF);
    if (F.tid < 64) MISC[F.tid] = 0u;
    __syncthreads();
    const int lo = args.ph_lo, hi = args.ph_hi;
    unsigned* barw = F.W<unsigned>(WS_CTL) + CW_BAR;
    XcdBarrier bar; bar.bar = barw; bar.x = 0; bar.st = nullptr;
    if (hi - lo > 1) bar = xcd_barrier_post(barw, MISC + 8);
#ifndef G3_ALIGN
#define G3_ALIGN GEMM_ALIGN
#endif
#ifndef GEMM_ALIGN
#define GEMM_ALIGN true
#endif
#ifndef GEMM_SP2
#define GEMM_SP2 true
#endif
#ifndef REP_P0
#define REP_P0 1
#endif
#ifndef REP_G1
#define REP_G1 1
#endif
#ifndef REP_MA
#define REP_MA 1
#endif
#ifndef REP_HY
#define REP_HY 1
#endif
#ifndef REP_MC
#define REP_MC 1
#endif
#ifndef REP_G3
#define REP_G3 1
#endif
#ifndef REP_HYT
#define REP_HYT 1
#endif
#ifndef REP_HYF
#define REP_HYF 1
#endif
#ifndef REP_LRUA
#define REP_LRUA 1
#endif
#ifndef REP_RETA
#define REP_RETA 1
#endif
#ifndef REP_LRUC
#define REP_LRUC 1
#endif
#ifndef REP_RETC
#define REP_RETC 1
#endif
#ifndef REP_HYN
#define REP_HYN 1
#endif
#ifndef PHASE_EN
#define PHASE_EN 0xffffffffu
#endif
#define EN(b) ((PHASE_EN >> (b)) & 1u)
#define IN(k) in_phase(lo, hi, (k))
#define SEAM(k) do { if (IN(k) && IN((k) + 1)) { asm volatile("" : "+s"(bar.bar)); xcd_barrier(bar, F.tid == 0); } FENCE(); } while (0)
#define FENCE() do { asm volatile("" : "+s"(F.ws), "+s"(F.out)); asm volatile("" : "+s"(F.G)); int ln_; asm volatile("v_mbcnt_lo_u32_b32 %0, -1, 0\n\tv_mbcnt_hi_u32_b32 %0, -1, %0" : "=v"(ln_)); F.lane = ln_; F.tid = F.wave * 64 + ln_; } while (0)
    FENCE();
    if (EN(0) && IN(0)) { for (int rep = 0; rep < REP_P0; ++rep) p0_prologue(F, rep); }
    SEAM(0);
    for (int l = 0; l < NLAYER; ++l) {
        const int pb = 1 + 7 * l;
        if (EN(1) && IN(pb + 0)) for (int rep = 0; rep < REP_G1; ++rep) {
            bf16* XB = F.W<bf16>(WS_XB); bf16* PR = F.W<bf16>(WS_PROJ);
            pg8::Gemm g{XB, F.W<bf16>(WS_WIN + (size_t)l * 88 * MiB), M, NIN, D};
            struct SkipHu : pg8::StaticOrder { DEV bool next(int i, pg8::Unit& u) const { const bool ok = pg8::StaticOrder::next(i, u); if (u.pn >= 8) u.pn += 12; return ok; } };
            SkipHu S; S.init(M, NIN - 3072, F.G, bidx());
            EpiIn E{PR, F.W<bf16>(WS_PROJ + 32 * MiB), F.W<bf16>(WS_PROJ + 64 * MiB), F.W<bf16>(WS_PROJ + 160 * MiB), F.W<bf16>(WS_PROJ + 192 * MiB), F.W<bf16>(WS_PROJ + 224 * MiB), F.W<bf16>(WS_PROJ + 288 * MiB),
                    F.W<ssq_t>(CTL_SSQ_OFF) + (2 * l) * M, F.W<float>(WS_ROT)};
            pg8::gemm_phase<EpiIn, SkipHu, GEMM_ALIGN, GEMM_SP2>(F.lds, g, S, E, F.tid);
            pg8::Gemm g2{F.W<bf16>(WS_WIN + (size_t)l * 88 * MiB) + (size_t)2048 * D, XB, 3072, M, D}; pg8::StaticOrder S2; S2.init(3072, M, F.G, bidx());
            EpiHuT E2{F.W<bf16>(WS_HYT), F.W<ssq_t>(CTL_SSQ_OFF) + (2 * l) * M};
            pg8::gemm_phase<EpiHuT, pg8::StaticOrder, GEMM_ALIGN, GEMM_SP2>(F.lds, g2, S2, E2, F.tid);
        }
        SEAM(pb + 0);
        if (IN(pb + 1)) for (int rep = 0; rep < REP_MA; ++rep) {
            if (I8_GU(l)) wq_rows(F, l);
            if (EN(3)) for (int r2 = 0; r2 < REP_HYF; ++r2) for (int it = F.vcu * 8 + F.wave; it < 2048; it += F.G * 8) hyf_item(F, l, it);
            __syncthreads();
            if (EN(4)) for (int r2 = 0; r2 < REP_LRUA; ++r2) for (int u = F.vcu; u < 1024; u += F.G) lru_unit<false>(F, l, u >> 3, u & 7);
            if (EN(5)) for (int r2 = 0; r2 < REP_RETA; ++r2) for (int u = F.vcu; u < 1024; u += F.G) reta_unit(F, u >> 3, u & 7);
        }
        SEAM(pb + 1);
        if (IN(pb + 2)) {
            if (EN(6)) { lrub_all(F); if (F.G * 512 < 131072) retb_all(F); }
            RetbJob job = retb_begin(F);
            FENCE();
            { LAS f32x2* TH = (LAS f32x2*)(F.lds + FFT_TAB_OFF);
              if (F.tid < 128) { const float j = (float)F.tid; TH[F.tid] = (f32x2){cospif(j * (1.f / 64.f)), -sinpif(j * (1.f / 64.f))}; TH[128 + F.tid] = (f32x2){cospif(j * (1.f / 8192.f)), -sinpif(j * (1.f / 8192.f))};
                  TH[256 + F.tid] = (f32x2){cospif(j * (1.f / 128.f)), -sinpif(j * (1.f / 128.f))}; TH[384 + F.tid] = (f32x2){cospif(j * (1.f / 16384.f)), -sinpif(j * (1.f / 16384.f))}; }
              __syncthreads(); }
            if (EN(7)) for (int rep = 0; rep < REP_HY; ++rep) for (int u = F.vcu; u < 1024; u += F.G) hyena_unit(F, l, u, job);
            while (job.left > 0) { v2u jv[8]; retb_load<8>(job, jv); retb_store<8>(job, jv); }
        }
        SEAM(pb + 2);
        if (IN(pb + 3)) for (int rep = 0; rep < REP_MC; ++rep) {
            if (EN(8)) for (int r2 = 0; r2 < REP_LRUC; ++r2) for (int u = F.vcu; u < 1024; u += F.G) lru_unit<true>(F, l, u >> 3, u & 7);
            if (EN(9)) for (int r2 = 0; r2 < REP_RETC; ++r2) for (int u = F.vcu; u < 1024; u += F.G) { retc_unit(F, l, u >> 3, u & 7); __syncthreads(); }
            if (EN(10)) for (int r2 = 0; r2 < REP_HYN; ++r2) for (int u = F.vcu; u < 1024; u += F.G) hyn_unit(F, l, u);
        }
        SEAM(pb + 3);
        if (EN(11) && IN(pb + 4)) {
            bf16* XB = F.W<bf16>(WS_XB); bf16* MIX = F.W<bf16>(WS_MIX);
            pg8::Gemm g{MIX, F.W<bf16>(WS_WOUT + (size_t)l * 32 * MiB), M, D, D}; pg8::StaticOrder S; S.init(M, D, F.G, bidx());
            EpiRes E{XB, F.W<ssq_t>(CTL_SSQ_OFF) + (2 * l + 1) * M, 1.f, I8_GU(l) ? F.W<unsigned char>(WS_KV) : nullptr, F.W<ssq_t>(CTL_SSQ_OFF) + (2 * l) * M};
            pg8::gemm_phase<EpiRes, pg8::StaticOrder, GEMM_ALIGN, GEMM_SP2>(F.lds, g, S, E, F.tid);
        }
        SEAM(pb + 4);
        if (EN(12) && IN(pb + 5)) for (int rep = 0; rep < REP_G3; ++rep) {
            bf16* XB = F.W<bf16>(WS_XB); bf16* PR = F.W<bf16>(WS_PROJ);
            pg8::StaticOrder S; S.init(M, NGU, F.G, bidx());
            if (I8_GU(l)) {
                pg8::Gemm g{F.W<bf16>(WS_KV), F.W<bf16>(WS_WGU + (size_t)l * 172 * MiB), M, NGU, D / 2, D / 2, D};
                EpiGU_<2> E{(unsigned char*)PR, F.W<ssq_t>(CTL_SSQ_OFF) + (2 * l + 1) * M, FP8_DOWN(l), F.W<ssq_t>(CTL_SSQ_OFF) + (2 * l) * M, F.W<unsigned>(CTL_AMAX_OFF) + l * NGU};
                pg8::gemm_phase<EpiGU_<2>, pg8::StaticOrder, G3_ALIGN, GEMM_SP2, 2>(F.lds, g, S, E, F.tid);
            } else {
                pg8::Gemm g{XB, F.W<bf16>(WS_WGU + (size_t)l * 172 * MiB), M, NGU, D};
                EpiGU E{(unsigned char*)PR, F.W<ssq_t>(CTL_SSQ_OFF) + (2 * l + 1) * M, FP8_DOWN(l), nullptr, nullptr};
                pg8::gemm_phase<EpiGU, pg8::StaticOrder, GEMM_ALIGN, GEMM_SP2>(F.lds, g, S, E, F.tid);
            }
        }
        SEAM(pb + 5);
        if (EN(13) && IN(pb + 6)) {
            bf16* XB = F.W<bf16>(WS_XB); bf16* PR = F.W<bf16>(WS_PROJ);
            struct RevM : pg8::StaticOrder { DEV bool next(int i, pg8::Unit& u) const { const bool ok = pg8::StaticOrder::next(i, u); u.pm = nM - 1 - u.pm; return ok; } };
            RevM S; S.init(M, D, F.G, bidx());
            if (FP8_DOWN(l)) {
                pg8::Gemm g{PR, F.W<bf16>(WS_WDN + (size_t)l * 86 * MiB), M, D, DFF / 2}; EpiRes E{XB, F.W<ssq_t>(CTL_SSQ_OFF) + (2 * l + 2) * M, 1.f / 8192.f, nullptr, nullptr};
                pg8::gemm_phase<EpiRes, RevM, GEMM_ALIGN, GEMM_SP2, 1>(F.lds, g, S, E, F.tid);
            } else {
                pg8::Gemm g{PR, F.W<bf16>(WS_WDN + (size_t)l * 86 * MiB), M, D, DFF}; EpiRes E{XB, F.W<ssq_t>(CTL_SSQ_OFF) + (2 * l + 2) * M, 1.f, nullptr, nullptr};
                pg8::gemm_phase<EpiRes, RevM, GEMM_ALIGN, GEMM_SP2>(F.lds, g, S, E, F.tid);
            }
        }
        SEAM(pb + 6);
    }
    if (EN(14) && IN(15)) final_norm(F);
#undef IN
#undef SEAM
}

#ifndef MK_PER_PHASE
#define MK_PER_PHASE 0
#endif
extern "C" void kernel_launch(void* const* d_in, const int* in_sizes, int n_in, void* d_out, int out_size, void* d_ws, size_t ws_size, hipStream_t stream) {
    static int grid = 0;
    if (grid == 0) {
        if (n_in != 29 || in_sizes[0] != M * D || out_size != M * D || ws_size < WS_END) { fprintf(stderr, "kernel_launch: unexpected shapes / workspace (n_in %d, ws %zu < %zu); nothing launched\n", n_in, ws_size, (size_t)WS_END); grid = -1; return; }
        int dev = 0, cus = 0, per_cu = 0;
        if (hipGetDevice(&dev) != hipSuccess || hipDeviceGetAttribute(&cus, hipDeviceAttributeMultiprocessorCount, dev) != hipSuccess) { grid = -1; return; }
        if (hipFuncSetAttribute((const void*)fwd_kernel, hipFuncAttributeMaxDynamicSharedMemorySize, LDS_BYTES) != hipSuccess) { fprintf(stderr, "kernel_launch: hipFuncSetAttribute failed\n"); grid = -1; return; }
        if (hipOccupancyMaxActiveBlocksPerMultiprocessor(&per_cu, (const void*)fwd_kernel, 512, LDS_BYTES) != hipSuccess || per_cu < 1) { fprintf(stderr, "kernel_launch: occupancy query says %d blocks per CU\n", per_cu); }
        (void)hipGetLastError();
        grid = cus;
    }
    if (grid < 0) return;
    if (hipMemsetAsync((char*)d_ws + WS_CTL, 0, CTL_BYTES, stream) != hipSuccess) return;
    Args a{};
    for (int i = 0; i < 29; ++i) a.in[i] = (const float*)d_in[i];
    a.out = (float*)d_out; a.ws = (unsigned char*)d_ws;
#if MK_PER_PHASE
    for (int p = 0; p < NPH; ++p) { a.ph_lo = p; a.ph_hi = p + 1; hipLaunchKernelGGL(fwd_kernel, dim3(grid), dim3(512), LDS_BYTES, stream, a); }
#else
    a.ph_lo = 0; a.ph_hi = NPH; hipLaunchKernelGGL(fwd_kernel, dim3(grid), dim3(512), LDS_BYTES, stream, a);
#endif
}
```

```cpp
#include <hip/hip_runtime.h>
#include <cstdio>
#include <cstdint>

#define DEV __device__ __forceinline__
#define GAS __attribute__((address_space(1)))
#define LAS __attribute__((address_space(3)))
typedef unsigned short bf16;
typedef unsigned v4u __attribute__((ext_vector_type(4)));
typedef unsigned v2u __attribute__((ext_vector_type(2)));
typedef float f32x4 __attribute__((ext_vector_type(4)));
typedef float f32x2 __attribute__((ext_vector_type(2)));
typedef short bf16x8 __attribute__((ext_vector_type(8)));
typedef int v8i __attribute__((ext_vector_type(8)));
typedef int v4i __attribute__((ext_vector_type(4)));

constexpr int M = 16384, D = 4096, DL = 1024, DH = 1024, DR = 2048, NIN = 11264, DFF = 11008, NGU = 22016, NLAYER = 2;
constexpr float EPS = 1e-6f;

DEV float bflo(unsigned w) { return __uint_as_float(w << 16); }
DEV float bfhi(unsigned w) { return __uint_as_float(w & 0xffff0000u); }
DEV float bf2f(bf16 v) { return __uint_as_float(((unsigned)v) << 16); }
DEV unsigned pk2(float lo, float hi) { unsigned r; asm volatile("v_cvt_pk_bf16_f32 %0, %1, %2" : "=v"(r) : "v"(lo), "v"(hi)); return r; }
DEV unsigned pk4_fp8(float a, float b, float c, float d) {
    a = __builtin_amdgcn_fmed3f(a, -448.f, 448.f); b = __builtin_amdgcn_fmed3f(b, -448.f, 448.f); c = __builtin_amdgcn_fmed3f(c, -448.f, 448.f); d = __builtin_amdgcn_fmed3f(d, -448.f, 448.f);
    int w = 0; w = __builtin_amdgcn_cvt_pk_fp8_f32(a, b, w, false); w = __builtin_amdgcn_cvt_pk_fp8_f32(c, d, w, true); return (unsigned)w; }
DEV unsigned pk4_i8(float a, float b, float c, float d) {
    const int ia = (int)__builtin_rintf(__builtin_amdgcn_fmed3f(a, -127.f, 127.f)), ib = (int)__builtin_rintf(__builtin_amdgcn_fmed3f(b, -127.f, 127.f)), ic = (int)__builtin_rintf(__builtin_amdgcn_fmed3f(c, -127.f, 127.f)), id = (int)__builtin_rintf(__builtin_amdgcn_fmed3f(d, -127.f, 127.f));
    return (unsigned)(ia & 255) | ((unsigned)(ib & 255) << 8) | ((unsigned)(ic & 255) << 16) | ((unsigned)id << 24); }
constexpr float XQ_CLIP = 5.f;
DEV bf16 f2bf(float f) { return (bf16)(pk2(f, 0.f) & 0xffffu); }
DEV float shx(float x, int mask, int lane) { return __builtin_bit_cast(float, __builtin_amdgcn_ds_bpermute((lane ^ mask) << 2, __builtin_bit_cast(int, x))); }
DEV float sigmoidf_(float x) { return __builtin_amdgcn_rcpf(1.f + __expf(-x)); }
DEV float siluf_(float x) { return x * __builtin_amdgcn_rcpf(1.f + __expf(-x)); }
DEV float gelu_tanh_(float x) { const float u = 0.7978845608028654f * (x + 0.044715f * x * x * x); return x - x * __builtin_amdgcn_rcpf(1.f + __expf(2.f * u)); }

#ifndef GEMM_WGM
#define GEMM_WGM 4
#endif
namespace pg8 {
#define PG8_LAS __attribute__((address_space(3)))
typedef unsigned short bf16_t;
typedef short bf16x8 __attribute__((ext_vector_type(8)));
typedef float f32x4 __attribute__((ext_vector_type(4)));
typedef unsigned u32x4 __attribute__((ext_vector_type(4)));
constexpr int BM = 256, BK = 64, HALF = 128, HTB = HALF * BK * 2  , STAGE_BYTES = 8 * HTB, NXCD = 8, WGM = GEMM_WGM;

__host__ __device__ __forceinline__ int lds_byte(int r, int c) { const int st = (r >> 4) * 2 + (c >> 5), rr = r & 15, cc = c & 31, ob = rr * 64 + cc * 2; return st * 1024 + (ob ^ (((ob >> 9) & 1) << 5)); }
__host__ __device__ __forceinline__ void stage_rc(int b, int& R, int& C) { const int st = b / 1024, sb = b % 1024, swz = sb ^ (((sb >> 9) & 1) << 5); R = (st >> 1) * 16 + swz / 64; C = (st & 1) * 32 + (swz % 64) / 2; }
__host__ __device__ __forceinline__ int perm32(int rho) { const int n = rho >> 4, i = rho & 15; return 8 * (i >> 2) + 4 * n + (i & 3); }

struct Unit { int pm, pn; };
struct Gemm { const bf16_t* A; const bf16_t* Bt; int M, N, K; int lda = 0, ldb = 0; };

struct StaticOrder {
    int nM, nN, nwg, G, c;
    __host__ __device__ void init(int M, int N, int G_, int c_) { nM = M / BM; nN = N / BM; nwg = nM * nN; G = G_; c = c_; }
    __host__ __device__ bool next(int i, Unit& u) const {
        const long L = (long)i * G + c; if (L >= nwg) return false;
        int wgid = (int)L; { const int q = nwg / NXCD, r = nwg % NXCD, xcd = wgid % NXCD, off = wgid / NXCD; wgid = (xcd < r ? xcd * (q + 1) : r * (q + 1) + (xcd - r) * q) + off; }
        const int nig = WGM * nN, gid = wgid / nig, fm = gid * WGM, gsz = (nM - fm) < WGM ? (nM - fm) : WGM;
        u.pm = fm + ((wgid % nig) % gsz); u.pn = (wgid % nig) / gsz; return true;
    }
    __device__ __forceinline__ void a_ready(const Unit&) const {}
    __device__ __forceinline__ void done(const Unit&) const {}
};
template <class Epi, class Sched, bool ALIGN_EPI = false, bool SP2 = false, int QT = 0>
__device__ __forceinline__ void gemm_phase(PG8_LAS unsigned char* lds, const Gemm g, const Sched& S, const Epi& E, int tid) {
    asm volatile("" : "+v"(tid));
    const int wid = __builtin_amdgcn_readfirstlane(tid >> 6), lane = tid & 63, wr = wid >> 2, wc = wid & 3, fr = lane & 15, fq = lane >> 4;
    constexpr bool FP8 = QT == 1, I8 = QT == 2;
    const int KA = g.lda ? g.lda : g.K, KB = g.ldb ? g.ldb : g.K, nt = g.K / BK;
    unsigned voffA[2], voffB[2];
#pragma unroll
    for (int i = 0; i < 2; ++i) { int R, C; stage_rc(tid * 16 + i * 8192, R, C); const int Rb = Epi::PERM ? ((R & ~31) + perm32(R & 31)) : R;
        voffA[i] = (unsigned)(R * KA + C) * 2u; voffB[i] = (unsigned)(Rb * KB + C) * 2u; }
    const size_t kstep = (size_t)(BK * 2);
    const size_t hstepA = (size_t)HALF * KA * 2, hstepB = (size_t)HALF * KB * 2;
    const size_t tstepA = 2 * hstepA, tstepB = 2 * hstepB;
    const unsigned ldsw = (unsigned)wid * 1024u;
    const int aoff = lds_byte(wr * 64 + fr, fq * 8), boff = lds_byte(wc * 32 + fr, fq * 8);
#define PG8_SA(b, h) (((b) * 2 + (h)) * HTB)
#define PG8_SB(b, h) ((4 + (b) * 2 + (h)) * HTB)
#define PG8_STAGE(bufoff, gbase, voff) do { _Pragma("unroll") for (int _i = 0; _i < 2; ++_i) \
        __builtin_amdgcn_global_load_lds((const unsigned*)((const char*)(gbase) + (voff)[_i]), (PG8_LAS unsigned*)(lds + (bufoff) + ldsw + _i * 8192), 16, 0, 0); } while (0)
#define PG8_LDA(dst, b, h) do { _Pragma("unroll") for (int m = 0; m < 4; ++m) _Pragma("unroll") for (int k = 0; k < 2; ++k) dst[m][k] = *(const PG8_LAS bf16x8*)(lds + PG8_SA(b, h) + aoff + m * 2048 + k * 1024); } while (0)
#define PG8_LDB(dst, b, h) do { _Pragma("unroll") for (int n = 0; n < 2; ++n) _Pragma("unroll") for (int k = 0; k < 2; ++k) dst[n][k] = *(const PG8_LAS bf16x8*)(lds + PG8_SB(b, h) + boff + n * 2048 + k * 1024); } while (0)
#define PG8_CAT(x, y) __builtin_bit_cast(v8i, __builtin_shufflevector(x, y, 0, 1, 2, 3, 4, 5, 6, 7, 8, 9, 10, 11, 12, 13, 14, 15))
#define PG8_MMA(ai, bj, At, Bt) do { __builtin_amdgcn_s_setprio(1); if constexpr (FP8) { _Pragma("unroll") for (int m = 0; m < 4; ++m) _Pragma("unroll") for (int n = 0; n < 2; ++n) \
        { const v8i b8_ = PG8_CAT(Bt[n][0], Bt[n][1]), a8_ = PG8_CAT(At[m][0], At[m][1]); asm volatile("v_mfma_scale_f32_16x16x128_f8f6f4 %0, %1, %2, %0, %3, %3 op_sel_hi:[0,0,0]" : "+v"(acc[ai][bj][m][n]) : "v"(b8_), "v"(a8_), "v"(one_scales)); } } else if constexpr (I8) { \
        _Pragma("unroll") for (int m = 0; m < 4; ++m) _Pragma("unroll") for (int n = 0; n < 2; ++n) _Pragma("unroll") for (int k = 0; k < 2; ++k) \
        acc[ai][bj][m][n] = __builtin_bit_cast(f32x4, __builtin_amdgcn_mfma_i32_16x16x64_i8(__builtin_bit_cast(v4i, Bt[n][k]), __builtin_bit_cast(v4i, At[m][k]), __builtin_bit_cast(v4i, acc[ai][bj][m][n]), 0, 0, 0)); } else { \
        _Pragma("unroll") for (int m = 0; m < 4; ++m) _Pragma("unroll") for (int n = 0; n < 2; ++n) _Pragma("unroll") for (int k = 0; k < 2; ++k) \
        acc[ai][bj][m][n] = __builtin_amdgcn_mfma_f32_16x16x32_bf16(Bt[n][k], At[m][k], acc[ai][bj][m][n], 0, 0, 0); } __builtin_amdgcn_s_setprio(0); } while (0)
#define PG8_WAIT_V(n) asm volatile("s_waitcnt vmcnt(" #n ")" ::: "memory")
#define PG8_WAIT_L(n) asm volatile("s_waitcnt lgkmcnt(" #n ")" ::: "memory")
#define PG8_BAR __builtin_amdgcn_s_barrier()
#define PG8_SCHED __builtin_amdgcn_sched_barrier(0)
    const int one_scales = 0x7f7f7f7f;
    Unit cur, nxt; int ui = 0;
    if (!S.next(0, cur)) return;
    f32x4 acc[2][2][4][2];
#pragma unroll
    for (int a = 0; a < 2; ++a)
#pragma unroll
        for (int b = 0; b < 2; ++b)
#pragma unroll
            for (int m = 0; m < 4; ++m)
#pragma unroll
                for (int n = 0; n < 2; ++n) acc[a][b][m][n] = (f32x4){0.f, 0.f, 0.f, 0.f};
    bf16x8 At[4][2], B0[2][2], B1[2][2];
    const char* cA = (const char*)g.A + (size_t)cur.pm * tstepA; const char* cB = (const char*)g.Bt + (size_t)cur.pn * tstepB;
    S.a_ready(cur);
    if constexpr (SP2) {
        PG8_STAGE(PG8_SB(0, 0), cB, voffB); PG8_STAGE(PG8_SB(0, 1), cB + hstepB, voffB); PG8_STAGE(PG8_SA(0, 0), cA, voffA); PG8_STAGE(PG8_SA(0, 1), cA + hstepA, voffA);
        if (wr == 1) PG8_BAR;
        PG8_WAIT_V(2); PG8_BAR;
        PG8_STAGE(PG8_SB(1, 0), cB + kstep, voffB); PG8_STAGE(PG8_SA(1, 0), cA + kstep, voffA); PG8_STAGE(PG8_SB(1, 1), cB + hstepB + kstep, voffB);
        PG8_WAIT_V(6); PG8_BAR;
    } else {
        PG8_STAGE(PG8_SB(0, 0), cB, voffB); PG8_STAGE(PG8_SA(0, 0), cA, voffA); PG8_STAGE(PG8_SB(0, 1), cB + hstepB, voffB); PG8_STAGE(PG8_SA(0, 1), cA + hstepA, voffA);
        if (wr == 1) PG8_BAR;
        PG8_WAIT_V(4); PG8_BAR;
        PG8_STAGE(PG8_SB(1, 0), cB + kstep, voffB); PG8_STAGE(PG8_SA(1, 0), cA + kstep, voffA); PG8_STAGE(PG8_SB(1, 1), cB + hstepB + kstep, voffB);
        PG8_WAIT_V(6); PG8_BAR;
    }
    for (;;) {
        const bool has_next = S.next(ui + 1, nxt);
        const char* nA = has_next ? (const char*)g.A + (size_t)nxt.pm * tstepA : cA; const char* nB = has_next ? (const char*)g.Bt + (size_t)nxt.pn * tstepB : cB;
        for (int t = 0; t < nt; t += 2) {
            const bool last = (t == nt - 2);
            const char* a1 = cA + (size_t)(t + 1) * kstep;
            const char* a2 = last ? nA : cA + (size_t)(t + 2) * kstep; const char* b2 = last ? nB : cB + (size_t)(t + 2) * kstep;
            const char* a3 = a2 + kstep; const char* b3 = b2 + kstep;
            if (last && has_next) S.a_ready(nxt);
            if constexpr (SP2) {
            PG8_LDB(B0, 0, 0); PG8_LDB(B1, 0, 1); PG8_SCHED; PG8_LDA(At, 0, 0); PG8_STAGE(PG8_SA(1, 1), a1 + hstepA, voffA);
            PG8_WAIT_V(8); PG8_WAIT_L(0); PG8_BAR; PG8_MMA(0, 0, At, B0); PG8_MMA(0, 1, At, B1); PG8_BAR; PG8_SCHED;
            PG8_LDA(At, 0, 1); PG8_STAGE(PG8_SB(0, 0), b2, voffB); PG8_STAGE(PG8_SB(0, 1), b2 + hstepB, voffB); PG8_STAGE(PG8_SA(0, 0), a2, voffA);
            PG8_WAIT_V(8); PG8_WAIT_L(0); PG8_BAR; PG8_MMA(1, 0, At, B0); PG8_MMA(1, 1, At, B1); PG8_BAR; PG8_SCHED;
            PG8_LDB(B0, 1, 0); PG8_LDB(B1, 1, 1); PG8_SCHED; PG8_LDA(At, 1, 0); PG8_STAGE(PG8_SA(0, 1), a2 + hstepA, voffA);
            PG8_WAIT_V(8); PG8_WAIT_L(0); PG8_BAR; PG8_MMA(0, 0, At, B0); PG8_MMA(0, 1, At, B1); PG8_BAR; PG8_SCHED;
            PG8_LDA(At, 1, 1); PG8_STAGE(PG8_SB(1, 0), b3, voffB); PG8_STAGE(PG8_SB(1, 1), b3 + hstepB, voffB); PG8_STAGE(PG8_SA(1, 0), a3, voffA);
            PG8_WAIT_V(8); PG8_WAIT_L(0); PG8_BAR; PG8_MMA(1, 0, At, B0); PG8_MMA(1, 1, At, B1); PG8_BAR; PG8_SCHED;
            } else {
            PG8_LDB(B0, 0, 0); PG8_SCHED; PG8_LDA(At, 0, 0); PG8_STAGE(PG8_SA(1, 1), a1 + hstepA, voffA);
            PG8_WAIT_L(8); PG8_BAR; PG8_WAIT_L(0); PG8_MMA(0, 0, At, B0); PG8_BAR; PG8_SCHED;
            PG8_LDB(B1, 0, 1); PG8_STAGE(PG8_SB(0, 0), b2, voffB);
            PG8_BAR; PG8_WAIT_L(0); PG8_MMA(0, 1, At, B1); PG8_BAR;
            PG8_LDA(At, 0, 1); PG8_STAGE(PG8_SA(0, 0), a2, voffA);
            PG8_BAR; PG8_WAIT_L(0); PG8_MMA(1, 0, At, B0); PG8_BAR; PG8_SCHED;
            PG8_STAGE(PG8_SB(0, 1), b2 + hstepB, voffB);
            PG8_WAIT_V(6); PG8_BAR; PG8_MMA(1, 1, At, B1); PG8_BAR;
            PG8_LDB(B0, 1, 0); PG8_SCHED; PG8_LDA(At, 1, 0); PG8_STAGE(PG8_SA(0, 1), a2 + hstepA, voffA);
            PG8_WAIT_L(8); PG8_BAR; PG8_WAIT_L(0); PG8_MMA(0, 0, At, B0); PG8_BAR; PG8_SCHED;
            PG8_LDB(B1, 1, 1); PG8_STAGE(PG8_SB(1, 0), b3, voffB);
            PG8_BAR; PG8_WAIT_L(0); PG8_MMA(0, 1, At, B1); PG8_BAR;
            PG8_LDA(At, 1, 1); PG8_STAGE(PG8_SA(1, 0), a3, voffA);
            PG8_BAR; PG8_WAIT_L(0); PG8_MMA(1, 0, At, B0); PG8_BAR; PG8_SCHED;
            PG8_STAGE(PG8_SB(1, 1), b3 + hstepB, voffB);
            PG8_WAIT_V(6); PG8_BAR; PG8_MMA(1, 1, At, B1); PG8_BAR;
            }
        }
        if constexpr (FP8) asm volatile("s_nop 15\n\ts_nop 15" ::: "memory");
        if constexpr (ALIGN_EPI) { if (wr == 0) PG8_BAR; }
        if constexpr (!Epi::AFTER_DRAIN) { E(acc, cur, wr, wc, fr, fq); S.done(cur); }
        if (!has_next) break;
#pragma unroll
        for (int a = 0; a < 2; ++a)
#pragma unroll
            for (int b = 0; b < 2; ++b)
#pragma unroll
                for (int m = 0; m < 4; ++m)
#pragma unroll
                    for (int n = 0; n < 2; ++n) acc[a][b][m][n] = (f32x4){0.f, 0.f, 0.f, 0.f};
        cur = nxt; cA = nA; cB = nB; ++ui;
        if constexpr (ALIGN_EPI) { if (wr == 1) PG8_BAR; }
    }
    PG8_WAIT_V(0);
    if constexpr (!ALIGN_EPI) { if (wr == 0) PG8_BAR; }
    PG8_BAR;
    if constexpr (Epi::AFTER_DRAIN) { E.fused(acc, cur, wr, wc, fr, fq, lds, wid, lane); S.done(cur); }
#undef PG8_SA
#undef PG8_SB
#undef PG8_STAGE
#undef PG8_LDA
#undef PG8_LDB
#undef PG8_MMA
#undef PG8_CAT
#undef PG8_WAIT_V
#undef PG8_WAIT_L
#undef PG8_BAR
#undef PG8_SCHED
}
}

typedef long long ssq_t;
DEV float rstd_of(const ssq_t* ssq, int row) { return __builtin_amdgcn_rsqf((float)((const GAS ssq_t*)ssq)[row] * (1.f / (4096.f * 16777216.f)) + EPS); }
DEV void ssq_add(ssq_t* ssq, int row, float ss) { __hip_atomic_fetch_add((GAS ssq_t*)ssq + row, (ssq_t)(ss * 16777216.f), __ATOMIC_RELAXED, __HIP_MEMORY_SCOPE_AGENT); }

struct EpiIn {
    static constexpr bool PERM = true, AFTER_DRAIN = false;
    bf16 *LG, *LX, *HU, *Q, *Kr, *V, *Gs; const ssq_t* ssq; const float* rot;
    DEV void operator()(const f32x4 (&acc)[2][2][4][2], const pg8::Unit& u, int wr, int wc, int fr, int fq) const {
        const int row0 = u.pm * 256 + wr * 64 + fr, cc0 = wc * 32 + 8 * fq, pn = u.pn;
        if (pn >= 20 && pn < 28) {
            const bool isk = pn >= 24; const int P = pn - (isk ? 24 : 20); bf16* dst = isk ? Kr : Q; const float sc = isk ? 0.08838834764831845f : 1.f;
            const int hh = wc >> 1, jj0 = 32 * (wc & 1) + 8 * fq, ocol = (2 * P + hh) * 128 + jj0;
#pragma unroll
            for (int ai = 0; ai < 2; ++ai)
#pragma unroll
                for (int m = 0; m < 4; ++m) {
                    const int row = row0 + ai * 128 + m * 16; const float rs = rstd_of(ssq, row) * sc;
                    const GAS f32x4* rp = (const GAS f32x4*)(rot + ((size_t)row * 64 + jj0) * 2);
                    const f32x4 t0 = rp[0], t1 = rp[1], t2 = rp[2], t3 = rp[3];
                    const f32x4 a0 = acc[ai][0][m][0] * rs, a1 = acc[ai][0][m][1] * rs, b0 = acc[ai][1][m][0] * rs, b1 = acc[ai][1][m][1] * rs;
                    v4u o1, o2;
                    o1.x = pk2(a0[0] * t0[0] - b0[0] * t0[1], a0[1] * t0[2] - b0[1] * t0[3]); o2.x = pk2(a0[0] * t0[1] + b0[0] * t0[0], a0[1] * t0[3] + b0[1] * t0[2]);
                    o1.y = pk2(a0[2] * t1[0] - b0[2] * t1[1], a0[3] * t1[2] - b0[3] * t1[3]); o2.y = pk2(a0[2] * t1[1] + b0[2] * t1[0], a0[3] * t1[3] + b0[3] * t1[2]);
                    o1.z = pk2(a1[0] * t2[0] - b1[0] * t2[1], a1[1] * t2[2] - b1[1] * t2[3]); o2.z = pk2(a1[0] * t2[1] + b1[0] * t2[0], a1[1] * t2[3] + b1[1] * t2[2]);
                    o1.w = pk2(a1[2] * t3[0] - b1[2] * t3[1], a1[3] * t3[2] - b1[3] * t3[3]); o2.w = pk2(a1[2] * t3[1] + b1[2] * t3[0], a1[3] * t3[3] + b1[3] * t3[2]);
                    bf16* rowp = dst + (size_t)row * 1024 + ocol;
                    *(GAS v4u*)rowp = o1; *(GAS v4u*)(rowp + 64) = o2;
                }
        } else {
            bf16* dst; int ldc, colt, act = 0;
            if (pn < 4) { dst = LG; ldc = 1024; colt = pn * 256; act = 1; }
            else if (pn < 8) { dst = LX; ldc = 1024; colt = (pn - 4) * 256; }
            else if (pn < 20) { dst = HU; ldc = 3072; colt = (pn - 8) * 256; }
            else if (pn < 36) { dst = V; ldc = 2048; colt = (pn - 28) * 256; }
            else { dst = Gs; ldc = 2048; colt = (pn - 36) * 256; act = 2; }
#pragma unroll
            for (int ai = 0; ai < 2; ++ai)
#pragma unroll
                for (int m = 0; m < 4; ++m) {
                    const int row = row0 + ai * 128 + m * 16; const float rs = rstd_of(ssq, row);
                    bf16* rowp = dst + (size_t)row * ldc + colt + cc0;
#pragma unroll
                    for (int bj = 0; bj < 2; ++bj) {
                        f32x4 v0 = acc[ai][bj][m][0] * rs, v1 = acc[ai][bj][m][1] * rs;
                        if (act == 1) {
#pragma unroll
                            for (int e = 0; e < 4; ++e) { v0[e] = gelu_tanh_(v0[e]); v1[e] = gelu_tanh_(v1[e]); }
                        } else if (act == 2) {
#pragma unroll
                            for (int e = 0; e < 4; ++e) { v0[e] = siluf_(v0[e]); v1[e] = siluf_(v1[e]); }
                        }
                        v4u w; w.x = pk2(v0[0], v0[1]); w.y = pk2(v0[2], v0[3]); w.z = pk2(v1[0], v1[1]); w.w = pk2(v1[2], v1[3]);
                        *(GAS v4u*)(rowp + bj * 128) = w;
                    }
                }
        }
    }
};
struct EpiRes {
    static constexpr bool PERM = true, AFTER_DRAIN = false;
    bf16* xb; ssq_t* ssq; float sc; unsigned char* xq; const ssq_t* ssq_old;
    DEV void operator()(const f32x4 (&acc)[2][2][4][2], const pg8::Unit& u, int wr, int wc, int fr, int fq) const {
        const int row0 = u.pm * 256 + wr * 64 + fr, col0 = u.pn * 256 + wc * 32 + 8 * fq;
#pragma unroll
        for (int ai = 0; ai < 2; ++ai)
#pragma unroll
            for (int m = 0; m < 4; ++m) {
                const int row = row0 + ai * 128 + m * 16; const size_t off = (size_t)row * 4096 + col0; float ss = 0.f;
                const float qs = xq ? (127.f / XQ_CLIP) * rstd_of(ssq_old, row) : 0.f;
                v4u rv[2];
#pragma unroll
                for (int bj = 0; bj < 2; ++bj) rv[bj] = *(const GAS v4u*)(xb + off + bj * 128);
#pragma unroll
                for (int bj = 0; bj < 2; ++bj) {
                    const f32x4 a0 = acc[ai][bj][m][0], a1 = acc[ai][bj][m][1];
                    const float o0 = fmaf(a0[0], sc, bflo(rv[bj].x)), o1 = fmaf(a0[1], sc, bfhi(rv[bj].x)), o2 = fmaf(a0[2], sc, bflo(rv[bj].y)), o3 = fmaf(a0[3], sc, bfhi(rv[bj].y));
                    const float o4 = fmaf(a1[0], sc, bflo(rv[bj].z)), o5 = fmaf(a1[1], sc, bfhi(rv[bj].z)), o6 = fmaf(a1[2], sc, bflo(rv[bj].w)), o7 = fmaf(a1[3], sc, bfhi(rv[bj].w));
                    ss += ((o0 * o0 + o1 * o1) + (o2 * o2 + o3 * o3)) + ((o4 * o4 + o5 * o5) + (o6 * o6 + o7 * o7));
                    v4u w; w.x = pk2(o0, o1); w.y = pk2(o2, o3); w.z = pk2(o4, o5); w.w = pk2(o6, o7); *(GAS v4u*)(xb + off + bj * 128) = w;
                    if (xq) { v2u q; q.x = pk4_i8(o0 * qs, o1 * qs, o2 * qs, o3 * qs); q.y = pk4_i8(o4 * qs, o5 * qs, o6 * qs, o7 * qs); *(GAS v2u*)(xq + off + bj * 128) = q; }
                }
                { const int ln = fq * 16 + fr; ss += shx(ss, 16, ln); ss += shx(ss, 32, ln); }
                if (fq == 0) ssq_add(ssq, row, ss);
                if (m & 1) asm volatile("" ::: "memory");
            }
    }
};
struct EpiHuT {
    static constexpr bool PERM = true, AFTER_DRAIN = false;
    bf16* HYT; const ssq_t* ssq;
    DEV void operator()(const f32x4 (&acc)[2][2][4][2], const pg8::Unit& u, int wr, int wc, int fr, int fq) const {
        const int row0 = u.pm * 256 + wr * 64 + fr, col0 = u.pn * 256 + wc * 32 + 8 * fq;
        float rs[2][8];
#pragma unroll
        for (int bj = 0; bj < 2; ++bj)
#pragma unroll
            for (int e = 0; e < 8; ++e) rs[bj][e] = rstd_of(ssq, col0 + bj * 128 + e);
#pragma unroll
        for (int ai = 0; ai < 2; ++ai)
#pragma unroll
            for (int m = 0; m < 4; ++m) { bf16* rowp = HYT + (size_t)(row0 + ai * 128 + m * 16) * M + col0;
#pragma unroll
                for (int bj = 0; bj < 2; ++bj) { const f32x4 v0 = acc[ai][bj][m][0], v1 = acc[ai][bj][m][1];
                    v4u w; w.x = pk2(v0[0] * rs[bj][0], v0[1] * rs[bj][1]); w.y = pk2(v0[2] * rs[bj][2], v0[3] * rs[bj][3]); w.z = pk2(v1[0] * rs[bj][4], v1[1] * rs[bj][5]); w.w = pk2(v1[2] * rs[bj][6], v1[3] * rs[bj][7]);
                    *(GAS v4u*)(rowp + bj * 128) = w; } }
    }
};
template <int QT> struct EpiGU_ {
    static constexpr bool PERM = true, AFTER_DRAIN = false;
    unsigned char* U; const ssq_t* ssq; int f8; const ssq_t* ssq_old; const unsigned* amax;
    DEV void operator()(const f32x4 (&acc)[2][2][4][2], const pg8::Unit& u, int wr, int wc, int fr, int fq) const {
        const int row0 = u.pm * 256 + wr * 64 + fr, col = u.pn * 128 + wc * 32 + 8 * fq;
        f32x4 cg0, cg1, cu0, cu1;
        if constexpr (QT == 2) { const GAS f32x4* ap = (const GAS f32x4*)((const GAS float*)amax + u.pn * 256 + wc * 32 + 8 * fq); cg0 = ap[0] * (1.f / 127.f); cg1 = ap[1] * (1.f / 127.f); cu0 = ap[32] * (1.f / 127.f); cu1 = ap[33] * (1.f / 127.f); }
#pragma unroll
        for (int ai = 0; ai < 2; ++ai)
#pragma unroll
            for (int m = 0; m < 4; ++m) {
                const int row = row0 + ai * 128 + m * 16; float rs = rstd_of(ssq, row);
                f32x4 g0, g1, u0, u1;
                if constexpr (QT == 2) {
                    rs *= (XQ_CLIP / 127.f) * __builtin_amdgcn_rcpf(rstd_of(ssq_old, row));
                    g0 = __builtin_convertvector(__builtin_bit_cast(v4i, acc[ai][0][m][0]), f32x4) * cg0; g1 = __builtin_convertvector(__builtin_bit_cast(v4i, acc[ai][0][m][1]), f32x4) * cg1;
                    u0 = __builtin_convertvector(__builtin_bit_cast(v4i, acc[ai][1][m][0]), f32x4) * cu0; u1 = __builtin_convertvector(__builtin_bit_cast(v4i, acc[ai][1][m][1]), f32x4) * cu1;
                } else { g0 = acc[ai][0][m][0]; g1 = acc[ai][0][m][1]; u0 = acc[ai][1][m][0]; u1 = acc[ai][1][m][1]; }
                const float rsu = f8 ? 8.f * rs : rs;
                g0 *= rs; g1 *= rs; u0 *= rsu; u1 *= rsu;
                const float y0 = siluf_(g0[0]) * u0[0], y1 = siluf_(g0[1]) * u0[1], y2 = siluf_(g0[2]) * u0[2], y3 = siluf_(g0[3]) * u0[3];
                const float y4 = siluf_(g1[0]) * u1[0], y5 = siluf_(g1[1]) * u1[1], y6 = siluf_(g1[2]) * u1[2], y7 = siluf_(g1[3]) * u1[3];
                if (f8) { v2u w; w.x = pk4_fp8(y0, y1, y2, y3); w.y = pk4_fp8(y4, y5, y6, y7); *(GAS v2u*)(U + (size_t)row * DFF + col) = w; }
                else { v4u w; w.x = pk2(y0, y1); w.y = pk2(y2, y3); w.z = pk2(y4, y5); w.w = pk2(y6, y7); *(GAS v4u*)((bf16*)U + (size_t)row * DFF + col) = w; }
            }
    }
};
typedef EpiGU_<0> EpiGU;
#define XB_TMO      128
#define XB_XCNT(j)  (256  + 64 * (j))
#define XB_XSUB(j)  (1280 + 64 * (j))
#define XB_XGEN(j)  (2304 + 64 * (j))
#define XB_TOP      3328
#define XB_TOPGEN   3392
#define XCD_BAR_WORDS 3456
#define XB_SPIN_CAP (1u << 18)
__device__ __forceinline__ unsigned xb_ld(unsigned* p)              { return __hip_atomic_load(p, __ATOMIC_RELAXED, __HIP_MEMORY_SCOPE_AGENT); }
__device__ __forceinline__ unsigned xb_add(unsigned* p, unsigned v) { return __hip_atomic_fetch_add(p, v, __ATOMIC_RELAXED, __HIP_MEMORY_SCOPE_AGENT); }
__device__ __forceinline__ unsigned xb_xcc_id() { return (unsigned)__builtin_amdgcn_s_getreg((3 << 11) | 20) & 0xFu; }
#define XB_SPIN(cond, bar) do { unsigned _sp = 0; while (cond) { __builtin_amdgcn_s_sleep(1); \
    if ((++_sp & 255u) == 0u) { if (xb_ld(&(bar)[XB_TMO])) break; if (_sp > XB_SPIN_CAP) { atomicAdd(&(bar)[XB_TMO], 1u); break; } } } } while (0)

struct XcdBarrier {
    unsigned* bar; unsigned x;
    volatile LAS unsigned* st;
};

__device__ __forceinline__ XcdBarrier xcd_barrier_post(unsigned* bar, volatile LAS unsigned* st) {
    XcdBarrier b; b.bar = bar; b.x = xb_xcc_id(); b.st = st;
    if (threadIdx.x == 0) (void)xb_add(&bar[XB_XCNT(b.x)], 1u);
    return b;
}
__device__ __forceinline__ void xcd_barrier_complete(unsigned* bar, unsigned x, unsigned& nloc, unsigned& nx) {
    const unsigned G = gridDim.x * gridDim.y * gridDim.z;
    unsigned sum, cnt, mine, sp = 0u;
    for (;;) {
        sum = 0u; cnt = 0u; mine = 0u;
#pragma unroll
        for (unsigned j = 0; j < 16; ++j) { const unsigned c = xb_ld(&bar[XB_XCNT(j)]); sum += c; cnt += (c > 0u) ? 1u : 0u; }
        if (sum == G) { mine = xb_ld(&bar[XB_XCNT(x)]); break; }
        __builtin_amdgcn_s_sleep(1);
        if ((++sp & 255u) == 0u) { if (xb_ld(&bar[XB_TMO])) break; if (sp > XB_SPIN_CAP) { atomicAdd(&bar[XB_TMO], 1u); break; } }
    }
    nloc = mine > 0u ? mine : 1u; nx = cnt > 0u ? cnt : 1u;
}

__device__ __forceinline__ void xcd_barrier(const XcdBarrier& b, const bool leader  ) {
    asm volatile("s_waitcnt vmcnt(0)" ::: "memory");
    __syncthreads();
    if (leader) {
        unsigned* bar = b.bar;
        __builtin_amdgcn_s_waitcnt(0);
        unsigned nloc = b.st[0], nx = b.st[1];
        if (nloc == 0u) { xcd_barrier_complete(bar, b.x, nloc, nx); b.st[0] = nloc; b.st[1] = nx; }
        const unsigned old = xb_add(&bar[XB_XSUB(b.x)], 1u);
        const unsigned gen = old / nloc;
        if (old + 1u == (gen + 1u) * nloc) {
            __builtin_amdgcn_fence(__ATOMIC_RELEASE, "agent");
            asm volatile("s_waitcnt vmcnt(0)" ::: "memory");
            const unsigned og = xb_add(&bar[XB_TOP], 1u);
            const unsigned tg = og / nx;
            if (og + 1u == (tg + 1u) * nx) xb_add(&bar[XB_TOPGEN], 1u);
            else XB_SPIN(xb_ld(&bar[XB_TOPGEN]) == tg, bar);
            __builtin_amdgcn_fence(__ATOMIC_ACQUIRE, "agent");
            xb_add(&bar[XB_XGEN(b.x)], 1u);
            asm volatile("s_waitcnt vmcnt(0)" ::: "memory");
        } else {
            XB_SPIN(xb_ld(&bar[XB_XGEN(b.x)]) == gen, bar);
            __builtin_amdgcn_fence(__ATOMIC_ACQUIRE, "agent");
            asm volatile("s_waitcnt vmcnt(0)" ::: "memory");
        }
    }
    __syncthreads();
}

constexpr size_t MiB = 1u << 20;
constexpr size_t WS_CTL = 0, CTL_BYTES = 1 * MiB;
constexpr int CW_BAR = 4096;
constexpr size_t CTL_SSQ_OFF = 128 * 1024;
constexpr size_t CTL_AMAX_OFF = 832 * 1024;
constexpr size_t WS_WIN = 1 * MiB;
constexpr size_t WS_WOUT = WS_WIN + 2 * 88 * MiB;
constexpr size_t WS_WGU = WS_WOUT + 2 * 32 * MiB;
constexpr size_t WS_WDN = WS_WGU + 2 * 172 * MiB;
constexpr size_t WS_XB = WS_WDN + 2 * 86 * MiB;
constexpr size_t WS_MIX = WS_XB + 128 * MiB;
constexpr size_t WS_PROJ = WS_MIX + 128 * MiB;
constexpr size_t WS_KV = WS_PROJ + 352 * MiB;
constexpr size_t WS_HYT = WS_KV + 128 * MiB;
constexpr size_t WS_HYO = WS_HYT + 96 * MiB;
constexpr size_t WS_GSCR = WS_HYO + 32 * MiB;
constexpr size_t WS_ROT = WS_GSCR + 96 * MiB;
constexpr size_t WS_HDN = WS_ROT + 8 * MiB;
constexpr size_t WS_LRUC = WS_HDN + 8 * MiB;
constexpr size_t WS_WGT = WS_LRUC + 3 * MiB;
constexpr size_t WS_END = WS_WGT + 2 * MiB;

constexpr int LDS_BYTES = 160 * 1024;
constexpr int MISC_OFF = LDS_BYTES - 256;
#ifndef FP8_MASK
#define FP8_MASK 2
#endif
#ifndef PROBE_P0
#define PROBE_P0 0
#endif
#ifndef I8_MASK
#define I8_MASK 3
#endif
#define I8_GU(l) ((I8_MASK >> (l)) & 1)
#define FP8_DOWN(l) ((FP8_MASK >> (l)) & 1)
constexpr int NPH = 16;

#define LDS_WAIT() asm volatile("s_waitcnt lgkmcnt(0)" ::: "memory")
#define VM_WAIT() asm volatile("s_waitcnt vmcnt(0)" ::: "memory")

struct Args { const float* in[29]; float* out; unsigned char* ws; int ph_lo, ph_hi; };

struct Frame {
    LAS unsigned char* lds; int tid, lane, wave, vcu, G;
    const float* const* in;
    float* out; unsigned char* ws;
    DEV const float* I(int k) const { return (const float*)(const GAS float*)in[k]; }
    template <class T> DEV T* W(size_t off) const { return (T*)(GAS T*)(ws + off); }
    DEV float* O() const { return (float*)(GAS float*)out; }
};

DEV float wave_sum(float v, int lane) {
#pragma unroll
    for (int o = 1; o < 64; o <<= 1) v += shx(v, o, lane);
    return v;
}
DEV f32x2 cmul(f32x2 a, f32x2 b) { return (f32x2){a.x * b.x - a.y * b.y, a.x * b.y + a.y * b.x}; }
DEV bf16x8 lfrag(const LAS unsigned char* base, int row0, int s, int stride, int fr, int fq) { return *(const LAS bf16x8*)(base + (row0 + fr) * stride + s * 64 + fq * 16); }
DEV f32x4 mfma16(bf16x8 a, bf16x8 b, f32x4 c) { return __builtin_amdgcn_mfma_f32_16x16x32_bf16(a, b, c, 0, 0, 0); }
template <int E> DEV float bfe(const v4u& v) { const unsigned w = E < 2 ? v.x : E < 4 ? v.y : E < 6 ? v.z : v.w; return (E & 1) ? bfhi(w) : bflo(w); }

DEV int map_win(int n) {
    if (n < 5120 || n >= 7168) return n;
    const int base = n < 6144 ? 5120 : 6144, r = n - base, h = r >> 7, j = r & 127;
    return base + 256 * (h >> 1) + 128 * (j >> 6) + 64 * (h & 1) + (j & 63);
}
template <int CTRL> DEV float dpp_f(float x) { return __builtin_bit_cast(float, __builtin_amdgcn_update_dpp(0, __builtin_bit_cast(int, x), CTRL, 0xf, 0xf, true)); }
DEV void tr_item(const float* W, int K, int N, bf16* WT, LAS float* scr, int item, int lane, const float* gain, int mode, unsigned* amax = nullptr) {
    const int nblk = N / 64, kb = item / nblk, nb = item - kb * nblk, k0 = 64 * kb, n0 = 64 * nb;
    const int l16 = lane & 15, kq = lane >> 4;
    f32x4 v[16];
#pragma unroll
    for (int i = 0; i < 16; ++i) v[i] = __builtin_nontemporal_load((const GAS f32x4*)(W + (size_t)(k0 + 4 * i + kq) * N + n0 + 4 * l16));
#pragma unroll
    for (int i = 0; i < 16; ++i) { LAS float* d = scr + (4 * l16) * 65 + 4 * i + kq; d[0] = v[i][0]; d[65] = v[i][1]; d[130] = v[i][2]; d[195] = v[i][3]; }
    LDS_WAIT();
    const int kc = lane & 7, nr = lane >> 3;
    f32x4 g0 = (f32x4){1.f, 1.f, 1.f, 1.f}, g1 = g0;
    if (gain) { g0 = *(const GAS f32x4*)(gain + k0 + 8 * kc); g1 = *(const GAS f32x4*)(gain + k0 + 8 * kc + 4); }
    float mine = 0.f;
#pragma unroll
    for (int j = 0; j < 8; ++j) { const int n = 8 * j + nr; const LAS float* s = scr + n * 65 + 8 * kc;
        int nd = n0 + n; if (mode == 1) nd = map_win(nd); else if (mode == 2) nd = 256 * (nd >> 7) + (nd & 127); else if (mode == 3) nd = 256 * (nd >> 7) + 128 + (nd & 127);
        if (mode == 4) { v2u o; o.x = pk4_fp8(s[0] * 1024.f, s[1] * 1024.f, s[2] * 1024.f, s[3] * 1024.f); o.y = pk4_fp8(s[4] * 1024.f, s[5] * 1024.f, s[6] * 1024.f, s[7] * 1024.f);
            *(GAS v2u*)((unsigned char*)WT + (size_t)nd * K + k0 + 8 * kc) = o; continue; }
        const float p0 = s[0] * g0[0], p1 = s[1] * g0[1], p2 = s[2] * g0[2], p3 = s[3] * g0[3], p4 = s[4] * g1[0], p5 = s[5] * g1[1], p6 = s[6] * g1[2], p7 = s[7] * g1[3];
        v4u o; o.x = pk2(p0, p1); o.y = pk2(p2, p3); o.z = pk2(p4, p5); o.w = pk2(p6, p7);
        *(GAS v4u*)(WT + (size_t)nd * K + k0 + 8 * kc) = o;
        if (amax) { float mx = fmaxf(fmaxf(fmaxf(fabsf(p0), fabsf(p1)), fmaxf(fabsf(p2), fabsf(p3))), fmaxf(fmaxf(fabsf(p4), fabsf(p5)), fmaxf(fabsf(p6), fabsf(p7))));
            mx = fmaxf(mx, dpp_f<0xB1>(mx)); mx = fmaxf(mx, dpp_f<0x4E>(mx)); mx = fmaxf(mx, dpp_f<0x141>(mx));
            mine = kc == j ? mx : mine; } }
    if (amax) {
        int nd = n0 + 8 * kc + nr; if (mode == 1) nd = map_win(nd); else if (mode == 2) nd = 256 * (nd >> 7) + (nd & 127); else if (mode == 3) nd = 256 * (nd >> 7) + 128 + (nd & 127);
        __hip_atomic_fetch_max((GAS unsigned*)amax + nd, __float_as_uint(mine), __ATOMIC_RELAXED, __HIP_MEMORY_SCOPE_AGENT); }
    LDS_WAIT();
}
DEV void p0_weights(const Frame& F, int gw, int NGW, int lane, int rep = 0) {
    LAS float* scr = (LAS float*)(F.lds + F.wave * 16896);
    constexpr int I_IN = 64 * 176, I_OUT = 64 * 64, I_G = 64 * 172, I_DN = 172 * 64, I_L = I_IN + I_OUT + 2 * I_G + I_DN;
    for (int it = gw; it < 2 * I_L; it += NGW) {
        const int itr = 2 * I_L - 1 - it;
        const int l = itr >= I_L ? 1 : 0; int r = itr - l * I_L;
        if (r < I_IN) { tr_item(F.I(2) + (size_t)l * D * NIN, D, NIN, F.W<bf16>(WS_WIN + (size_t)l * 88 * MiB), scr, r, lane, F.I(1) + l * D, 1); continue; } r -= I_IN;
        if (r < I_OUT) { tr_item(F.I(23) + (size_t)l * D * D, D, D, F.W<bf16>(WS_WOUT + (size_t)l * 32 * MiB), scr, r, lane, nullptr, 0); continue; } r -= I_OUT;
        unsigned* am = nullptr;
        if (r < I_G) { tr_item(F.I(25) + (size_t)l * D * DFF, D, DFF, F.W<bf16>(WS_WGU + (size_t)l * 172 * MiB), scr, r, lane, F.I(24) + l * D, 2, am); continue; } r -= I_G;
        if (r < I_G) { tr_item(F.I(26) + (size_t)l * D * DFF, D, DFF, F.W<bf16>(WS_WGU + (size_t)l * 172 * MiB), scr, r, lane, F.I(24) + l * D, 3, am); continue; } r -= I_G;
        tr_item(F.I(27) + (size_t)l * DFF * D, DFF, D, F.W<bf16>(WS_WDN + (size_t)l * 86 * MiB), scr, r, lane, nullptr, FP8_DOWN(l) ? 4 : 0);
    }
}
DEV void wq_rows(const Frame& F, int l) {
    unsigned char* base = F.W<unsigned char>(WS_WGU + (size_t)l * 172 * MiB); const unsigned* am = F.W<unsigned>(CTL_AMAX_OFF) + l * NGU;
    for (int r = F.vcu * 8 + F.wave; r < NGU; r += F.G * 8) {
        const GAS v4u* rp = (const GAS v4u*)(base + (size_t)r * 8192) + F.lane; v4u v[8];
#pragma unroll
        for (int i = 0; i < 8; ++i) v[i] = rp[i * 64];
        float a = 0.f;
#pragma unroll
        for (int i = 0; i < 8; ++i) a = fmaxf(fmaxf(fmaxf(a, fmaxf(fabsf(bflo(v[i].x)), fabsf(bfhi(v[i].x)))), fmaxf(fabsf(bflo(v[i].y)), fabsf(bfhi(v[i].y)))), fmaxf(fmaxf(fabsf(bflo(v[i].z)), fabsf(bfhi(v[i].z))), fmaxf(fabsf(bflo(v[i].w)), fabsf(bfhi(v[i].w)))));
#pragma unroll
        for (int o = 1; o < 64; o <<= 1) a = fmaxf(a, shx(a, o, F.lane));
        if (F.lane == 0) ((GAS unsigned*)am)[r] = __float_as_uint(a);
        const float qs = a > 0.f ? 127.f * __builtin_amdgcn_rcpf(a) : 0.f;
#pragma unroll
        for (int i = 0; i < 8; ++i) { v2u o; o.x = pk4_i8(bflo(v[i].x) * qs, bfhi(v[i].x) * qs, bflo(v[i].y) * qs, bfhi(v[i].y) * qs); o.y = pk4_i8(bflo(v[i].z) * qs, bfhi(v[i].z) * qs, bflo(v[i].w) * qs, bfhi(v[i].w) * qs);
            *(GAS v2u*)(base + (size_t)r * 8192 + i * 512 + F.lane * 8) = o; }
    }
}
DEV void p0_x(const Frame& F, int gw, int NGW, int lane) {
    { const float* x = F.I(0); bf16* xb = F.W<bf16>(WS_XB); ssq_t* ssq = F.W<ssq_t>(CTL_SSQ_OFF);
      for (int m = gw; m < M; m += NGW) { const GAS f32x4* xr = (const GAS f32x4*)(x + (size_t)m * D) + lane; GAS v2u* o = (GAS v2u*)(xb + (size_t)m * D) + lane; float s = 0.f;
#pragma unroll
          for (int j = 0; j < 16; ++j) { const f32x4 v = __builtin_nontemporal_load(xr + 64 * j); s += (v[0] * v[0] + v[1] * v[1]) + (v[2] * v[2] + v[3] * v[3]); v2u w; w.x = pk2(v[0], v[1]); w.y = pk2(v[2], v[3]); o[64 * j] = w; }
          s = wave_sum(s, lane); if (lane == 0) ((GAS ssq_t*)ssq)[m] = (ssq_t)(s * 16777216.f); } }
}
DEV void p0_small(const Frame& F, int gw, int NGW, int lane) {
    { float* rot = F.W<float>(WS_ROT); const double inv = exp(-(double)lane * (9.210340371976184 / 64.0)) * 0.3183098861837907;
      for (int idx = gw * 64 + lane; idx < M * 64; idx += NGW * 64) { const int pos = idx >> 6;
          double xx = (double)pos * inv; xx -= 2.0 * floor(xx * 0.5); const float xf = (float)xx;
          *(GAS f32x2*)(rot + 2 * idx) = (f32x2){cospif(xf), sinpif(xf)}; } }
    { float* hdn = F.W<float>(WS_HDN);
      for (int l = 0; l < NLAYER; ++l) {
          const GAS float* w1 = (const GAS float*)F.I(13) + l * 33 * 64 + lane; const GAS float* w2 = (const GAS float*)F.I(15) + l * 64 * 64 + lane;
          float w1c[33], w2c[64];
#pragma unroll
          for (int i = 0; i < 33; ++i) w1c[i] = w1[i * 64];
#pragma unroll
          for (int i = 0; i < 64; ++i) w2c[i] = w2[i * 64];
          const float fq_ = ((const GAS float*)F.I(18))[l * 64 + lane], b1 = ((const GAS float*)F.I(14))[l * 64 + lane], b2 = ((const GAS float*)F.I(16))[l * 64 + lane];
          const int bb = (lane - 1) & 15; const double fb2 = 2.0 * (1e-4 + (double)bb * ((15.0 - 1e-4) / 15.0)) * (1.0 / 16384.0);
          for (int t = gw; t < M; t += NGW) {
              float feat = (float)t * (1.0f / 16383.0f);
              if (lane >= 1 && lane < 33) { double xx = fb2 * (double)t; xx -= 2.0 * floor(xx * 0.5); const float xf = (float)xx; feat = lane <= 16 ? cospif(xf) : -sinpif(xf); }
              float h1 = b1;
#pragma unroll
              for (int i = 0; i < 33; ++i) h1 += __builtin_bit_cast(float, __builtin_amdgcn_readlane(__builtin_bit_cast(int, feat), i)) * w1c[i];
              h1 = __sinf(fq_ * h1);
              float h2 = b2;
#pragma unroll
              for (int i = 0; i < 64; ++i) h2 += __builtin_bit_cast(float, __builtin_amdgcn_readlane(__builtin_bit_cast(int, h1), i)) * w2c[i];
              ((GAS float*)hdn)[((size_t)l * M + t) * 64 + lane] = __sinf(fq_ * h2); } } }
    { bf16* wgt = F.W<bf16>(WS_WGT);
      for (int idx = gw * 64 + lane; idx < 2 * 2 * 2 * 8 * 16384; idx += NGW * 64) { const int i = idx & 127, j = (idx >> 7) & 127, h = (idx >> 14) & 7, g = (idx >> 17) & 1, ld = idx >> 18;
          const GAS float* src = (const GAS float*)(g ? F.I(7) : F.I(5)); ((GAS bf16*)wgt)[idx] = f2bf(src[((size_t)(ld * 8 + h) * 128 + i) * 128 + j]); } }
}
DEV void p0_prologue(const Frame& F, int rep = 0) {
    const int gw = F.vcu * 8 + F.wave, NGW = F.G * 8, lane = F.lane;
    if (F.wave & 1) { p0_small(F, gw, NGW, lane); p0_weights(F, gw, NGW, lane, rep); p0_x(F, gw, NGW, lane); }
    else { p0_weights(F, gw, NGW, lane, rep); p0_x(F, gw, NGW, lane); p0_small(F, gw, NGW, lane); }
}

DEV void hyt_unit(const Frame& F, int l, int unit) {
    int tid = F.tid; asm volatile("" : "+v"(tid)); const int tb = unit / 24, cb = unit - tb * 24, t0 = tb * 128, c0 = cb * 128;
    LAS float* S = (LAS float*)F.lds;
    const bf16* HU = F.W<bf16>(WS_PROJ + 64 * MiB);
    { v4u vv[5];
#pragma unroll
      for (int k = 0; k < 5; ++k) { const int task = tid + 512 * k, r = task >> 4, ch = task & 15, t = t0 - 1 + r; vv[k] = (v4u){0u, 0u, 0u, 0u};
          if (task < 130 * 16 && t >= 0 && t < M) vv[k] = *(const GAS v4u*)(HU + (size_t)t * 3072 + c0 + ch * 8); }
#pragma unroll
      for (int k = 0; k < 5; ++k) { const int task = tid + 512 * k, r = task >> 4, ch = task & 15; const v4u v = vv[k];
          if (task < 130 * 16) { LAS float* d = S + r * 129 + ch * 8; d[0] = bflo(v.x); d[1] = bfhi(v.x); d[2] = bflo(v.y); d[3] = bfhi(v.y); d[4] = bflo(v.z); d[5] = bfhi(v.z); d[6] = bflo(v.w); d[7] = bfhi(v.w); } } }
    __syncthreads();
    { const int cc = tid & 127, tq = tid >> 7, c = c0 + cc; const float* cw = F.I(11) + l * 3 * 3072; const float w0 = cw[c], w1 = cw[3072 + c], w2 = cw[2 * 3072 + c], b = F.I(12)[l * 3072 + c];
      bf16* dst = F.W<bf16>(WS_HYT) + (size_t)c * M + t0 + tq * 32;
#pragma unroll
      for (int k = 0; k < 4; ++k) { float y[8];
#pragma unroll
          for (int e = 0; e < 8; ++e) { const int t = tq * 32 + k * 8 + e; y[e] = b + w0 * S[t * 129 + cc] + w1 * S[(t + 1) * 129 + cc] + w2 * S[(t + 2) * 129 + cc]; }
          v4u o; o.x = pk2(y[0], y[1]); o.y = pk2(y[2], y[3]); o.z = pk2(y[4], y[5]); o.w = pk2(y[6], y[7]); *(GAS v4u*)(dst + k * 8) = o; } }
    __syncthreads();
}
DEV void split_bf16(const float (&x)[8], bf16x8& hi, bf16x8& lo) {
    unsigned h[4], l[4];
#pragma unroll
    for (int j = 0; j < 4; ++j) { h[j] = pk2(x[2 * j], x[2 * j + 1]); l[j] = pk2(x[2 * j] - bflo(h[j]), x[2 * j + 1] - bfhi(h[j])); }
    const v4u hv = (v4u){h[0], h[1], h[2], h[3]}, lv = (v4u){l[0], l[1], l[2], l[3]};
    hi = __builtin_bit_cast(bf16x8, hv); lo = __builtin_bit_cast(bf16x8, lv);
}
DEV void hyf_item(const Frame& F, int l, int item) {
    int lane = F.lane; asm volatile("" : "+v"(lane)); const int cg = item >> 5, tr = item & 31, fr = lane & 15, fq = lane >> 4;
    const float* w3 = F.I(17) + (size_t)l * 64 * 4096; const float* hdn = F.W<float>(WS_HDN) + (size_t)l * M * 64; bf16* filt = F.W<bf16>(WS_MIX);
    bf16x8 bh[4][2], bl[4][2]; float rate[4];
#pragma unroll
    for (int ct = 0; ct < 4; ++ct) { const int col = 64 * cg + 16 * ct + fr; rate[ct] = -fabsf(((const GAS float*)F.I(19))[l * 4096 + col]) * (1.0f / 16383.0f);
#pragma unroll
        for (int s = 0; s < 2; ++s) { float x[8];
#pragma unroll
            for (int j = 0; j < 8; ++j) x[j] = ((const GAS float*)w3)[(size_t)(32 * s + 8 * fq + j) * 4096 + col];
            split_bf16(x, bh[ct][s], bl[ct][s]); } }
    LAS unsigned char* wt = F.lds + F.wave * 9216;
    for (int tg = 0; tg < 8; ++tg) {
#pragma unroll
      for (int t4 = 0; t4 < 4; ++t4) { const int tb = tr * 512 + (tg * 4 + t4) * 16; const GAS f32x4* ap = (const GAS f32x4*)(hdn + (size_t)(tb + fr) * 64 + 8 * fq);
        bf16x8 ah[2], al[2];
#pragma unroll
        for (int s = 0; s < 2; ++s) { const f32x4 a0 = ap[8 * s], a1 = ap[8 * s + 1]; const float x[8] = {a0[0], a0[1], a0[2], a0[3], a1[0], a1[1], a1[2], a1[3]}; split_bf16(x, ah[s], al[s]); }
#pragma unroll
        for (int ct = 0; ct < 4; ++ct) { f32x4 acc = (f32x4){0.f, 0.f, 0.f, 0.f};
#pragma unroll
            for (int s = 0; s < 2; ++s) { acc = mfma16(al[s], bh[ct][s], acc); acc = mfma16(ah[s], bl[ct][s], acc); acc = mfma16(ah[s], bh[ct][s], acc); }
            const int t = tb + 4 * fq; float y[4];
#pragma unroll
            for (int e = 0; e < 4; ++e) y[e] = acc[e] * __expf((float)(t + e) * rate[ct]);
            v2u o; o.x = pk2(y[0], y[1]); o.y = pk2(y[2], y[3]); *(LAS v2u*)(wt + ct * 2304 + fr * 144 + t4 * 32 + fq * 8) = o; } }
      LDS_WAIT();
#pragma unroll
      for (int ct = 0; ct < 4; ++ct)
#pragma unroll
          for (int it = 0; it < 2; ++it) { const int row = lane >> 2, ch = (lane & 3) + 4 * it; const v4u v = *(const LAS v4u*)(wt + ct * 2304 + row * 144 + ch * 16);
              *(GAS v4u*)(filt + (size_t)(64 * cg + 16 * ct + row) * M + tr * 512 + tg * 64 + ch * 8) = v; }
      LDS_WAIT();
    }
}
template <bool PHASE_C> DEV void lru_unit(const Frame& F, int l, int n, int h) {
    int tid = F.tid; asm volatile("" : "+v"(tid)); const int t0 = n * 128, lane = tid & 63, w = F.wave, fr = lane & 15, fq = lane >> 4;
    LAS unsigned char* RAW = F.lds; LAS unsigned char* XCF = F.lds + 33792; LAS unsigned char* XCB = F.lds + 33792 + 67584;
    const bf16* LX = F.W<bf16>(WS_PROJ + 32 * MiB);
    const int cw16 = 16 * w + fr, cg = h * 128 + cw16;
    const float* CIN = F.W<float>(WS_LRUC) + 4 * 128 * 1024;
    const float* cw = F.I(3) + l * 4 * 1024; const float* cb = F.I(4) + l * 1024; const int c4 = tid & 31, c = h * 128 + c4 * 4;
    v4u vv[5];
#pragma unroll
    for (int k = 0; k < 5; ++k) { const int task = tid + 512 * k, r = (task >> 4) > 130 ? 130 : (task >> 4), ch = task & 15, t = t0 - 2 + r, tc = t < 0 ? 0 : (t > M - 1 ? M - 1 : t);
        vv[k] = *(const GAS v4u*)(LX + (size_t)tc * 1024 + h * 128 + ch * 8); if (t != tc) vv[k] = (v4u){0u, 0u, 0u, 0u}; }
    const f32x4 bias = *(const GAS f32x4*)(cb + c), w0 = *(const GAS f32x4*)(cw + c), w1 = *(const GAS f32x4*)(cw + 1024 + c), w2 = *(const GAS f32x4*)(cw + 2048 + c), w3 = *(const GAS f32x4*)(cw + 3072 + c);
    float brv2[2], biv2[2], lam2[2], cin2[2];
#pragma unroll
    for (int d = 0; d < 2; ++d) {
        const int pidx = (l * 2 + d) * 1024 + cg; brv2[d] = ((const GAS float*)F.I(6))[pidx]; biv2[d] = ((const GAS float*)F.I(8))[pidx]; lam2[d] = ((const GAS float*)F.I(9))[pidx];
        cin2[d] = PHASE_C ? ((const GAS float*)CIN)[(d * 128 + n) * 1024 + cg] : 0.f; }
#pragma unroll
    for (int k = 0; k < 5; ++k) { const int task = tid + 512 * k, r = task >> 4, ch = task & 15; if (task < 131 * 16) *(LAS v4u*)(RAW + r * 256 + ch * 16) = vv[k]; }
    __syncthreads();
    {
#pragma unroll
      for (int k = 0; k < 8; ++k) { const int t = (tid >> 5) + 16 * k; f32x4 a = bias;
          const v2u r0 = *(const LAS v2u*)(RAW + (t + 0) * 256 + c4 * 8), r1 = *(const LAS v2u*)(RAW + (t + 1) * 256 + c4 * 8), r2 = *(const LAS v2u*)(RAW + (t + 2) * 256 + c4 * 8), r3 = *(const LAS v2u*)(RAW + (t + 3) * 256 + c4 * 8);
          a[0] += w0[0] * bflo(r0.x) + w1[0] * bflo(r1.x) + w2[0] * bflo(r2.x) + w3[0] * bflo(r3.x); a[1] += w0[1] * bfhi(r0.x) + w1[1] * bfhi(r1.x) + w2[1] * bfhi(r2.x) + w3[1] * bfhi(r3.x);
          a[2] += w0[2] * bflo(r0.y) + w1[2] * bflo(r1.y) + w2[2] * bflo(r2.y) + w3[2] * bflo(r3.y); a[3] += w0[3] * bfhi(r0.y) + w1[3] * bfhi(r1.y) + w2[3] * bfhi(r2.y) + w3[3] * bfhi(r3.y);
          *(LAS f32x4*)(XCF + t * 528 + c4 * 16) = a; v2u pb; pb.x = pk2(a[0], a[1]); pb.y = pk2(a[2], a[3]); *(LAS v2u*)(XCB + t * 272 + c4 * 8) = pb; } }
    __syncthreads();
    float* AP = F.W<float>(WS_LRUC); float* BE = AP + 2 * 128 * 1024;
    float hs[8][4];
#pragma unroll
    for (int d = 0; d < 2; ++d) {
        const bf16* wg = F.W<bf16>(WS_WGT) + ((((size_t)(l * 2 + d) * 2) * 8 + h) * 128 + cw16) * 128;
        bf16x8 br_[4], bi_[4];
#pragma unroll
        for (int s = 0; s < 4; ++s) { br_[s] = *(const GAS bf16x8*)(wg + 32 * s + 8 * fq); bi_[s] = *(const GAS bf16x8*)(wg + (size_t)8 * 128 * 128 + 32 * s + 8 * fq); }
        const float brv = brv2[d], biv = biv2[d], sp = log1pf(__expf(-lam2[d]));
        const int bp16 = 4 * (d == 0 ? (lane >= 16 ? lane - 16 : lane) : (lane < 48 ? lane + 16 : lane)), bp32 = 4 * (d == 0 ? (lane >= 32 ? lane - 32 : lane) : (lane < 32 ? lane + 32 : lane)), bpt = 4 * (d == 0 ? fr + 48 : fr);
#define BPERM(addr, x) __builtin_bit_cast(float, __builtin_amdgcn_ds_bpermute((addr), __builtin_bit_cast(int, (x))))
        float hin = cin2[d], CA = 1.f, CB = 0.f;
#pragma unroll
        for (int hf = 0; hf < 4; ++hf) { const int mb = (d == 0 ? hf : 3 - hf) * 2;
        f32x4 pra[2], pia[2];
#pragma unroll
        for (int m4 = 0; m4 < 2; ++m4) { const int m = mb + m4;
            f32x4 pr = (f32x4){0.f, 0.f, 0.f, 0.f}, pi = (f32x4){0.f, 0.f, 0.f, 0.f};
#pragma unroll
            for (int s = 0; s < 4; ++s) { const bf16x8 a = lfrag(XCB, 16 * m, s, 272, fr, fq); pr = mfma16(a, br_[s], pr); pi = mfma16(a, bi_[s], pi); }
#pragma unroll
            for (int e = 0; e < 4; ++e) { const int tk = 16 * m + 4 * fq + e; const float xc = *(const LAS float*)(XCF + tk * 528 + cw16 * 4);
                const float r = sigmoidf_(pr[e] + brv), ig = sigmoidf_(pi[e] + biv), la = -8.f * r * sp;
                const float av = __expf(la), om = (1.f - av) * (1.f + av);
                pr[e] = av; pi[e] = __builtin_amdgcn_sqrtf(om) * ig * xc; }
            pra[m4] = pr; pia[m4] = pi; }
#pragma unroll
        for (int mm = 0; mm < 2; ++mm) { const int m4 = d == 0 ? mm : 1 - mm, m = mb + m4; const f32x4 pr = pra[m4], pi = pia[m4];
            float A = 1.f, B = 0.f;
#pragma unroll
            for (int rr = 0; rr < 4; ++rr) { const int e = d == 0 ? rr : 3 - rr; B = pr[e] * B + pi[e]; A = A * pr[e]; }
            float EA, EB, TA, TB;
            { float A1 = BPERM(bp16, A), B1 = BPERM(bp16, B); if (d == 0 ? fq >= 1 : fq <= 2) { B = A * B1 + B; A = A1 * A; }
              A1 = BPERM(bp32, A); B1 = BPERM(bp32, B); if (d == 0 ? fq >= 2 : fq <= 1) { B = A * B1 + B; A = A1 * A; }
              EA = BPERM(bp16, A); EB = BPERM(bp16, B); if (d == 0 ? fq == 0 : fq == 3) { EA = 1.f; EB = 0.f; }
              TA = BPERM(bpt, A); TB = BPERM(bpt, B); }
            if (PHASE_C) { float hc = EA * hin + EB;
#pragma unroll
                for (int rr = 0; rr < 4; ++rr) { const int e = d == 0 ? rr : 3 - rr; hc = pr[e] * hc + pi[e]; if (d == 0) hs[m][e] = hc; else hs[m][e] += hc; } }
            hin = TA * hin + TB; CB = TA * CB + TB; CA = CA * TA; }
        __builtin_amdgcn_sched_barrier(0); }
#undef BPERM
        if (!PHASE_C && fq == 0) { ((GAS float*)AP)[(d * 128 + n) * 1024 + cg] = CA; ((GAS float*)BE)[(d * 128 + n) * 1024 + cg] = CB; }
    }
    if (PHASE_C) {
        bf16* MIX = F.W<bf16>(WS_MIX); const bf16* LG = F.W<bf16>(WS_PROJ); const float* gn = F.I(10) + l * 1024 + h * 128;
        v4u lgv[4];
#pragma unroll
        for (int k = 0; k < 4; ++k) { const int task = tid + 512 * k, t = task >> 4, ch = task & 15; lgv[k] = *(const GAS v4u*)(LG + (size_t)(t0 + t) * 1024 + h * 128 + ch * 8); }
        const f32x4 gn0 = *(const GAS f32x4*)(gn + (tid & 15) * 8), gn1 = *(const GAS f32x4*)(gn + (tid & 15) * 8 + 4);
        __syncthreads();
#pragma unroll
        for (int m = 0; m < 8; ++m)
#pragma unroll
            for (int e = 0; e < 4; ++e) *(LAS float*)(XCF + (16 * m + 4 * fq + e) * 528 + cw16 * 4) = hs[m][e];
        __syncthreads();
#pragma unroll
        for (int k = 0; k < 4; ++k) { const int task = tid + 512 * k, t = task >> 4, ch = task & 15;
            const f32x4 h0 = *(const LAS f32x4*)(XCF + t * 528 + ch * 32), h1 = *(const LAS f32x4*)(XCF + t * 528 + ch * 32 + 16);
            const v4u lg = lgv[k];
            float y[8]; y[0] = bflo(lg.x) * h0[0]; y[1] = bfhi(lg.x) * h0[1]; y[2] = bflo(lg.y) * h0[2]; y[3] = bfhi(lg.y) * h0[3];
            y[4] = bflo(lg.z) * h1[0]; y[5] = bfhi(lg.z) * h1[1]; y[6] = bflo(lg.w) * h1[2]; y[7] = bfhi(lg.w) * h1[3];
            float ss = 0.f;
#pragma unroll
            for (int e = 0; e < 8; ++e) ss += y[e] * y[e];
            ss += shx(ss, 1, lane); ss += shx(ss, 2, lane); ss += shx(ss, 4, lane); ss += shx(ss, 8, lane);
            const float rinv = rsqrtf(ss * (1.f / 128.f) + EPS); const f32x4 g0 = gn0, g1 = gn1;
            v4u o; o.x = pk2(y[0] * rinv * g0[0], y[1] * rinv * g0[1]); o.y = pk2(y[2] * rinv * g0[2], y[3] * rinv * g0[3]);
            o.z = pk2(y[4] * rinv * g1[0], y[5] * rinv * g1[1]); o.w = pk2(y[6] * rinv * g1[2], y[7] * rinv * g1[3]);
            *(GAS v4u*)(MIX + (size_t)(t0 + t) * 4096 + h * 128 + ch * 8) = o; }
    }
    __syncthreads();
}
DEV void reta_unit(const Frame& F, int n, int h) {
    int tid = F.tid; asm volatile("" : "+v"(tid)); const int t0 = n * 128, lane = tid & 63, w = F.wave, fr = lane & 15, fq = lane >> 4;
    LAS unsigned char* KTF = F.lds; LAS unsigned char* KTB = F.lds + 34816; LAS unsigned char* VT = F.lds + 69632;
    const bf16* Kr = F.W<bf16>(WS_PROJ + 192 * MiB); const bf16* V = F.W<bf16>(WS_PROJ + 224 * MiB); bf16* KV = F.W<bf16>(WS_KV);
    const float l2g = log2f(1.f - exp2f(-5.f - (float)h));
    v4u kr0[2], kr1[2], vr0[4], vr1[4];
#pragma unroll
    for (int k = 0; k < 2; ++k) { const int task = tid + 512 * k, p = task & 63, ch = task >> 6, c0 = 2 * p;
        kr0[k] = *(const GAS v4u*)(Kr + (size_t)(t0 + c0) * 1024 + h * 128 + ch * 8); kr1[k] = *(const GAS v4u*)(Kr + (size_t)(t0 + c0 + 1) * 1024 + h * 128 + ch * 8); }
#pragma unroll
    for (int k = 0; k < 4; ++k) { const int task = tid + 512 * k, p = task & 63, ch = task >> 6, c0 = 2 * p;
        vr0[k] = *(const GAS v4u*)(V + (size_t)(t0 + c0) * 2048 + h * 256 + ch * 8); vr1[k] = *(const GAS v4u*)(V + (size_t)(t0 + c0 + 1) * 2048 + h * 256 + ch * 8); }
#pragma unroll
    for (int k = 0; k < 2; ++k) { const int task = tid + 512 * k, p = task & 63, ch = task >> 6, c0 = 2 * p;
        const v4u r0 = kr0[k], r1 = kr1[k];
        const float ff0 = __builtin_amdgcn_exp2f((float)(127 - c0) * l2g), ff1 = __builtin_amdgcn_exp2f((float)(126 - c0) * l2g), fb0 = __builtin_amdgcn_exp2f((float)c0 * l2g), fb1 = __builtin_amdgcn_exp2f((float)(c0 + 1) * l2g);
#define KT_ST(E) { const float k0 = bfe<E>(r0), k1 = bfe<E>(r1); *(LAS unsigned*)(KTF + (ch * 8 + E) * 272 + c0 * 2) = pk2(k0 * ff0, k1 * ff1); *(LAS unsigned*)(KTB + (ch * 8 + E) * 272 + c0 * 2) = pk2(k0 * fb0, k1 * fb1); }
        KT_ST(0) KT_ST(1) KT_ST(2) KT_ST(3) KT_ST(4) KT_ST(5) KT_ST(6) KT_ST(7)
#undef KT_ST
    }
#pragma unroll
    for (int k = 0; k < 4; ++k) { const int task = tid + 512 * k, p = task & 63, ch = task >> 6, c0 = 2 * p;
        const v4u r0 = vr0[k], r1 = vr1[k];
#define VT_ST(E) { *(LAS unsigned*)(VT + (ch * 8 + E) * 272 + c0 * 2) = pk2(bfe<E>(r0), bfe<E>(r1)); }
        VT_ST(0) VT_ST(1) VT_ST(2) VT_ST(3) VT_ST(4) VT_ST(5) VT_ST(6) VT_ST(7)
#undef VT_ST
    }
    __syncthreads();
    f32x4 acc[2][8][2];
#pragma unroll
    for (int a = 0; a < 2; ++a)
#pragma unroll
        for (int b = 0; b < 8; ++b)
#pragma unroll
            for (int c = 0; c < 2; ++c) acc[a][b][c] = (f32x4){0.f, 0.f, 0.f, 0.f};
#pragma unroll
    for (int s = 0; s < 4; ++s) { const bf16x8 bv0 = lfrag(VT, 32 * w, s, 272, fr, fq), bv1 = lfrag(VT, 32 * w + 16, s, 272, fr, fq);
#pragma unroll
        for (int dt = 0; dt < 8; ++dt) { const bf16x8 af = lfrag(KTF, 16 * dt, s, 272, fr, fq), ab = lfrag(KTB, 16 * dt, s, 272, fr, fq);
            acc[0][dt][0] = mfma16(af, bv0, acc[0][dt][0]); acc[0][dt][1] = mfma16(af, bv1, acc[0][dt][1]);
            acc[1][dt][0] = mfma16(ab, bv0, acc[1][dt][0]); acc[1][dt][1] = mfma16(ab, bv1, acc[1][dt][1]); } }
#pragma unroll
    for (int dir = 0; dir < 2; ++dir)
#pragma unroll
        for (int dt = 0; dt < 8; ++dt)
#pragma unroll
            for (int et = 0; et < 2; ++et) { const f32x4 a = acc[dir][dt][et]; v2u o; o.x = pk2(a[0], a[1]); o.y = pk2(a[2], a[3]);
                *(GAS v2u*)(KV + ((size_t)(dir * 128 + n) * 8 + h) * 32768 + (32 * w + 16 * et + fr) * 128 + 16 * dt + 4 * fq) = o; }
    __syncthreads();
}

DEV void lrub_all(const Frame& F) {
    const GAS float* AP = (const GAS float*)F.W<float>(WS_LRUC); const GAS float* BE = AP + 2 * 128 * 1024; GAS float* CIN = (GAS float*)F.W<float>(WS_LRUC) + 4 * 128 * 1024;
    for (int idx = F.vcu * 512 + F.tid; idx < 2048; idx += F.G * 512) { const int d = idx >> 10, c = idx & 1023; float s = 0.f;
        for (int it0 = 0; it0 < 128; it0 += 16) { float a[16], b[16];
#pragma unroll
            for (int j = 0; j < 16; ++j) { const int it = it0 + j, n = d ? 127 - it : it, o = (d * 128 + n) * 1024 + c; a[j] = AP[o]; b[j] = BE[o]; }
#pragma unroll
            for (int j = 0; j < 16; ++j) { const int it = it0 + j, n = d ? 127 - it : it, o = (d * 128 + n) * 1024 + c; CIN[o] = s; s = a[j] * s + b[j]; } } }
}
DEV void retb_all(const Frame& F) {
    GAS bf16* KV = (GAS bf16*)F.W<bf16>(WS_KV);
    for (int idx = F.vcu * 512 + F.tid; idx < 131072; idx += F.G * 512) { const int dir = idx >> 16, h = (idx >> 13) & 7, off = (idx & 8191) * 4;
        const float dec = exp2f(128.f * log2f(1.f - exp2f(-5.f - (float)h))); float s0 = 0.f, s1 = 0.f, s2 = 0.f, s3 = 0.f;
        for (int it0 = 0; it0 < 128; it0 += 16) { v2u v[16];
#pragma unroll
            for (int j = 0; j < 16; ++j) { const int it = it0 + j, n = dir ? 127 - it : it; v[j] = *(const GAS v2u*)(KV + ((size_t)(dir * 128 + n) * 8 + h) * 32768 + off); }
#pragma unroll
            for (int j = 0; j < 16; ++j) { const int it = it0 + j, n = dir ? 127 - it : it; v2u o; o.x = pk2(s0, s1); o.y = pk2(s2, s3); *(GAS v2u*)(KV + ((size_t)(dir * 128 + n) * 8 + h) * 32768 + off) = o;
                s0 = dec * s0 + bflo(v[j].x); s1 = dec * s1 + bfhi(v[j].x); s2 = dec * s2 + bflo(v[j].y); s3 = dec * s3 + bfhi(v[j].y); } } }
}
DEV int rev14(int p) { const unsigned r = __builtin_bitreverse32((unsigned)p) >> 18; return (int)(((r & 0x1555u) << 1) | ((r >> 1) & 0x1555u)); }
DEV f32x2 twid(const LAS f32x2* TH, const LAS f32x2* TL, int e) { return cmul(TH[e >> 7], TL[e & 127]); }
constexpr int FFT_IM_OFF = 69632, FFT_TAB_OFF = 139264;
DEV int ppad(int p) { return p + 4 * (p >> 6); }
struct cpx2 { f32x2 r, i; };
DEV cpx2 cmul2(const cpx2 a, const cpx2 b) { cpx2 c; c.r = a.r * b.r - a.i * b.i; c.i = a.r * b.i + a.i * b.r; return c; }
DEV cpx2 cmulc(const cpx2 a, float cr, float ci) { cpx2 c; c.r = a.r * cr - a.i * ci; c.i = a.r * ci + a.i * cr; return c; }
DEV void r4p(cpx2& a0, cpx2& a1, cpx2& a2, cpx2& a3) {
    const f32x2 b0r = a0.r + a2.r, b0i = a0.i + a2.i, b1r = a0.r - a2.r, b1i = a0.i - a2.i, b2r = a1.r + a3.r, b2i = a1.i + a3.i, tr = a1.r - a3.r, ti = a1.i - a3.i;
    a0.r = b0r + b2r; a0.i = b0i + b2i; a1.r = b1r + ti; a1.i = b1i - tr; a2.r = b0r - b2r; a2.i = b0i - b2i; a3.r = b1r - ti; a3.i = b1i + tr;
}
template <bool DIT> DEV void r16_core(cpx2 (&e)[16], const cpx2 w) {
    const cpx2 ww = cmul2(w, w), w4 = cmul2(ww, ww), w8 = cmul2(w4, w4), w12 = cmul2(w8, w4);
    if (DIT) {
#pragma unroll
        for (int p = 0; p < 4; ++p) { e[4 * p + 1] = cmul2(e[4 * p + 1], w4); e[4 * p + 2] = cmul2(e[4 * p + 2], w8); e[4 * p + 3] = cmul2(e[4 * p + 3], w12); r4p(e[4 * p], e[4 * p + 1], e[4 * p + 2], e[4 * p + 3]); }
    }
#pragma unroll
    for (int r = 0; r < 4; ++r) {
        const cpx2 w1 = r == 0 ? w : r == 1 ? cmulc(w, 0.9238795325112867f, -0.3826834323650898f) : r == 2 ? cmulc(w, 0.7071067811865476f, -0.7071067811865476f) : cmulc(w, 0.3826834323650898f, -0.9238795325112867f);
        const cpx2 w2 = cmul2(w1, w1), w3 = cmul2(w2, w1);
        if (DIT) { e[r + 4] = cmul2(e[r + 4], w1); e[r + 8] = cmul2(e[r + 8], w2); e[r + 12] = cmul2(e[r + 12], w3); }
        r4p(e[r], e[r + 4], e[r + 8], e[r + 12]);
        if (!DIT) { e[r + 4] = cmul2(e[r + 4], w1); e[r + 8] = cmul2(e[r + 8], w2); e[r + 12] = cmul2(e[r + 12], w3); }
    }
    if (!DIT) {
#pragma unroll
        for (int p = 0; p < 4; ++p) { r4p(e[4 * p], e[4 * p + 1], e[4 * p + 2], e[4 * p + 3]); e[4 * p + 1] = cmul2(e[4 * p + 1], w4); e[4 * p + 2] = cmul2(e[4 * p + 2], w8); e[4 * p + 3] = cmul2(e[4 * p + 3], w12); }
    }
}
template <bool DIT, int LQ16> DEV void r16_pass(LAS unsigned char* lds, const LAS f32x2* TH, const LAS f32x2* TL, int tid) {
    constexpr int q16 = 1 << LQ16, sp = q16 >= 64 ? q16 + 4 * (q16 >> 6) : q16;
    asm volatile("" : "+v"(tid));
    int g, i;
    if (LQ16 == 10) { g = 0; i = 2 * tid; } else if (LQ16 == 6) { g = tid >> 5; i = 2 * (tid & 31); } else { g = tid >> 1; i = 2 * (tid & 1); }
    const int p0 = ppad((g << (LQ16 + 4)) + i);
    const LAS float* RE = (const LAS float*)lds; const LAS float* IM = (const LAS float*)(lds + FFT_IM_OFF);
    const f32x2 wA = twid(TH, TL, i << (10 - LQ16)), wB = twid(TH, TL, (i + 1) << (10 - LQ16));
    cpx2 w; w.r = (f32x2){wA.x, wB.x}; w.i = (f32x2){wA.y, wB.y};
    cpx2 e[16];
#pragma unroll
    for (int r = 0; r < 16; ++r) { e[r].r = *(const LAS f32x2*)(RE + p0 + r * sp); e[r].i = *(const LAS f32x2*)(IM + p0 + r * sp); }
    r16_core<DIT>(e, w);
#pragma unroll
    for (int r = 0; r < 16; ++r) { *(LAS f32x2*)((LAS float*)RE + p0 + r * sp) = e[r].r; *(LAS f32x2*)((LAS float*)IM + p0 + r * sp) = e[r].i; }
    __syncthreads();
}
DEV void r4_pass(LAS unsigned char* lds, int tid) {
    asm volatile("" : "+v"(tid));
    LAS float* RE = (LAS float*)lds; LAS float* IM = (LAS float*)(lds + FFT_IM_OFF);
#pragma unroll
    for (int hh = 0; hh < 2; ++hh) { f32x4 R[4], I[4];
#pragma unroll
        for (int c = 0; c < 4; ++c) { const int g = tid + 512 * (4 * hh + c), p = 4 * g + 4 * (g >> 4); R[c] = *(const LAS f32x4*)(RE + p); I[c] = *(const LAS f32x4*)(IM + p); }
#pragma unroll
        for (int c = 0; c < 4; ++c) { const int g = tid + 512 * (4 * hh + c), p = 4 * g + 4 * (g >> 4);
            const float b0r = R[c][0] + R[c][2], b0i = I[c][0] + I[c][2], b1r = R[c][0] - R[c][2], b1i = I[c][0] - I[c][2], b2r = R[c][1] + R[c][3], b2i = I[c][1] + I[c][3], tr = R[c][1] - R[c][3], ti = I[c][1] - I[c][3];
            *(LAS f32x4*)(RE + p) = (f32x4){b0r + b2r, b1r + ti, b0r - b2r, b1r - ti}; *(LAS f32x4*)(IM + p) = (f32x4){b0i + b2i, b1i - tr, b0i - b2i, b1i + tr}; } }
    __syncthreads();
}
DEV void fft_dif(LAS unsigned char* lds, const LAS f32x2* TH, const LAS f32x2* TL, int tid) {
    r16_pass<false, 10>(lds, TH, TL, tid); r16_pass<false, 6>(lds, TH, TL, tid); r16_pass<false, 2>(lds, TH, TL, tid); r4_pass(lds, tid);
}
DEV void fft_dit(LAS unsigned char* lds, const LAS f32x2* TH, const LAS f32x2* TL, int tid) {
    r4_pass(lds, tid); r16_pass<true, 2>(lds, TH, TL, tid); r16_pass<true, 6>(lds, TH, TL, tid); r16_pass<true, 10>(lds, TH, TL, tid);
}
DEV f32x2 fb_ld(const LAS unsigned char* lds, int p) { const int q = ppad(p); return (f32x2){((const LAS float*)lds)[q], ((const LAS float*)(lds + FFT_IM_OFF))[q]}; }
DEV void fb_st(LAS unsigned char* lds, int p, const f32x2 v) { const int q = ppad(p); ((LAS float*)lds)[q] = v.x; ((LAS float*)(lds + FFT_IM_OFF))[q] = v.y; }
DEV void hy_pair(const f32x2 Z, const f32x2 Zp, const f32x2 G, const f32x2 Gq, const f32x2 w, f32x2& o0, f32x2& o1) {
    const float invN = 1.0f / 16384.0f;
    const f32x2 Ze = (f32x2){0.5f * (Z.x + Zp.x), 0.5f * (Z.y - Zp.y)}, Zo = (f32x2){0.5f * (Z.y + Zp.y), -0.5f * (Z.x - Zp.x)};
    const f32x2 Ge = (f32x2){0.5f * (G.x + Gq.x), 0.5f * (G.y - Gq.y)}, Go = (f32x2){0.5f * (G.y + Gq.y), -0.5f * (G.x - Gq.x)};
    const f32x2 wZo = cmul(w, Zo), wGo = cmul(w, Go), U = cmul(Ze + wZo, Ge + wGo), V = cmul(Ze - wZo, Ge - wGo);
    const f32x2 Ye = 0.5f * (U + V), Yo = 0.5f * cmul(U - V, (f32x2){w.x, -w.y});
    o0 = (f32x2){(Ye.x - Yo.y) * invN, -(Ye.y + Yo.x) * invN}; o1 = (f32x2){(Ye.x + Yo.y) * invN, (Ye.y - Yo.x) * invN};
}
struct RetbJob { GAS bf16* p; int step; float dec, s0, s1, s2, s3; int left; };
DEV RetbJob retb_begin(const Frame& F) {
    RetbJob j; const int idx = F.vcu * 512 + F.tid; j.left = 0; j.p = (GAS bf16*)F.W<bf16>(WS_KV); j.step = 0; j.dec = 0.f; j.s0 = j.s1 = j.s2 = j.s3 = 0.f;
    if (idx < 131072 && F.G * 512 >= 131072) { const int dir = idx >> 16, h = (idx >> 13) & 7, off = (idx & 8191) * 4;
        j.p += ((size_t)(dir * 128 + (dir ? 127 : 0)) * 8 + h) * 32768 + off; j.step = dir ? -(8 * 32768) : 8 * 32768; j.dec = exp2f(128.f * log2f(1.f - exp2f(-5.f - (float)h))); j.left = 128; }
    return j;
}
template <int NB> DEV void retb_load(const RetbJob& j, v2u (&v)[NB]) {
#pragma unroll
    for (int b = 0; b < NB; ++b) v[b] = *(const GAS v2u*)(j.p + (long)b * j.step);
}
template <int NB> DEV void retb_store(RetbJob& j, const v2u (&v)[NB]) {
#pragma unroll
    for (int b = 0; b < NB; ++b) if (b < j.left) { v2u o; o.x = pk2(j.s0, j.s1); o.y = pk2(j.s2, j.s3); *(GAS v2u*)(j.p + (long)b * j.step) = o;
        j.s0 = j.dec * j.s0 + bflo(v[b].x); j.s1 = j.dec * j.s1 + bfhi(v[b].x); j.s2 = j.dec * j.s2 + bflo(v[b].y); j.s3 = j.dec * j.s3 + bfhi(v[b].y); }
    const int n = j.left < NB ? j.left : NB; j.p += (long)n * j.step; j.left -= n;
}
DEV f32x2 conv_pair(unsigned wp, unsigned wc_, unsigned wn, const f32x4 k) { const float um = bfhi(wp), u0 = bflo(wc_), u1 = bfhi(wc_), u2 = bflo(wn);
    return (f32x2){k[3] + k[0] * um + k[1] * u0 + k[2] * u1, k[3] + k[0] * u0 + k[1] * u1 + k[2] * u2}; }
#define HY_LD3(rowp, wp, wc_, wn) do { _Pragma("unroll") for (int i = 0; i < 16; ++i) { const int m = tid + 512 * i, mp = m > 0 ? m - 1 : 0, mn = m < 8191 ? m + 1 : 8191;     \
    wc_[i] = *(const GAS unsigned*)((rowp) + 2 * m); wp[i] = *(const GAS unsigned*)((rowp) + 2 * mp); wn[i] = *(const GAS unsigned*)((rowp) + 2 * mn); } \
    _Pragma("unroll") for (int i = 0; i < 16; ++i) { const int m = tid + 512 * i; wp[i] = m > 0 ? wp[i] : 0u; wn[i] = m < 8191 ? wn[i] : 0u; } } while (0)
DEV void hyena_unit(const Frame& F, int l, int c, RetbJob& job) {
    int tid = F.tid; asm volatile("" : "+v"(tid));
    LAS unsigned char* FB = F.lds; LAS f32x2* TH = (LAS f32x2*)(F.lds + FFT_TAB_OFF); LAS f32x2* TL = TH + 128; LAS f32x2* T2H = TL + 128; LAS f32x2* T2L = T2H + 128;
    const bf16* FILT = F.W<bf16>(WS_MIX); const bf16* HYT = F.W<bf16>(WS_HYT); bf16* HYO = F.W<bf16>(WS_HYO);
    const bf16* zv = HYT + (size_t)c * M;
    f32x4 kz, kg0, kg1;
    { const GAS float* cw = (const GAS float*)F.I(11) + l * 3 * 3072; const GAS float* cb = (const GAS float*)F.I(12) + l * 3072;
      kz = (f32x4){cw[c], cw[3072 + c], cw[6144 + c], cb[c]}; kg0 = (f32x4){cw[1024 + c], cw[3072 + 1024 + c], cw[6144 + 1024 + c], cb[1024 + c]}; kg1 = (f32x4){cw[2048 + c], cw[3072 + 2048 + c], cw[6144 + 2048 + c], cb[2048 + c]}; }
    f32x2 Gk[16], Gq[16], Gmid;
    f32x2* Z1 = F.W<f32x2>(WS_GSCR + (size_t)blockIdx.x * 384 * 1024);
#pragma unroll
    for (int o = 0; o < 2; ++o) {
        const bf16* hf = FILT + (size_t)((2 * o) * 1024 + c) * M; const bf16* hb = FILT + (size_t)((2 * o + 1) * 1024 + c) * M;
        { unsigned wl[16]; unsigned short ha[16], hc[16]; const float hb0 = bf2f(((const GAS bf16*)hb)[0]);
#pragma unroll
          for (int i = 0; i < 16; ++i) { const int m = tid + 512 * i; wl[i] = *(const GAS unsigned*)(hf + 2 * m); ha[i] = ((const GAS bf16*)hb)[m ? 16384 - 2 * m : 0]; hc[i] = ((const GAS bf16*)hb)[16383 - 2 * m]; }
#pragma unroll
          for (int i = 0; i < 16; ++i) { const int m = tid + 512 * i; f32x2 v = (f32x2){bflo(wl[i]), bfhi(wl[i])}; if (m == 0) v.x += hb0; fb_st(FB, m, v);
              fb_st(FB, 8192 + m, (f32x2){m ? bf2f(ha[i]) : 0.f, bf2f(hc[i])}); } }
        __syncthreads();
        { v2u jv[8]; retb_load<8>(job, jv); fft_dif(FB, TH, TL, tid); retb_store<8>(job, jv); }
        asm volatile("" : "+v"(tid));
#pragma unroll
        for (int i = 0; i < 16; ++i) { const int q = 4 * (tid >> 1) + (tid & 1) + 1024 * i, k = rev14(q); Gk[i] = fb_ld(FB, q); Gq[i] = fb_ld(FB, rev14((16384 - k) & 16383)); }
        Gmid = fb_ld(FB, rev14(8192));
        __syncthreads();
        asm volatile("" : "+v"(tid));
        if (o == 0) { unsigned wp[16], wz[16], wn[16]; HY_LD3(zv, wp, wz, wn);
#pragma unroll
            for (int i = 0; i < 16; ++i) { const int m = tid + 512 * i; fb_st(FB, m, conv_pair(wp[i], wz[i], wn[i], kz)); fb_st(FB, 8192 + m, (f32x2){0.f, 0.f}); } }
        else { f32x2 zz[16];
#pragma unroll
            for (int i = 0; i < 16; ++i) zz[i] = ((const GAS f32x2*)Z1)[tid + 512 * i];
#pragma unroll
            for (int i = 0; i < 16; ++i) { const int m = tid + 512 * i; fb_st(FB, m, zz[i]); fb_st(FB, 8192 + m, (f32x2){0.f, 0.f}); } }
        __syncthreads();
        fft_dif(FB, TH, TL, tid);
        asm volatile("" : "+v"(tid));
        {
#pragma unroll
          for (int hb_ = 0; hb_ < 2; ++hb_) { asm volatile("" : "+v"(tid)); f32x2 Z[8], Zp[8]; int kk[8], fpp[8];
#pragma unroll
              for (int ii = 0; ii < 8; ++ii) { const int q = 4 * (tid >> 1) + (tid & 1) + 1024 * (8 * hb_ + ii); kk[ii] = rev14(q); fpp[ii] = rev14((16384 - kk[ii]) & 16383); Z[ii] = fb_ld(FB, q); Zp[ii] = fb_ld(FB, fpp[ii]); }
#pragma unroll
              for (int ii = 0; ii < 8; ++ii) { const int i = 8 * hb_ + ii, q = 4 * (tid >> 1) + (tid & 1) + 1024 * i; const f32x2 w = cmul(T2H[kk[ii] >> 7], T2L[kk[ii] & 127]); f32x2 o0, o1;
                  hy_pair(Z[ii], Zp[ii], Gk[i], Gq[i], w, o0, o1); fb_st(FB, q, o0); fb_st(FB, fpp[ii], o1); } }
          if (tid == 0) { const int fm = rev14(8192); const f32x2 Zm = fb_ld(FB, fm); f32x2 o0, o1; hy_pair(Zm, Zm, Gmid, Gmid, (f32x2){0.f, -1.f}, o0, o1); fb_st(FB, fm, o0); } }
        __syncthreads();
        { v2u jv[8]; retb_load<8>(job, jv); fft_dit(FB, TH, TL, tid); retb_store<8>(job, jv); }
        asm volatile("" : "+v"(tid));
        if (o == 0) { const bf16* g0 = HYT + (size_t)(1024 + c) * M; const float sk = ((const GAS float*)F.I(20))[l * 2048 + c]; f32x2 zc[16];
            { unsigned wp[16], wz[16], wn[16]; HY_LD3(zv, wp, wz, wn);
#pragma unroll
              for (int i = 0; i < 16; ++i) zc[i] = conv_pair(wp[i], wz[i], wn[i], kz); }
            { unsigned wp[16], wg[16], wn[16]; HY_LD3(g0, wp, wg, wn);
#pragma unroll
              for (int i = 0; i < 16; ++i) { const f32x2 y = fb_ld(FB, tid + 512 * i), gg = conv_pair(wp[i], wg[i], wn[i], kg0); ((GAS f32x2*)Z1)[tid + 512 * i] = (f32x2){gg.x * (y.x + sk * zc[i].x), gg.y * (-y.y + sk * zc[i].y)}; } } }
        else { const bf16* g1 = HYT + (size_t)(2048 + c) * M; const float sk = ((const GAS float*)F.I(20))[l * 2048 + 1024 + c]; unsigned wp[16], wg[16], wn[16]; f32x2 zz[16]; HY_LD3(g1, wp, wg, wn);
#pragma unroll
            for (int i = 0; i < 16; ++i) zz[i] = ((const GAS f32x2*)Z1)[tid + 512 * i];
#pragma unroll
            for (int i = 0; i < 16; ++i) { const f32x2 y = fb_ld(FB, tid + 512 * i), gg = conv_pair(wp[i], wg[i], wn[i], kg1);
                *(GAS unsigned*)(HYO + (size_t)c * M + 2 * (tid + 512 * i)) = pk2(gg.x * (y.x + sk * zz[i].x), gg.y * (-y.y + sk * zz[i].y)); } }
        __syncthreads();
    }
}
DEV void retc_unit(const Frame& F, int l, int n, int h) {
    int tid = F.tid; asm volatile("" : "+v"(tid)); const int t0 = n * 128, lane = tid & 63, w = F.wave, fr = lane & 15, fq = lane >> 4;
    LAS unsigned char* QS = F.lds; LAS unsigned char* KS = F.lds + 34816; LAS unsigned char* BIG = F.lds + 69632;
    const bf16* Qr = F.W<bf16>(WS_PROJ + 160 * MiB); const bf16* Kr = F.W<bf16>(WS_PROJ + 192 * MiB); const bf16* V = F.W<bf16>(WS_PROJ + 224 * MiB);
    const bf16* Gs = F.W<bf16>(WS_PROJ + 288 * MiB); const bf16* KV = F.W<bf16>(WS_KV); bf16* MIX = F.W<bf16>(WS_MIX);
    const float l2g = log2f(1.f - exp2f(-5.f - (float)h));
    { v4u qv[4], kv[4], vr0[4], vr1[4];
#pragma unroll
    for (int k = 0; k < 4; ++k) { const int task = tid + 512 * k, r = task >> 4, ch = task & 15;
        qv[k] = *(const GAS v4u*)(Qr + (size_t)(t0 + r) * 1024 + h * 128 + ch * 8); kv[k] = *(const GAS v4u*)(Kr + (size_t)(t0 + r) * 1024 + h * 128 + ch * 8); }
#pragma unroll
    for (int k = 0; k < 4; ++k) { const int task = tid + 512 * k, p = task & 63, ch = task >> 6, c0 = 2 * p;
        vr0[k] = *(const GAS v4u*)(V + (size_t)(t0 + c0) * 2048 + h * 256 + ch * 8); vr1[k] = *(const GAS v4u*)(V + (size_t)(t0 + c0 + 1) * 2048 + h * 256 + ch * 8); }
#pragma unroll
    for (int k = 0; k < 4; ++k) { const int task = tid + 512 * k, r = task >> 4, ch = task & 15; *(LAS v4u*)(QS + r * 272 + ch * 16) = qv[k]; *(LAS v4u*)(KS + r * 272 + ch * 16) = kv[k]; }
#pragma unroll
    for (int k = 0; k < 4; ++k) { const int task = tid + 512 * k, p = task & 63, ch = task >> 6, c0 = 2 * p;
        const v4u r0 = vr0[k], r1 = vr1[k];
#define VT_ST(E) { *(LAS unsigned*)(BIG + (ch * 8 + E) * 272 + c0 * 2) = pk2(bfe<E>(r0), bfe<E>(r1)); }
        VT_ST(0) VT_ST(1) VT_ST(2) VT_ST(3) VT_ST(4) VT_ST(5) VT_ST(6) VT_ST(7)
#undef VT_ST
    } }
    __syncthreads();
    v4u sv[8];
    { const bf16* st = KV + ((size_t)(0 * 128 + n) * 8 + h) * 32768;
#pragma unroll
      for (int k = 0; k < 8; ++k) { const int task = tid + 512 * k, r = task >> 4, ch = task & 15; sv[k] = *(const GAS v4u*)(st + r * 128 + ch * 8); } }
    bf16x8 aq[4];
#pragma unroll
    for (int s = 0; s < 4; ++s) aq[s] = lfrag(QS, 16 * w, s, 272, fr, fq);
    f32x4 S[8];
#pragma unroll
    for (int jt = 0; jt < 8; ++jt) { S[jt] = (f32x4){0.f, 0.f, 0.f, 0.f};
#pragma unroll
        for (int s = 0; s < 4; ++s) S[jt] = mfma16(aq[s], lfrag(KS, 16 * jt, s, 272, fr, fq), S[jt]);
#pragma unroll
        for (int e = 0; e < 4; ++e) { const int i = 16 * w + 4 * fq + e, j = 16 * jt + fr; S[jt][e] *= __builtin_amdgcn_exp2f(l2g * fabsf((float)(i - j))); } }
    __syncthreads();
#pragma unroll
    for (int jt = 0; jt < 8; ++jt)
#pragma unroll
        for (int e = 0; e < 4; ++e) *(LAS bf16*)(KS + (16 * w + 4 * fq + e) * 272 + (16 * jt + fr) * 2) = f2bf(S[jt][e]);
    LDS_WAIT();
    __syncthreads();
    f32x4 y[16];
    { bf16x8 ap[4];
#pragma unroll
      for (int s = 0; s < 4; ++s) ap[s] = lfrag(KS, 16 * w, s, 272, fr, fq);
#pragma unroll
      for (int et = 0; et < 16; ++et) { y[et] = (f32x4){0.f, 0.f, 0.f, 0.f};
#pragma unroll
          for (int s = 0; s < 4; ++s) y[et] = mfma16(ap[s], lfrag(BIG, 16 * et, s, 272, fr, fq), y[et]);
          __builtin_amdgcn_sched_barrier(0); } }
    __syncthreads();
    const float* gn = F.I(22) + l * 2048 + h * 256;
    v4u gvv[8];
#pragma unroll
    for (int dir = 0; dir < 2; ++dir) {
#pragma unroll
        for (int k = 0; k < 8; ++k) { const int task = tid + 512 * k, r = task >> 4, ch = task & 15; *(LAS v4u*)(BIG + r * 272 + ch * 16) = sv[k]; }
        if (dir == 0) { const bf16* st = KV + ((size_t)(1 * 128 + n) * 8 + h) * 32768;
#pragma unroll
            for (int k = 0; k < 8; ++k) { const int task = tid + 512 * k, r = task >> 4, ch = task & 15; sv[k] = *(const GAS v4u*)(st + r * 128 + ch * 8); } }
        else {
#pragma unroll
            for (int k = 0; k < 8; ++k) { const int task = tid + 512 * k, t = task >> 5, ch = task & 31; gvv[k] = *(const GAS v4u*)(Gs + (size_t)(t0 + t) * 2048 + h * 256 + ch * 8); } }
        __syncthreads();
        float fac[4];
#pragma unroll
        for (int e = 0; e < 4; ++e) { const int i = 16 * w + 4 * fq + e; fac[e] = __builtin_amdgcn_exp2f(l2g * (dir == 0 ? (float)(i + 1) : (float)(128 - i))); }
#pragma unroll
        for (int et = 0; et < 16; ++et) { f32x4 t = (f32x4){0.f, 0.f, 0.f, 0.f};
#pragma unroll
            for (int s = 0; s < 4; ++s) t = mfma16(aq[s], lfrag(BIG, 16 * et, s, 272, fr, fq), t);
#pragma unroll
            for (int e = 0; e < 4; ++e) y[et][e] += fac[e] * t[e];
            __builtin_amdgcn_sched_barrier(0); }
        __syncthreads();
    }
    float rinv[4];
#pragma unroll
    for (int e = 0; e < 4; ++e) { float ss = 0.f;
#pragma unroll
        for (int et = 0; et < 16; ++et) ss += y[et][e] * y[et][e];
        ss += shx(ss, 1, lane); ss += shx(ss, 2, lane); ss += shx(ss, 4, lane); ss += shx(ss, 8, lane); rinv[e] = rsqrtf(ss * (1.f / 256.f) + EPS); }
#pragma unroll
    for (int et = 0; et < 16; ++et)
#pragma unroll
        for (int e = 0; e < 4; ++e) *(LAS bf16*)(BIG + (16 * w + 4 * fq + e) * 528 + (16 * et + fr) * 2) = f2bf(y[et][e] * rinv[e]);
    __syncthreads();
    const f32x4 g0 = *(const GAS f32x4*)(gn + (tid & 31) * 8), g1 = *(const GAS f32x4*)(gn + (tid & 31) * 8 + 4);
#pragma unroll
    for (int k = 0; k < 8; ++k) { const int task = tid + 512 * k, t = task >> 5, ch = task & 31;
        const v4u yv = *(const LAS v4u*)(BIG + t * 528 + ch * 16); const v4u gv = gvv[k];
        v4u o; o.x = pk2(bflo(yv.x) * g0[0] * bflo(gv.x), bfhi(yv.x) * g0[1] * bfhi(gv.x)); o.y = pk2(bflo(yv.y) * g0[2] * bflo(gv.y), bfhi(yv.y) * g0[3] * bfhi(gv.y));
        o.z = pk2(bflo(yv.z) * g1[0] * bflo(gv.z), bfhi(yv.z) * g1[1] * bfhi(gv.z)); o.w = pk2(bflo(yv.w) * g1[2] * bflo(gv.w), bfhi(yv.w) * g1[3] * bfhi(gv.w));
        *(GAS v4u*)(MIX + (size_t)(t0 + t) * 4096 + 2048 + h * 256 + ch * 8) = o; }
}
DEV void hyn_unit(const Frame& F, int l, int unit) {
    int tid = F.tid; asm volatile("" : "+v"(tid)); const int g = unit >> 7, t0 = (unit & 127) * 128;
    LAS float* S = (LAS float*)F.lds; LAS float* RED = S + 128 * 129;
    const bf16* HYO = F.W<bf16>(WS_HYO); bf16* MIX = F.W<bf16>(WS_MIX);
    v4u hv[4];
#pragma unroll
    for (int k = 0; k < 4; ++k) { const int task = tid + 512 * k, cc = task >> 4, ch = task & 15; hv[k] = *(const GAS v4u*)(HYO + (size_t)(128 * g + cc) * M + t0 + ch * 8); }
#pragma unroll
    for (int k = 0; k < 4; ++k) { const int task = tid + 512 * k, cc = task >> 4, ch = task & 15; const v4u v = hv[k];
        LAS float* d = S + cc * 129 + ch * 8; d[0] = bflo(v.x); d[1] = bfhi(v.x); d[2] = bflo(v.y); d[3] = bfhi(v.y); d[4] = bflo(v.z); d[5] = bfhi(v.z); d[6] = bflo(v.w); d[7] = bfhi(v.w); }
    __syncthreads();
    { const int t = tid & 127, part = tid >> 7; float ss = 0.f;
#pragma unroll 8
      for (int cc = 0; cc < 32; ++cc) { const float v = S[(32 * part + cc) * 129 + t]; ss += v * v; }
      RED[part * 128 + t] = ss; }
    __syncthreads();
    const float* gn = F.I(21) + l * 1024 + 128 * g;
    for (int task = tid; task < 2048; task += 512) { const int t = task >> 4, ch = task & 15;
        const float rinv = rsqrtf((RED[t] + RED[128 + t] + RED[256 + t] + RED[384 + t]) * (1.f / 128.f) + EPS); float y[8];
#pragma unroll
        for (int e = 0; e < 8; ++e) y[e] = S[(8 * ch + e) * 129 + t] * rinv * gn[8 * ch + e];
        v4u o; o.x = pk2(y[0], y[1]); o.y = pk2(y[2], y[3]); o.z = pk2(y[4], y[5]); o.w = pk2(y[6], y[7]);
        *(GAS v4u*)(MIX + (size_t)(t0 + t) * 4096 + 1024 + 128 * g + 8 * ch) = o; }
    __syncthreads();
}
DEV void final_norm(const Frame& F) {
    const ssq_t* ssq = F.W<ssq_t>(CTL_SSQ_OFF) + 4 * M; const float* gn = F.I(28); const bf16* xb = F.W<bf16>(WS_XB); const int gw = F.vcu * 8 + F.wave, NGW = F.G * 8, lane = F.lane;
    for (int m = gw; m < M; m += NGW) { const float rs = rstd_of(ssq, m); GAS f32x4* xo = (GAS f32x4*)(F.O() + (size_t)m * D) + lane; const GAS v2u* xi = (const GAS v2u*)(xb + (size_t)m * D) + lane; const GAS f32x4* gr = (const GAS f32x4*)gn + lane;
#pragma unroll
        for (int j = 0; j < 16; ++j) { const v2u v = xi[64 * j]; const f32x4 g = gr[64 * j]; xo[64 * j] = (f32x4){bflo(v.x) * rs * g[0], bfhi(v.x) * rs * g[1], bflo(v.y) * rs * g[2], bfhi(v.y) * rs * g[3]}; } }
}

DEV int bidx() { int c = (int)blockIdx.x; asm volatile("" : "+s"(c)); return c; }
DEV bool in_phase(int lo, int hi, int k) { asm volatile("" : "+s"(lo), "+s"(hi)); return lo <= k && k < hi; }
__global__ void __launch_bounds__(512, 2) fwd_kernel(Args args) {
    extern __shared__ __attribute__((aligned(16))) unsigned char lds_raw[];
    Frame F; F.lds = (LAS unsigned char*)lds_raw; F.tid = threadIdx.x; F.lane = F.tid & 63; F.wave = __builtin_amdgcn_readfirstlane(F.tid >> 6);
    F.G = gridDim.x; { const int bx = blockIdx.x; F.vcu = (F.G % 8 == 0) ? (bx % 8) * (F.G / 8) + bx / 8 : bx; }
    F.in = args.in; F.out = args.out; F.ws = args.ws;
    volatile LAS unsigned* MISC = (volatile LAS unsigned*)(F.lds + MISC_OFF);
    if (F.tid < 64) MISC[F.tid] = 0u;
    __syncthreads();
    const int lo = args.ph_lo, hi = args.ph_hi;
    unsigned* barw = F.W<unsigned>(WS_CTL) + CW_BAR;
    XcdBarrier bar; bar.bar = barw; bar.x = 0; bar.st = nullptr;
    if (hi - lo > 1) bar = xcd_barrier_post(barw, MISC + 8);
#ifndef G3_ALIGN
#define G3_ALIGN GEMM_ALIGN
#endif
#ifndef GEMM_ALIGN
#define GEMM_ALIGN true
#endif
#ifndef GEMM_SP2
#define GEMM_SP2 true
#endif
#ifndef REP_P0
#define REP_P0 1
#endif
#ifndef REP_G1
#define REP_G1 1
#endif
#ifndef REP_MA
#define REP_MA 1
#endif
#ifndef REP_HY
#define REP_HY 1
#endif
#ifndef REP_MC
#define REP_MC 1
#endif
#ifndef REP_G3
#define REP_G3 1
#endif
#ifndef REP_HYT
#define REP_HYT 1
#endif
#ifndef REP_HYF
#define REP_HYF 1
#endif
#ifndef REP_LRUA
#define REP_LRUA 1
#endif
#ifndef REP_RETA
#define REP_RETA 1
#endif
#ifndef REP_LRUC
#define REP_LRUC 1
#endif
#ifndef REP_RETC
#define REP_RETC 1
#endif
#ifndef REP_HYN
#define REP_HYN 1
#endif
#ifndef PHASE_EN
#define PHASE_EN 0xffffffffu
#endif
#define EN(b) ((PHASE_EN >> (b)) & 1u)
#define IN(k) in_phase(lo, hi, (k))
#define SEAM(k) do { if (IN(k) && IN((k) + 1)) { asm volatile("" : "+s"(bar.bar)); xcd_barrier(bar, F.tid == 0); } FENCE(); } while (0)
#define FENCE() do { asm volatile("" : "+s"(F.ws), "+s"(F.out)); asm volatile("" : "+s"(F.G)); int ln_; asm volatile("v_mbcnt_lo_u32_b32 %0, -1, 0\n\tv_mbcnt_hi_u32_b32 %0, -1, %0" : "=v"(ln_)); F.lane = ln_; F.tid = F.wave * 64 + ln_; } while (0)
    FENCE();
    if (EN(0) && IN(0)) { for (int rep = 0; rep < REP_P0; ++rep) p0_prologue(F, rep); }
    SEAM(0);
    for (int l = 0; l < NLAYER; ++l) {
        const int pb = 1 + 7 * l;
        if (EN(1) && IN(pb + 0)) for (int rep = 0; rep < REP_G1; ++rep) {
            bf16* XB = F.W<bf16>(WS_XB); bf16* PR = F.W<bf16>(WS_PROJ);
            pg8::Gemm g{XB, F.W<bf16>(WS_WIN + (size_t)l * 88 * MiB), M, NIN, D};
            struct SkipHu : pg8::StaticOrder { DEV bool next(int i, pg8::Unit& u) const { const bool ok = pg8::StaticOrder::next(i, u); if (u.pn >= 8) u.pn += 12; return ok; } };
            SkipHu S; S.init(M, NIN - 3072, F.G, bidx());
            EpiIn E{PR, F.W<bf16>(WS_PROJ + 32 * MiB), F.W<bf16>(WS_PROJ + 64 * MiB), F.W<bf16>(WS_PROJ + 160 * MiB), F.W<bf16>(WS_PROJ + 192 * MiB), F.W<bf16>(WS_PROJ + 224 * MiB), F.W<bf16>(WS_PROJ + 288 * MiB),
                    F.W<ssq_t>(CTL_SSQ_OFF) + (2 * l) * M, F.W<float>(WS_ROT)};
            pg8::gemm_phase<EpiIn, SkipHu, GEMM_ALIGN, GEMM_SP2>(F.lds, g, S, E, F.tid);
            pg8::Gemm g2{F.W<bf16>(WS_WIN + (size_t)l * 88 * MiB) + (size_t)2048 * D, XB, 3072, M, D}; pg8::StaticOrder S2; S2.init(3072, M, F.G, bidx());
            EpiHuT E2{F.W<bf16>(WS_HYT), F.W<ssq_t>(CTL_SSQ_OFF) + (2 * l) * M};
            pg8::gemm_phase<EpiHuT, pg8::StaticOrder, GEMM_ALIGN, GEMM_SP2>(F.lds, g2, S2, E2, F.tid);
        }
        SEAM(pb + 0);
        if (IN(pb + 1)) for (int rep = 0; rep < REP_MA; ++rep) {
            if (I8_GU(l)) wq_rows(F, l);
            if (EN(3)) for (int r2 = 0; r2 < REP_HYF; ++r2) for (int it = F.vcu * 8 + F.wave; it < 2048; it += F.G * 8) hyf_item(F, l, it);
            __syncthreads();
            if (EN(4)) for (int r2 = 0; r2 < REP_LRUA; ++r2) for (int u = F.vcu; u < 1024; u += F.G) lru_unit<false>(F, l, u >> 3, u & 7);
            if (EN(5)) for (int r2 = 0; r2 < REP_RETA; ++r2) for (int u = F.vcu; u < 1024; u += F.G) reta_unit(F, u >> 3, u & 7);
        }
        SEAM(pb + 1);
        if (IN(pb + 2)) {
            if (EN(6)) { lrub_all(F); if (F.G * 512 < 131072) retb_all(F); }
            RetbJob job = retb_begin(F);
            FENCE();
            { LAS f32x2* TH = (LAS f32x2*)(F.lds + FFT_TAB_OFF);
              if (F.tid < 128) { const float j = (float)F.tid; TH[F.tid] = (f32x2){cospif(j * (1.f / 64.f)), -sinpif(j * (1.f / 64.f))}; TH[128 + F.tid] = (f32x2){cospif(j * (1.f / 8192.f)), -sinpif(j * (1.f / 8192.f))};
                  TH[256 + F.tid] = (f32x2){cospif(j * (1.f / 128.f)), -sinpif(j * (1.f / 128.f))}; TH[384 + F.tid] = (f32x2){cospif(j * (1.f / 16384.f)), -sinpif(j * (1.f / 16384.f))}; }
              __syncthreads(); }
            if (EN(7)) for (int rep = 0; rep < REP_HY; ++rep) for (int u = F.vcu; u < 1024; u += F.G) hyena_unit(F, l, u, job);
            while (job.left > 0) { v2u jv[8]; retb_load<8>(job, jv); retb_store<8>(job, jv); }
        }
        SEAM(pb + 2);
        if (IN(pb + 3)) for (int rep = 0; rep < REP_MC; ++rep) {
            if (EN(8)) for (int r2 = 0; r2 < REP_LRUC; ++r2) for (int u = F.vcu; u < 1024; u += F.G) lru_unit<true>(F, l, u >> 3, u & 7);
            if (EN(9)) for (int r2 = 0; r2 < REP_RETC; ++r2) for (int u = F.vcu; u < 1024; u += F.G) { retc_unit(F, l, u >> 3, u & 7); __syncthreads(); }
            if (EN(10)) for (int r2 = 0; r2 < REP_HYN; ++r2) for (int u = F.vcu; u < 1024; u += F.G) hyn_unit(F, l, u);
        }
        SEAM(pb + 3);
        if (EN(11) && IN(pb + 4)) {
            bf16* XB = F.W<bf16>(WS_XB); bf16* MIX = F.W<bf16>(WS_MIX);
            pg8::Gemm g{MIX, F.W<bf16>(WS_WOUT + (size_t)l * 32 * MiB), M, D, D}; pg8::StaticOrder S; S.init(M, D, F.G, bidx());
            EpiRes E{XB, F.W<ssq_t>(CTL_SSQ_OFF) + (2 * l + 1) * M, 1.f, I8_GU(l) ? F.W<unsigned char>(WS_KV) : nullptr, F.W<ssq_t>(CTL_SSQ_OFF) + (2 * l) * M};
            pg8::gemm_phase<EpiRes, pg8::StaticOrder, GEMM_ALIGN, GEMM_SP2>(F.lds, g, S, E, F.tid);
        }
        SEAM(pb + 4);
        if (EN(12) && IN(pb + 5)) for (int rep = 0; rep < REP_G3; ++rep) {
            bf16* XB = F.W<bf16>(WS_XB); bf16* PR = F.W<bf16>(WS_PROJ);
            pg8::StaticOrder S; S.init(M, NGU, F.G, bidx());
            if (I8_GU(l)) {
                pg8::Gemm g{F.W<bf16>(WS_KV), F.W<bf16>(WS_WGU + (size_t)l * 172 * MiB), M, NGU, D / 2, D / 2, D};
                EpiGU_<2> E{(unsigned char*)PR, F.W<ssq_t>(CTL_SSQ_OFF) + (2 * l + 1) * M, FP8_DOWN(l), F.W<ssq_t>(CTL_SSQ_OFF) + (2 * l) * M, F.W<unsigned>(CTL_AMAX_OFF) + l * NGU};
                pg8::gemm_phase<EpiGU_<2>, pg8::StaticOrder, G3_ALIGN, GEMM_SP2, 2>(F.lds, g, S, E, F.tid);
            } else {
                pg8::Gemm g{XB, F.W<bf16>(WS_WGU + (size_t)l * 172 * MiB), M, NGU, D};
                EpiGU E{(unsigned char*)PR, F.W<ssq_t>(CTL_SSQ_OFF) + (2 * l + 1) * M, FP8_DOWN(l), nullptr, nullptr};
                pg8::gemm_phase<EpiGU, pg8::StaticOrder, GEMM_ALIGN, GEMM_SP2>(F.lds, g, S, E, F.tid);
            }
        }
        SEAM(pb + 5);
        if (EN(13) && IN(pb + 6)) {
            bf16* XB = F.W<bf16>(WS_XB); bf16* PR = F.W<bf16>(WS_PROJ);
            pg8::StaticOrder S; S.init(M, D, F.G, bidx());
            if (FP8_DOWN(l)) {
                pg8::Gemm g{PR, F.W<bf16>(WS_WDN + (size_t)l * 86 * MiB), M, D, DFF / 2}; EpiRes E{XB, F.W<ssq_t>(CTL_SSQ_OFF) + (2 * l + 2) * M, 1.f / 8192.f, nullptr, nullptr};
                pg8::gemm_phase<EpiRes, pg8::StaticOrder, GEMM_ALIGN, GEMM_SP2, 1>(F.lds, g, S, E, F.tid);
            } else {
                pg8::Gemm g{PR, F.W<bf16>(WS_WDN + (size_t)l * 86 * MiB), M, D, DFF}; EpiRes E{XB, F.W<ssq_t>(CTL_SSQ_OFF) + (2 * l + 2) * M, 1.f, nullptr, nullptr};
                pg8::gemm_phase<EpiRes, pg8::StaticOrder, GEMM_ALIGN, GEMM_SP2>(F.lds, g, S, E, F.tid);
            }
        }
        SEAM(pb + 6);
    }
    if (EN(14) && IN(15)) final_norm(F);
#undef IN
#undef SEAM
}

#ifndef MK_PER_PHASE
#define MK_PER_PHASE 0
#endif
extern "C" void kernel_launch(void* const* d_in, const int* in_sizes, int n_in, void* d_out, int out_size, void* d_ws, size_t ws_size, hipStream_t stream) {
    static int grid = 0;
    if (grid == 0) {
        if (n_in != 29 || in_sizes[0] != M * D || out_size != M * D || ws_size < WS_END) { fprintf(stderr, "kernel_launch: unexpected shapes / workspace (n_in %d, ws %zu < %zu); nothing launched\n", n_in, ws_size, (size_t)WS_END); grid = -1; return; }
        int dev = 0, cus = 0, per_cu = 0;
        if (hipGetDevice(&dev) != hipSuccess || hipDeviceGetAttribute(&cus, hipDeviceAttributeMultiprocessorCount, dev) != hipSuccess) { grid = -1; return; }
        if (hipFuncSetAttribute((const void*)fwd_kernel, hipFuncAttributeMaxDynamicSharedMemorySize, LDS_BYTES) != hipSuccess) { fprintf(stderr, "kernel_launch: hipFuncSetAttribute failed\n"); grid = -1; return; }
        if (hipOccupancyMaxActiveBlocksPerMultiprocessor(&per_cu, (const void*)fwd_kernel, 512, LDS_BYTES) != hipSuccess || per_cu < 1) { fprintf(stderr, "kernel_launch: occupancy query says %d blocks per CU\n", per_cu); }
        (void)hipGetLastError();
        grid = cus;
    }
    if (grid < 0) return;
    if (hipMemsetAsync((char*)d_ws + WS_CTL, 0, CTL_BYTES, stream) != hipSuccess) return;
    Args a{};
    for (int i = 0; i < 29; ++i) a.in[i] = (const float*)d_in[i];
    a.out = (float*)d_out; a.ws = (unsigned char*)d_ws;
#if MK_PER_PHASE
    for (int p = 0; p < NPH; ++p) { a.ph_lo = p; a.ph_hi = p + 1; hipLaunchKernelGGL(fwd_kernel, dim3(grid), dim3(512), LDS_BYTES, stream, a); }
#else
    a.ph_lo = 0; a.ph_hi = NPH; hipLaunchKernelGGL(fwd_kernel, dim3(grid), dim3(512), LDS_BYTES, stream, a);
#endif
}
```

```cpp
#include <hip/hip_runtime.h>
#include <cstdio>
#include <cstdint>

#define DEV __device__ __forceinline__
#define GAS __attribute__((address_space(1)))
#define LAS __attribute__((address_space(3)))
typedef unsigned short bf16;
typedef unsigned v4u __attribute__((ext_vector_type(4)));
typedef unsigned v2u __attribute__((ext_vector_type(2)));
typedef float f32x4 __attribute__((ext_vector_type(4)));
typedef float f32x2 __attribute__((ext_vector_type(2)));
typedef short bf16x8 __attribute__((ext_vector_type(8)));
typedef int v8i __attribute__((ext_vector_type(8)));
typedef int v4i __attribute__((ext_vector_type(4)));

constexpr int M = 16384, D = 4096, DL = 1024, DH = 1024, DR = 2048, NIN = 11264, DFF = 11008, NGU = 22016, NLAYER = 2;
constexpr float EPS = 1e-6f;

DEV float bflo(unsigned w) { return __uint_as_float(w << 16); }
DEV float bfhi(unsigned w) { return __uint_as_float(w & 0xffff0000u); }
DEV float bf2f(bf16 v) { return __uint_as_float(((unsigned)v) << 16); }
DEV unsigned pk2(float lo, float hi) { unsigned r; asm volatile("v_cvt_pk_bf16_f32 %0, %1, %2" : "=v"(r) : "v"(lo), "v"(hi)); return r; }
DEV unsigned pk4_fp8(float a, float b, float c, float d) {
    a = __builtin_amdgcn_fmed3f(a, -448.f, 448.f); b = __builtin_amdgcn_fmed3f(b, -448.f, 448.f); c = __builtin_amdgcn_fmed3f(c, -448.f, 448.f); d = __builtin_amdgcn_fmed3f(d, -448.f, 448.f);
    int w = 0; w = __builtin_amdgcn_cvt_pk_fp8_f32(a, b, w, false); w = __builtin_amdgcn_cvt_pk_fp8_f32(c, d, w, true); return (unsigned)w; }
DEV unsigned pk4_i8(float a, float b, float c, float d) {
    const int ia = (int)__builtin_rintf(__builtin_amdgcn_fmed3f(a, -127.f, 127.f)), ib = (int)__builtin_rintf(__builtin_amdgcn_fmed3f(b, -127.f, 127.f)), ic = (int)__builtin_rintf(__builtin_amdgcn_fmed3f(c, -127.f, 127.f)), id = (int)__builtin_rintf(__builtin_amdgcn_fmed3f(d, -127.f, 127.f));
    return (unsigned)(ia & 255) | ((unsigned)(ib & 255) << 8) | ((unsigned)(ic & 255) << 16) | ((unsigned)id << 24); }
constexpr float XQ_CLIP = 5.f;
DEV bf16 f2bf(float f) { return (bf16)(pk2(f, 0.f) & 0xffffu); }
DEV float shx(float x, int mask, int lane) { return __builtin_bit_cast(float, __builtin_amdgcn_ds_bpermute((lane ^ mask) << 2, __builtin_bit_cast(int, x))); }
DEV float sigmoidf_(float x) { return __builtin_amdgcn_rcpf(1.f + __expf(-x)); }
DEV float siluf_(float x) { return x * __builtin_amdgcn_rcpf(1.f + __expf(-x)); }
DEV float gelu_tanh_(float x) { const float u = 0.7978845608028654f * (x + 0.044715f * x * x * x); return x - x * __builtin_amdgcn_rcpf(1.f + __expf(2.f * u)); }

#ifndef GEMM_WGM
#define GEMM_WGM 4
#endif
namespace pg8 {
#define PG8_LAS __attribute__((address_space(3)))
typedef unsigned short bf16_t;
typedef short bf16x8 __attribute__((ext_vector_type(8)));
typedef float f32x4 __attribute__((ext_vector_type(4)));
typedef unsigned u32x4 __attribute__((ext_vector_type(4)));
constexpr int BM = 256, BK = 64, HALF = 128, HTB = HALF * BK * 2  , STAGE_BYTES = 8 * HTB, NXCD = 8, WGM = GEMM_WGM;

__host__ __device__ __forceinline__ int lds_byte(int r, int c) { const int st = (r >> 4) * 2 + (c >> 5), rr = r & 15, cc = c & 31, ob = rr * 64 + cc * 2; return st * 1024 + (ob ^ (((ob >> 9) & 1) << 5)); }
__host__ __device__ __forceinline__ void stage_rc(int b, int& R, int& C) { const int st = b / 1024, sb = b % 1024, swz = sb ^ (((sb >> 9) & 1) << 5); R = (st >> 1) * 16 + swz / 64; C = (st & 1) * 32 + (swz % 64) / 2; }
__host__ __device__ __forceinline__ int perm32(int rho) { const int n = rho >> 4, i = rho & 15; return 8 * (i >> 2) + 4 * n + (i & 3); }

struct Unit { int pm, pn; };
struct Gemm { const bf16_t* A; const bf16_t* Bt; int M, N, K; int lda = 0, ldb = 0; };

struct StaticOrder {
    int nM, nN, nwg, G, c;
    __host__ __device__ void init(int M, int N, int G_, int c_) { nM = M / BM; nN = N / BM; nwg = nM * nN; G = G_; c = c_; }
    __host__ __device__ bool next(int i, Unit& u) const {
        const long L = (long)i * G + c; if (L >= nwg) return false;
        int wgid = (int)L; { const int q = nwg / NXCD, r = nwg % NXCD, xcd = wgid % NXCD, off = wgid / NXCD; wgid = (xcd < r ? xcd * (q + 1) : r * (q + 1) + (xcd - r) * q) + off; }
        const int nig = WGM * nN, gid = wgid / nig, fm = gid * WGM, gsz = (nM - fm) < WGM ? (nM - fm) : WGM;
        u.pm = fm + ((wgid % nig) % gsz); u.pn = (wgid % nig) / gsz; return true;
    }
    __device__ __forceinline__ void a_ready(const Unit&) const {}
    __device__ __forceinline__ void done(const Unit&) const {}
};
template <class Epi, class Sched, bool ALIGN_EPI = false, bool SP2 = false, int QT = 0>
__device__ __forceinline__ void gemm_phase(PG8_LAS unsigned char* lds, const Gemm g, const Sched& S, const Epi& E, int tid) {
    asm volatile("" : "+v"(tid));
    const int wid = __builtin_amdgcn_readfirstlane(tid >> 6), lane = tid & 63, wr = wid >> 2, wc = wid & 3, fr = lane & 15, fq = lane >> 4;
    constexpr bool FP8 = QT == 1, I8 = QT == 2;
    const int KA = g.lda ? g.lda : g.K, KB = g.ldb ? g.ldb : g.K, nt = g.K / BK;
    unsigned voffA[2], voffB[2];
#pragma unroll
    for (int i = 0; i < 2; ++i) { int R, C; stage_rc(tid * 16 + i * 8192, R, C); const int Rb = Epi::PERM ? ((R & ~31) + perm32(R & 31)) : R;
        voffA[i] = (unsigned)(R * KA + C) * 2u; voffB[i] = (unsigned)(Rb * KB + C) * 2u; }
    const size_t kstep = (size_t)(BK * 2);
    const size_t hstepA = (size_t)HALF * KA * 2, hstepB = (size_t)HALF * KB * 2;
    const size_t tstepA = 2 * hstepA, tstepB = 2 * hstepB;
    const unsigned ldsw = (unsigned)wid * 1024u;
    const int aoff = lds_byte(wr * 64 + fr, fq * 8), boff = lds_byte(wc * 32 + fr, fq * 8);
#define PG8_SA(b, h) (((b) * 2 + (h)) * HTB)
#define PG8_SB(b, h) ((4 + (b) * 2 + (h)) * HTB)
#define PG8_STAGE(bufoff, gbase, voff) do { _Pragma("unroll") for (int _i = 0; _i < 2; ++_i) \
        __builtin_amdgcn_global_load_lds((const unsigned*)((const char*)(gbase) + (voff)[_i]), (PG8_LAS unsigned*)(lds + (bufoff) + ldsw + _i * 8192), 16, 0, 0); } while (0)
#define PG8_LDA(dst, b, h) do { _Pragma("unroll") for (int m = 0; m < 4; ++m) _Pragma("unroll") for (int k = 0; k < 2; ++k) dst[m][k] = *(const PG8_LAS bf16x8*)(lds + PG8_SA(b, h) + aoff + m * 2048 + k * 1024); } while (0)
#define PG8_LDB(dst, b, h) do { _Pragma("unroll") for (int n = 0; n < 2; ++n) _Pragma("unroll") for (int k = 0; k < 2; ++k) dst[n][k] = *(const PG8_LAS bf16x8*)(lds + PG8_SB(b, h) + boff + n * 2048 + k * 1024); } while (0)
#define PG8_CAT(x, y) __builtin_bit_cast(v8i, __builtin_shufflevector(x, y, 0, 1, 2, 3, 4, 5, 6, 7, 8, 9, 10, 11, 12, 13, 14, 15))
#define PG8_MMA(ai, bj, At, Bt) do { __builtin_amdgcn_s_setprio(1); if constexpr (FP8) { _Pragma("unroll") for (int m = 0; m < 4; ++m) _Pragma("unroll") for (int n = 0; n < 2; ++n) \
        { const v8i b8_ = PG8_CAT(Bt[n][0], Bt[n][1]), a8_ = PG8_CAT(At[m][0], At[m][1]); asm volatile("v_mfma_scale_f32_16x16x128_f8f6f4 %0, %1, %2, %0, %3, %3 op_sel_hi:[0,0,0]" : "+v"(acc[ai][bj][m][n]) : "v"(b8_), "v"(a8_), "v"(one_scales)); } } else if constexpr (I8) { \
        _Pragma("unroll") for (int m = 0; m < 4; ++m) _Pragma("unroll") for (int n = 0; n < 2; ++n) _Pragma("unroll") for (int k = 0; k < 2; ++k) \
        acc[ai][bj][m][n] = __builtin_bit_cast(f32x4, __builtin_amdgcn_mfma_i32_16x16x64_i8(__builtin_bit_cast(v4i, Bt[n][k]), __builtin_bit_cast(v4i, At[m][k]), __builtin_bit_cast(v4i, acc[ai][bj][m][n]), 0, 0, 0)); } else { \
        _Pragma("unroll") for (int m = 0; m < 4; ++m) _Pragma("unroll") for (int n = 0; n < 2; ++n) _Pragma("unroll") for (int k = 0; k < 2; ++k) \
        acc[ai][bj][m][n] = __builtin_amdgcn_mfma_f32_16x16x32_bf16(Bt[n][k], At[m][k], acc[ai][bj][m][n], 0, 0, 0); } __builtin_amdgcn_s_setprio(0); } while (0)
#define PG8_WAIT_V(n) asm volatile("s_waitcnt vmcnt(" #n ")" ::: "memory")
#define PG8_WAIT_L(n) asm volatile("s_waitcnt lgkmcnt(" #n ")" ::: "memory")
#define PG8_BAR __builtin_amdgcn_s_barrier()
#define PG8_SCHED __builtin_amdgcn_sched_barrier(0)
    const int one_scales = 0x7f7f7f7f;
    Unit cur, nxt; int ui = 0;
    if (!S.next(0, cur)) return;
    f32x4 acc[2][2][4][2];
#pragma unroll
    for (int a = 0; a < 2; ++a)
#pragma unroll
        for (int b = 0; b < 2; ++b)
#pragma unroll
            for (int m = 0; m < 4; ++m)
#pragma unroll
                for (int n = 0; n < 2; ++n) acc[a][b][m][n] = (f32x4){0.f, 0.f, 0.f, 0.f};
    bf16x8 At[4][2], B0[2][2], B1[2][2];
    const char* cA = (const char*)g.A + (size_t)cur.pm * tstepA; const char* cB = (const char*)g.Bt + (size_t)cur.pn * tstepB;
    S.a_ready(cur);
    if constexpr (SP2) {
        PG8_STAGE(PG8_SB(0, 0), cB, voffB); PG8_STAGE(PG8_SB(0, 1), cB + hstepB, voffB); PG8_STAGE(PG8_SA(0, 0), cA, voffA); PG8_STAGE(PG8_SA(0, 1), cA + hstepA, voffA);
        if (wr == 1) PG8_BAR;
        PG8_WAIT_V(2); PG8_BAR;
        PG8_STAGE(PG8_SB(1, 0), cB + kstep, voffB); PG8_STAGE(PG8_SA(1, 0), cA + kstep, voffA); PG8_STAGE(PG8_SB(1, 1), cB + hstepB + kstep, voffB);
        PG8_WAIT_V(6); PG8_BAR;
    } else {
        PG8_STAGE(PG8_SB(0, 0), cB, voffB); PG8_STAGE(PG8_SA(0, 0), cA, voffA); PG8_STAGE(PG8_SB(0, 1), cB + hstepB, voffB); PG8_STAGE(PG8_SA(0, 1), cA + hstepA, voffA);
        if (wr == 1) PG8_BAR;
        PG8_WAIT_V(4); PG8_BAR;
        PG8_STAGE(PG8_SB(1, 0), cB + kstep, voffB); PG8_STAGE(PG8_SA(1, 0), cA + kstep, voffA); PG8_STAGE(PG8_SB(1, 1), cB + hstepB + kstep, voffB);
        PG8_WAIT_V(6); PG8_BAR;
    }
    for (;;) {
        const bool has_next = S.next(ui + 1, nxt);
        const char* nA = has_next ? (const char*)g.A + (size_t)nxt.pm * tstepA : cA; const char* nB = has_next ? (const char*)g.Bt + (size_t)nxt.pn * tstepB : cB;
        for (int t = 0; t < nt; t += 2) {
            const bool last = (t == nt - 2);
            const char* a1 = cA + (size_t)(t + 1) * kstep;
            const char* a2 = last ? nA : cA + (size_t)(t + 2) * kstep; const char* b2 = last ? nB : cB + (size_t)(t + 2) * kstep;
            const char* a3 = a2 + kstep; const char* b3 = b2 + kstep;
            if (last && has_next) S.a_ready(nxt);
            if constexpr (SP2) {
            PG8_LDB(B0, 0, 0); PG8_LDB(B1, 0, 1); PG8_SCHED; PG8_LDA(At, 0, 0); PG8_STAGE(PG8_SA(1, 1), a1 + hstepA, voffA);
            PG8_WAIT_V(8); PG8_WAIT_L(0); PG8_BAR; PG8_MMA(0, 0, At, B0); PG8_MMA(0, 1, At, B1); PG8_BAR; PG8_SCHED;
            PG8_LDA(At, 0, 1); PG8_STAGE(PG8_SB(0, 0), b2, voffB); PG8_STAGE(PG8_SB(0, 1), b2 + hstepB, voffB); PG8_STAGE(PG8_SA(0, 0), a2, voffA);
            PG8_WAIT_V(8); PG8_WAIT_L(0); PG8_BAR; PG8_MMA(1, 0, At, B0); PG8_MMA(1, 1, At, B1); PG8_BAR; PG8_SCHED;
            PG8_LDB(B0, 1, 0); PG8_LDB(B1, 1, 1); PG8_SCHED; PG8_LDA(At, 1, 0); PG8_STAGE(PG8_SA(0, 1), a2 + hstepA, voffA);
            PG8_WAIT_V(8); PG8_WAIT_L(0); PG8_BAR; PG8_MMA(0, 0, At, B0); PG8_MMA(0, 1, At, B1); PG8_BAR; PG8_SCHED;
            PG8_LDA(At, 1, 1); PG8_STAGE(PG8_SB(1, 0), b3, voffB); PG8_STAGE(PG8_SB(1, 1), b3 + hstepB, voffB); PG8_STAGE(PG8_SA(1, 0), a3, voffA);
            PG8_WAIT_V(8); PG8_WAIT_L(0); PG8_BAR; PG8_MMA(1, 0, At, B0); PG8_MMA(1, 1, At, B1); PG8_BAR; PG8_SCHED;
            } else {
            PG8_LDB(B0, 0, 0); PG8_SCHED; PG8_LDA(At, 0, 0); PG8_STAGE(PG8_SA(1, 1), a1 + hstepA, voffA);
            PG8_WAIT_L(8); PG8_BAR; PG8_WAIT_L(0); PG8_MMA(0, 0, At, B0); PG8_BAR; PG8_SCHED;
            PG8_LDB(B1, 0, 1); PG8_STAGE(PG8_SB(0, 0), b2, voffB);
            PG8_BAR; PG8_WAIT_L(0); PG8_MMA(0, 1, At, B1); PG8_BAR;
            PG8_LDA(At, 0, 1); PG8_STAGE(PG8_SA(0, 0), a2, voffA);
            PG8_BAR; PG8_WAIT_L(0); PG8_MMA(1, 0, At, B0); PG8_BAR; PG8_SCHED;
            PG8_STAGE(PG8_SB(0, 1), b2 + hstepB, voffB);
            PG8_WAIT_V(6); PG8_BAR; PG8_MMA(1, 1, At, B1); PG8_BAR;
            PG8_LDB(B0, 1, 0); PG8_SCHED; PG8_LDA(At, 1, 0); PG8_STAGE(PG8_SA(0, 1), a2 + hstepA, voffA);
            PG8_WAIT_L(8); PG8_BAR; PG8_WAIT_L(0); PG8_MMA(0, 0, At, B0); PG8_BAR; PG8_SCHED;
            PG8_LDB(B1, 1, 1); PG8_STAGE(PG8_SB(1, 0), b3, voffB);
            PG8_BAR; PG8_WAIT_L(0); PG8_MMA(0, 1, At, B1); PG8_BAR;
            PG8_LDA(At, 1, 1); PG8_STAGE(PG8_SA(1, 0), a3, voffA);
            PG8_BAR; PG8_WAIT_L(0); PG8_MMA(1, 0, At, B0); PG8_BAR; PG8_SCHED;
            PG8_STAGE(PG8_SB(1, 1), b3 + hstepB, voffB);
            PG8_WAIT_V(6); PG8_BAR; PG8_MMA(1, 1, At, B1); PG8_BAR;
            }
        }
        if constexpr (FP8) asm volatile("s_nop 15\n\ts_nop 15" ::: "memory");
        if constexpr (ALIGN_EPI) { if (wr == 0) PG8_BAR; }
        if constexpr (!Epi::AFTER_DRAIN) { E(acc, cur, wr, wc, fr, fq); S.done(cur); }
        if (!has_next) break;
#pragma unroll
        for (int a = 0; a < 2; ++a)
#pragma unroll
            for (int b = 0; b < 2; ++b)
#pragma unroll
                for (int m = 0; m < 4; ++m)
#pragma unroll
                    for (int n = 0; n < 2; ++n) acc[a][b][m][n] = (f32x4){0.f, 0.f, 0.f, 0.f};
        cur = nxt; cA = nA; cB = nB; ++ui;
        if constexpr (ALIGN_EPI) { if (wr == 1) PG8_BAR; }
    }
    PG8_WAIT_V(0);
    if constexpr (!ALIGN_EPI) { if (wr == 0) PG8_BAR; }
    PG8_BAR;
    if constexpr (Epi::AFTER_DRAIN) { E.fused(acc, cur, wr, wc, fr, fq, lds, wid, lane); S.done(cur); }
#undef PG8_SA
#undef PG8_SB
#undef PG8_STAGE
#undef PG8_LDA
#undef PG8_LDB
#undef PG8_MMA
#undef PG8_CAT
#undef PG8_WAIT_V
#undef PG8_WAIT_L
#undef PG8_BAR
#undef PG8_SCHED
}
}

typedef long long ssq_t;
DEV float rstd_of(const ssq_t* ssq, int row) { return __builtin_amdgcn_rsqf((float)((const GAS ssq_t*)ssq)[row] * (1.f / (4096.f * 16777216.f)) + EPS); }
DEV void ssq_add(ssq_t* ssq, int row, float ss) { __hip_atomic_fetch_add((GAS ssq_t*)ssq + row, (ssq_t)(ss * 16777216.f), __ATOMIC_RELAXED, __HIP_MEMORY_SCOPE_AGENT); }

struct EpiIn {
    static constexpr bool PERM = true, AFTER_DRAIN = false;
    bf16 *LG, *LX, *HU, *Q, *Kr, *V, *Gs; const ssq_t* ssq; const float* rot;
    DEV void operator()(const f32x4 (&acc)[2][2][4][2], const pg8::Unit& u, int wr, int wc, int fr, int fq) const {
        const int row0 = u.pm * 256 + wr * 64 + fr, cc0 = wc * 32 + 8 * fq, pn = u.pn;
        if (pn >= 20 && pn < 28) {
            const bool isk = pn >= 24; const int P = pn - (isk ? 24 : 20); bf16* dst = isk ? Kr : Q; const float sc = isk ? 0.08838834764831845f : 1.f;
            const int hh = wc >> 1, jj0 = 32 * (wc & 1) + 8 * fq, ocol = (2 * P + hh) * 128 + jj0;
#pragma unroll
            for (int ai = 0; ai < 2; ++ai)
#pragma unroll
                for (int m = 0; m < 4; ++m) {
                    const int row = row0 + ai * 128 + m * 16; const float rs = rstd_of(ssq, row) * sc;
                    const GAS f32x4* rp = (const GAS f32x4*)(rot + ((size_t)row * 64 + jj0) * 2);
                    const f32x4 t0 = rp[0], t1 = rp[1], t2 = rp[2], t3 = rp[3];
                    const f32x4 a0 = acc[ai][0][m][0] * rs, a1 = acc[ai][0][m][1] * rs, b0 = acc[ai][1][m][0] * rs, b1 = acc[ai][1][m][1] * rs;
                    v4u o1, o2;
                    o1.x = pk2(a0[0] * t0[0] - b0[0] * t0[1], a0[1] * t0[2] - b0[1] * t0[3]); o2.x = pk2(a0[0] * t0[1] + b0[0] * t0[0], a0[1] * t0[3] + b0[1] * t0[2]);
                    o1.y = pk2(a0[2] * t1[0] - b0[2] * t1[1], a0[3] * t1[2] - b0[3] * t1[3]); o2.y = pk2(a0[2] * t1[1] + b0[2] * t1[0], a0[3] * t1[3] + b0[3] * t1[2]);
                    o1.z = pk2(a1[0] * t2[0] - b1[0] * t2[1], a1[1] * t2[2] - b1[1] * t2[3]); o2.z = pk2(a1[0] * t2[1] + b1[0] * t2[0], a1[1] * t2[3] + b1[1] * t2[2]);
                    o1.w = pk2(a1[2] * t3[0] - b1[2] * t3[1], a1[3] * t3[2] - b1[3] * t3[3]); o2.w = pk2(a1[2] * t3[1] + b1[2] * t3[0], a1[3] * t3[3] + b1[3] * t3[2]);
                    bf16* rowp = dst + (size_t)row * 1024 + ocol;
                    *(GAS v4u*)rowp = o1; *(GAS v4u*)(rowp + 64) = o2;
                }
        } else {
            bf16* dst; int ldc, colt, act = 0;
            if (pn < 4) { dst = LG; ldc = 1024; colt = pn * 256; act = 1; }
            else if (pn < 8) { dst = LX; ldc = 1024; colt = (pn - 4) * 256; }
            else if (pn < 20) { dst = HU; ldc = 3072; colt = (pn - 8) * 256; }
            else if (pn < 36) { dst = V; ldc = 2048; colt = (pn - 28) * 256; }
            else { dst = Gs; ldc = 2048; colt = (pn - 36) * 256; act = 2; }
#pragma unroll
            for (int ai = 0; ai < 2; ++ai)
#pragma unroll
                for (int m = 0; m < 4; ++m) {
                    const int row = row0 + ai * 128 + m * 16; const float rs = rstd_of(ssq, row);
                    bf16* rowp = dst + (size_t)row * ldc + colt + cc0;
#pragma unroll
                    for (int bj = 0; bj < 2; ++bj) {
                        f32x4 v0 = acc[ai][bj][m][0] * rs, v1 = acc[ai][bj][m][1] * rs;
                        if (act == 1) {
#pragma unroll
                            for (int e = 0; e < 4; ++e) { v0[e] = gelu_tanh_(v0[e]); v1[e] = gelu_tanh_(v1[e]); }
                        } else if (act == 2) {
#pragma unroll
                            for (int e = 0; e < 4; ++e) { v0[e] = siluf_(v0[e]); v1[e] = siluf_(v1[e]); }
                        }
                        v4u w; w.x = pk2(v0[0], v0[1]); w.y = pk2(v0[2], v0[3]); w.z = pk2(v1[0], v1[1]); w.w = pk2(v1[2], v1[3]);
                        *(GAS v4u*)(rowp + bj * 128) = w;
                    }
                }
        }
    }
};
struct EpiRes {
    static constexpr bool PERM = true, AFTER_DRAIN = false;
    bf16* xb; ssq_t* ssq; float sc; unsigned char* xq; const ssq_t* ssq_old;
    DEV void operator()(const f32x4 (&acc)[2][2][4][2], const pg8::Unit& u, int wr, int wc, int fr, int fq) const {
        const int row0 = u.pm * 256 + wr * 64 + fr, col0 = u.pn * 256 + wc * 32 + 8 * fq;
#pragma unroll
        for (int ai = 0; ai < 2; ++ai)
#pragma unroll
            for (int m = 0; m < 4; ++m) {
                const int row = row0 + ai * 128 + m * 16; const size_t off = (size_t)row * 4096 + col0; float ss = 0.f;
                const float qs = xq ? (127.f / XQ_CLIP) * rstd_of(ssq_old, row) : 0.f;
                v4u rv[2];
#pragma unroll
                for (int bj = 0; bj < 2; ++bj) rv[bj] = *(const GAS v4u*)(xb + off + bj * 128);
#pragma unroll
                for (int bj = 0; bj < 2; ++bj) {
                    const f32x4 a0 = acc[ai][bj][m][0], a1 = acc[ai][bj][m][1];
                    const float o0 = fmaf(a0[0], sc, bflo(rv[bj].x)), o1 = fmaf(a0[1], sc, bfhi(rv[bj].x)), o2 = fmaf(a0[2], sc, bflo(rv[bj].y)), o3 = fmaf(a0[3], sc, bfhi(rv[bj].y));
                    const float o4 = fmaf(a1[0], sc, bflo(rv[bj].z)), o5 = fmaf(a1[1], sc, bfhi(rv[bj].z)), o6 = fmaf(a1[2], sc, bflo(rv[bj].w)), o7 = fmaf(a1[3], sc, bfhi(rv[bj].w));
                    ss += ((o0 * o0 + o1 * o1) + (o2 * o2 + o3 * o3)) + ((o4 * o4 + o5 * o5) + (o6 * o6 + o7 * o7));
                    v4u w; w.x = pk2(o0, o1); w.y = pk2(o2, o3); w.z = pk2(o4, o5); w.w = pk2(o6, o7); *(GAS v4u*)(xb + off + bj * 128) = w;
                    if (xq) { v2u q; q.x = pk4_i8(o0 * qs, o1 * qs, o2 * qs, o3 * qs); q.y = pk4_i8(o4 * qs, o5 * qs, o6 * qs, o7 * qs); *(GAS v2u*)(xq + off + bj * 128) = q; }
                }
                { const int ln = fq * 16 + fr; ss += shx(ss, 16, ln); ss += shx(ss, 32, ln); }
                if (fq == 0) ssq_add(ssq, row, ss);
                if (m & 1) asm volatile("" ::: "memory");
            }
    }
};
struct EpiHuT {
    static constexpr bool PERM = true, AFTER_DRAIN = false;
    bf16* HYT; const ssq_t* ssq;
    DEV void operator()(const f32x4 (&acc)[2][2][4][2], const pg8::Unit& u, int wr, int wc, int fr, int fq) const {
        const int row0 = u.pm * 256 + wr * 64 + fr, col0 = u.pn * 256 + wc * 32 + 8 * fq;
        float rs[2][8];
#pragma unroll
        for (int bj = 0; bj < 2; ++bj)
#pragma unroll
            for (int e = 0; e < 8; ++e) rs[bj][e] = rstd_of(ssq, col0 + bj * 128 + e);
#pragma unroll
        for (int ai = 0; ai < 2; ++ai)
#pragma unroll
            for (int m = 0; m < 4; ++m) { bf16* rowp = HYT + (size_t)(row0 + ai * 128 + m * 16) * M + col0;
#pragma unroll
                for (int bj = 0; bj < 2; ++bj) { const f32x4 v0 = acc[ai][bj][m][0], v1 = acc[ai][bj][m][1];
                    v4u w; w.x = pk2(v0[0] * rs[bj][0], v0[1] * rs[bj][1]); w.y = pk2(v0[2] * rs[bj][2], v0[3] * rs[bj][3]); w.z = pk2(v1[0] * rs[bj][4], v1[1] * rs[bj][5]); w.w = pk2(v1[2] * rs[bj][6], v1[3] * rs[bj][7]);
                    *(GAS v4u*)(rowp + bj * 128) = w; } }
    }
};
template <int QT> struct EpiGU_ {
    static constexpr bool PERM = true, AFTER_DRAIN = false;
    unsigned char* U; const ssq_t* ssq; int f8; const ssq_t* ssq_old; const unsigned* amax;
    DEV void operator()(const f32x4 (&acc)[2][2][4][2], const pg8::Unit& u, int wr, int wc, int fr, int fq) const {
        const int row0 = u.pm * 256 + wr * 64 + fr, col = u.pn * 128 + wc * 32 + 8 * fq;
        f32x4 cg0, cg1, cu0, cu1;
        if constexpr (QT == 2) { const GAS f32x4* ap = (const GAS f32x4*)((const GAS float*)amax + u.pn * 256 + wc * 32 + 8 * fq); cg0 = ap[0] * (1.f / 127.f); cg1 = ap[1] * (1.f / 127.f); cu0 = ap[32] * (1.f / 127.f); cu1 = ap[33] * (1.f / 127.f); }
#pragma unroll
        for (int ai = 0; ai < 2; ++ai)
#pragma unroll
            for (int m = 0; m < 4; ++m) {
                const int row = row0 + ai * 128 + m * 16; float rs = rstd_of(ssq, row);
                f32x4 g0, g1, u0, u1;
                if constexpr (QT == 2) {
                    rs *= (XQ_CLIP / 127.f) * __builtin_amdgcn_rcpf(rstd_of(ssq_old, row));
                    g0 = __builtin_convertvector(__builtin_bit_cast(v4i, acc[ai][0][m][0]), f32x4) * cg0; g1 = __builtin_convertvector(__builtin_bit_cast(v4i, acc[ai][0][m][1]), f32x4) * cg1;
                    u0 = __builtin_convertvector(__builtin_bit_cast(v4i, acc[ai][1][m][0]), f32x4) * cu0; u1 = __builtin_convertvector(__builtin_bit_cast(v4i, acc[ai][1][m][1]), f32x4) * cu1;
                } else { g0 = acc[ai][0][m][0]; g1 = acc[ai][0][m][1]; u0 = acc[ai][1][m][0]; u1 = acc[ai][1][m][1]; }
                const float rsu = f8 ? 8.f * rs : rs;
                g0 *= rs; g1 *= rs; u0 *= rsu; u1 *= rsu;
                const float y0 = siluf_(g0[0]) * u0[0], y1 = siluf_(g0[1]) * u0[1], y2 = siluf_(g0[2]) * u0[2], y3 = siluf_(g0[3]) * u0[3];
                const float y4 = siluf_(g1[0]) * u1[0], y5 = siluf_(g1[1]) * u1[1], y6 = siluf_(g1[2]) * u1[2], y7 = siluf_(g1[3]) * u1[3];
                if (f8) { v2u w; w.x = pk4_fp8(y0, y1, y2, y3); w.y = pk4_fp8(y4, y5, y6, y7); *(GAS v2u*)(U + (size_t)row * DFF + col) = w; }
                else { v4u w; w.x = pk2(y0, y1); w.y = pk2(y2, y3); w.z = pk2(y4, y5); w.w = pk2(y6, y7); *(GAS v4u*)((bf16*)U + (size_t)row * DFF + col) = w; }
            }
    }
};
typedef EpiGU_<0> EpiGU;
#define XB_TMO      128
#define XB_XCNT(j)  (256  + 64 * (j))
#define XB_XSUB(j)  (1280 + 64 * (j))
#define XB_XGEN(j)  (2304 + 64 * (j))
#define XB_TOP      3328
#define XB_TOPGEN   3392
#define XCD_BAR_WORDS 3456
#define XB_SPIN_CAP (1u << 18)
__device__ __forceinline__ unsigned xb_ld(unsigned* p)              { return __hip_atomic_load(p, __ATOMIC_RELAXED, __HIP_MEMORY_SCOPE_AGENT); }
__device__ __forceinline__ unsigned xb_add(unsigned* p, unsigned v) { return __hip_atomic_fetch_add(p, v, __ATOMIC_RELAXED, __HIP_MEMORY_SCOPE_AGENT); }
__device__ __forceinline__ unsigned xb_xcc_id() { return (unsigned)__builtin_amdgcn_s_getreg((3 << 11) | 20) & 0xFu; }
#define XB_SPIN(cond, bar) do { unsigned _sp = 0; while (cond) { __builtin_amdgcn_s_sleep(1); \
    if ((++_sp & 255u) == 0u) { if (xb_ld(&(bar)[XB_TMO])) break; if (_sp > XB_SPIN_CAP) { atomicAdd(&(bar)[XB_TMO], 1u); break; } } } } while (0)

struct XcdBarrier {
    unsigned* bar; unsigned x;
    volatile LAS unsigned* st;
};

__device__ __forceinline__ XcdBarrier xcd_barrier_post(unsigned* bar, volatile LAS unsigned* st) {
    XcdBarrier b; b.bar = bar; b.x = xb_xcc_id(); b.st = st;
    if (threadIdx.x == 0) (void)xb_add(&bar[XB_XCNT(b.x)], 1u);
    return b;
}
__device__ __forceinline__ void xcd_barrier_complete(unsigned* bar, unsigned x, unsigned& nloc, unsigned& nx) {
    const unsigned G = gridDim.x * gridDim.y * gridDim.z;
    unsigned sum, cnt, mine, sp = 0u;
    for (;;) {
        sum = 0u; cnt = 0u; mine = 0u;
#pragma unroll
        for (unsigned j = 0; j < 16; ++j) { const unsigned c = xb_ld(&bar[XB_XCNT(j)]); sum += c; cnt += (c > 0u) ? 1u : 0u; }
        if (sum == G) { mine = xb_ld(&bar[XB_XCNT(x)]); break; }
        __builtin_amdgcn_s_sleep(1);
        if ((++sp & 255u) == 0u) { if (xb_ld(&bar[XB_TMO])) break; if (sp > XB_SPIN_CAP) { atomicAdd(&bar[XB_TMO], 1u); break; } }
    }
    nloc = mine > 0u ? mine : 1u; nx = cnt > 0u ? cnt : 1u;
}

__device__ __forceinline__ void xcd_barrier(const XcdBarrier& b, const bool leader  ) {
    asm volatile("s_waitcnt vmcnt(0)" ::: "memory");
    __syncthreads();
    if (leader) {
        unsigned* bar = b.bar;
        __builtin_amdgcn_s_waitcnt(0);
        unsigned nloc = b.st[0], nx = b.st[1];
        if (nloc == 0u) { xcd_barrier_complete(bar, b.x, nloc, nx); b.st[0] = nloc; b.st[1] = nx; }
        const unsigned old = xb_add(&bar[XB_XSUB(b.x)], 1u);
        const unsigned gen = old / nloc;
        if (old + 1u == (gen + 1u) * nloc) {
            __builtin_amdgcn_fence(__ATOMIC_RELEASE, "agent");
            asm volatile("s_waitcnt vmcnt(0)" ::: "memory");
            const unsigned og = xb_add(&bar[XB_TOP], 1u);
            const unsigned tg = og / nx;
            if (og + 1u == (tg + 1u) * nx) xb_add(&bar[XB_TOPGEN], 1u);
            else XB_SPIN(xb_ld(&bar[XB_TOPGEN]) == tg, bar);
            __builtin_amdgcn_fence(__ATOMIC_ACQUIRE, "agent");
            xb_add(&bar[XB_XGEN(b.x)], 1u);
            asm volatile("s_waitcnt vmcnt(0)" ::: "memory");
        } else {
            XB_SPIN(xb_ld(&bar[XB_XGEN(b.x)]) == gen, bar);
            __builtin_amdgcn_fence(__ATOMIC_ACQUIRE, "agent");
            asm volatile("s_waitcnt vmcnt(0)" ::: "memory");
        }
    }
    __syncthreads();
}

constexpr size_t MiB = 1u << 20;
constexpr size_t WS_CTL = 0, CTL_BYTES = 1 * MiB;
constexpr int CW_BAR = 4096;
constexpr size_t CTL_SSQ_OFF = 128 * 1024;
constexpr size_t CTL_AMAX_OFF = 832 * 1024;
constexpr size_t WS_WIN = 1 * MiB;
constexpr size_t WS_WOUT = WS_WIN + 2 * 88 * MiB;
constexpr size_t WS_WGU = WS_WOUT + 2 * 32 * MiB;
constexpr size_t WS_WDN = WS_WGU + 2 * 172 * MiB;
constexpr size_t WS_XB = WS_WDN + 2 * 86 * MiB;
constexpr size_t WS_MIX = WS_XB + 128 * MiB;
constexpr size_t WS_PROJ = WS_MIX + 128 * MiB;
constexpr size_t WS_KV = WS_PROJ + 352 * MiB;
constexpr size_t WS_HYT = WS_KV + 128 * MiB;
constexpr size_t WS_HYO = WS_HYT + 96 * MiB;
constexpr size_t WS_GSCR = WS_HYO + 32 * MiB;
constexpr size_t WS_ROT = WS_GSCR + 96 * MiB;
constexpr size_t WS_HDN = WS_ROT + 8 * MiB;
constexpr size_t WS_LRUC = WS_HDN + 8 * MiB;
constexpr size_t WS_WGT = WS_LRUC + 3 * MiB;
constexpr size_t WS_END = WS_WGT + 2 * MiB;

constexpr int LDS_BYTES = 160 * 1024;
constexpr int MISC_OFF = LDS_BYTES - 256;
#ifndef FP8_MASK
#define FP8_MASK 2
#endif
#ifndef PROBE_P0
#define PROBE_P0 0
#endif
#ifndef I8_MASK
#define I8_MASK 3
#endif
#define I8_GU(l) ((I8_MASK >> (l)) & 1)
#define FP8_DOWN(l) ((FP8_MASK >> (l)) & 1)
constexpr int NPH = 16;

#define LDS_WAIT() asm volatile("s_waitcnt lgkmcnt(0)" ::: "memory")
#define VM_WAIT() asm volatile("s_waitcnt vmcnt(0)" ::: "memory")

struct Args { const float* in[29]; float* out; unsigned char* ws; int ph_lo, ph_hi; };

struct Frame {
    LAS unsigned char* lds; int tid, lane, wave, vcu, G;
    const float* const* in;
    float* out; unsigned char* ws;
    DEV const float* I(int k) const { return (const float*)(const GAS float*)in[k]; }
    template <class T> DEV T* W(size_t off) const { return (T*)(GAS T*)(ws + off); }
    DEV float* O() const { return (float*)(GAS float*)out; }
};

DEV float wave_sum(float v, int lane) {
#pragma unroll
    for (int o = 1; o < 64; o <<= 1) v += shx(v, o, lane);
    return v;
}
DEV f32x2 cmul(f32x2 a, f32x2 b) { return (f32x2){a.x * b.x - a.y * b.y, a.x * b.y + a.y * b.x}; }
DEV bf16x8 lfrag(const LAS unsigned char* base, int row0, int s, int stride, int fr, int fq) { return *(const LAS bf16x8*)(base + (row0 + fr) * stride + s * 64 + fq * 16); }
DEV f32x4 mfma16(bf16x8 a, bf16x8 b, f32x4 c) { return __builtin_amdgcn_mfma_f32_16x16x32_bf16(a, b, c, 0, 0, 0); }
template <int E> DEV float bfe(const v4u& v) { const unsigned w = E < 2 ? v.x : E < 4 ? v.y : E < 6 ? v.z : v.w; return (E & 1) ? bfhi(w) : bflo(w); }

DEV int map_win(int n) {
    if (n < 5120 || n >= 7168) return n;
    const int base = n < 6144 ? 5120 : 6144, r = n - base, h = r >> 7, j = r & 127;
    return base + 256 * (h >> 1) + 128 * (j >> 6) + 64 * (h & 1) + (j & 63);
}
template <int CTRL> DEV float dpp_f(float x) { return __builtin_bit_cast(float, __builtin_amdgcn_update_dpp(0, __builtin_bit_cast(int, x), CTRL, 0xf, 0xf, true)); }
DEV void tr_item(const float* W, int K, int N, bf16* WT, LAS float* scr, int item, int lane, const float* gain, int mode, unsigned* amax = nullptr) {
    const int nblk = N / 64, kb = item / nblk, nb = item - kb * nblk, k0 = 64 * kb, n0 = 64 * nb;
    const int l16 = lane & 15, kq = lane >> 4;
    f32x4 v[16];
#pragma unroll
    for (int i = 0; i < 16; ++i) v[i] = __builtin_nontemporal_load((const GAS f32x4*)(W + (size_t)(k0 + 4 * i + kq) * N + n0 + 4 * l16));
#pragma unroll
    for (int i = 0; i < 16; ++i) { LAS float* d = scr + (4 * l16) * 65 + 4 * i + kq; d[0] = v[i][0]; d[65] = v[i][1]; d[130] = v[i][2]; d[195] = v[i][3]; }
    LDS_WAIT();
    const int kc = lane & 7, nr = lane >> 3;
    f32x4 g0 = (f32x4){1.f, 1.f, 1.f, 1.f}, g1 = g0;
    if (gain) { g0 = *(const GAS f32x4*)(gain + k0 + 8 * kc); g1 = *(const GAS f32x4*)(gain + k0 + 8 * kc + 4); }
    float mine = 0.f;
#pragma unroll
    for (int j = 0; j < 8; ++j) { const int n = 8 * j + nr; const LAS float* s = scr + n * 65 + 8 * kc;
        int nd = n0 + n; if (mode == 1) nd = map_win(nd); else if (mode == 2) nd = 256 * (nd >> 7) + (nd & 127); else if (mode == 3) nd = 256 * (nd >> 7) + 128 + (nd & 127);
        if (mode == 4) { v2u o; o.x = pk4_fp8(s[0] * 1024.f, s[1] * 1024.f, s[2] * 1024.f, s[3] * 1024.f); o.y = pk4_fp8(s[4] * 1024.f, s[5] * 1024.f, s[6] * 1024.f, s[7] * 1024.f);
            *(GAS v2u*)((unsigned char*)WT + (size_t)nd * K + k0 + 8 * kc) = o; continue; }
        const float p0 = s[0] * g0[0], p1 = s[1] * g0[1], p2 = s[2] * g0[2], p3 = s[3] * g0[3], p4 = s[4] * g1[0], p5 = s[5] * g1[1], p6 = s[6] * g1[2], p7 = s[7] * g1[3];
        v4u o; o.x = pk2(p0, p1); o.y = pk2(p2, p3); o.z = pk2(p4, p5); o.w = pk2(p6, p7);
        *(GAS v4u*)(WT + (size_t)nd * K + k0 + 8 * kc) = o;
        if (amax) { float mx = fmaxf(fmaxf(fmaxf(fabsf(p0), fabsf(p1)), fmaxf(fabsf(p2), fabsf(p3))), fmaxf(fmaxf(fabsf(p4), fabsf(p5)), fmaxf(fabsf(p6), fabsf(p7))));
            mx = fmaxf(mx, dpp_f<0xB1>(mx)); mx = fmaxf(mx, dpp_f<0x4E>(mx)); mx = fmaxf(mx, dpp_f<0x141>(mx));
            mine = kc == j ? mx : mine; } }
    if (amax) {
        int nd = n0 + 8 * kc + nr; if (mode == 1) nd = map_win(nd); else if (mode == 2) nd = 256 * (nd >> 7) + (nd & 127); else if (mode == 3) nd = 256 * (nd >> 7) + 128 + (nd & 127);
        __hip_atomic_fetch_max((GAS unsigned*)amax + nd, __float_as_uint(mine), __ATOMIC_RELAXED, __HIP_MEMORY_SCOPE_AGENT); }
    LDS_WAIT();
}
DEV void p0_weights(const Frame& F, int gw, int NGW, int lane, int rep = 0) {
    LAS float* scr = (LAS float*)(F.lds + F.wave * 16896);
    constexpr int I_IN = 64 * 176, I_OUT = 64 * 64, I_G = 64 * 172, I_DN = 172 * 64, I_L = I_IN + I_OUT + 2 * I_G + I_DN;
    for (int it = gw; it < 2 * I_L; it += NGW) {
        const int itr = 2 * I_L - 1 - it;
        const int l = itr >= I_L ? 1 : 0; int r = itr - l * I_L;
        unsigned* am = nullptr;
        if (r < I_G) { tr_item(F.I(25) + (size_t)l * D * DFF, D, DFF, F.W<bf16>(WS_WGU + (size_t)l * 172 * MiB), scr, r, lane, F.I(24) + l * D, 2, am); continue; } r -= I_G;
        if (r < I_G) { tr_item(F.I(26) + (size_t)l * D * DFF, D, DFF, F.W<bf16>(WS_WGU + (size_t)l * 172 * MiB), scr, r, lane, F.I(24) + l * D, 3, am); continue; } r -= I_G;
        if (r < I_IN) { tr_item(F.I(2) + (size_t)l * D * NIN, D, NIN, F.W<bf16>(WS_WIN + (size_t)l * 88 * MiB), scr, r, lane, F.I(1) + l * D, 1); continue; } r -= I_IN;
        if (r < I_OUT) { tr_item(F.I(23) + (size_t)l * D * D, D, D, F.W<bf16>(WS_WOUT + (size_t)l * 32 * MiB), scr, r, lane, nullptr, 0); continue; } r -= I_OUT;
        tr_item(F.I(27) + (size_t)l * DFF * D, DFF, D, F.W<bf16>(WS_WDN + (size_t)l * 86 * MiB), scr, r, lane, nullptr, FP8_DOWN(l) ? 4 : 0);
    }
}
DEV void wq_rows(const Frame& F, int l) {
    unsigned char* base = F.W<unsigned char>(WS_WGU + (size_t)l * 172 * MiB); const unsigned* am = F.W<unsigned>(CTL_AMAX_OFF) + l * NGU;
    for (int r = F.vcu * 8 + F.wave; r < NGU; r += F.G * 8) {
        const GAS v4u* rp = (const GAS v4u*)(base + (size_t)r * 8192) + F.lane; v4u v[8];
#pragma unroll
        for (int i = 0; i < 8; ++i) v[i] = rp[i * 64];
        float a = 0.f;
#pragma unroll
        for (int i = 0; i < 8; ++i) a = fmaxf(fmaxf(fmaxf(a, fmaxf(fabsf(bflo(v[i].x)), fabsf(bfhi(v[i].x)))), fmaxf(fabsf(bflo(v[i].y)), fabsf(bfhi(v[i].y)))), fmaxf(fmaxf(fabsf(bflo(v[i].z)), fabsf(bfhi(v[i].z))), fmaxf(fabsf(bflo(v[i].w)), fabsf(bfhi(v[i].w)))));
#pragma unroll
        for (int o = 1; o < 64; o <<= 1) a = fmaxf(a, shx(a, o, F.lane));
        if (F.lane == 0) ((GAS unsigned*)am)[r] = __float_as_uint(a);
        const float qs = a > 0.f ? 127.f * __builtin_amdgcn_rcpf(a) : 0.f;
#pragma unroll
        for (int i = 0; i < 8; ++i) { v2u o; o.x = pk4_i8(bflo(v[i].x) * qs, bfhi(v[i].x) * qs, bflo(v[i].y) * qs, bfhi(v[i].y) * qs); o.y = pk4_i8(bflo(v[i].z) * qs, bfhi(v[i].z) * qs, bflo(v[i].w) * qs, bfhi(v[i].w) * qs);
            *(GAS v2u*)(base + (size_t)r * 8192 + i * 512 + F.lane * 8) = o; }
    }
}
DEV void p0_small(const Frame& F, int gw, int NGW, int lane) {
    { const float* x = F.I(0); bf16* xb = F.W<bf16>(WS_XB); ssq_t* ssq = F.W<ssq_t>(CTL_SSQ_OFF);
      for (int m = gw; m < M; m += NGW) { const GAS f32x4* xr = (const GAS f32x4*)(x + (size_t)m * D) + lane; GAS v2u* o = (GAS v2u*)(xb + (size_t)m * D) + lane; float s = 0.f;
#pragma unroll
          for (int j = 0; j < 16; ++j) { const f32x4 v = xr[64 * j]; s += (v[0] * v[0] + v[1] * v[1]) + (v[2] * v[2] + v[3] * v[3]); v2u w; w.x = pk2(v[0], v[1]); w.y = pk2(v[2], v[3]); o[64 * j] = w; }
          s = wave_sum(s, lane); if (lane == 0) ((GAS ssq_t*)ssq)[m] = (ssq_t)(s * 16777216.f); } }
    { float* rot = F.W<float>(WS_ROT); const double inv = exp(-(double)lane * (9.210340371976184 / 64.0)) * 0.3183098861837907;
      for (int idx = gw * 64 + lane; idx < M * 64; idx += NGW * 64) { const int pos = idx >> 6;
          double xx = (double)pos * inv; xx -= 2.0 * floor(xx * 0.5); const float xf = (float)xx;
          *(GAS f32x2*)(rot + 2 * idx) = (f32x2){cospif(xf), sinpif(xf)}; } }
    { float* hdn = F.W<float>(WS_HDN);
      for (int l = 0; l < NLAYER; ++l) {
          const GAS float* w1 = (const GAS float*)F.I(13) + l * 33 * 64 + lane; const GAS float* w2 = (const GAS float*)F.I(15) + l * 64 * 64 + lane;
          float w1c[33], w2c[64];
#pragma unroll
          for (int i = 0; i < 33; ++i) w1c[i] = w1[i * 64];
#pragma unroll
          for (int i = 0; i < 64; ++i) w2c[i] = w2[i * 64];
          const float fq_ = ((const GAS float*)F.I(18))[l * 64 + lane], b1 = ((const GAS float*)F.I(14))[l * 64 + lane], b2 = ((const GAS float*)F.I(16))[l * 64 + lane];
          const int bb = (lane - 1) & 15; const double fb2 = 2.0 * (1e-4 + (double)bb * ((15.0 - 1e-4) / 15.0)) * (1.0 / 16384.0);
          for (int t = gw; t < M; t += NGW) {
              float feat = (float)t * (1.0f / 16383.0f);
              if (lane >= 1 && lane < 33) { double xx = fb2 * (double)t; xx -= 2.0 * floor(xx * 0.5); const float xf = (float)xx; feat = lane <= 16 ? cospif(xf) : -sinpif(xf); }
              float h1 = b1;
#pragma unroll
              for (int i = 0; i < 33; ++i) h1 += __builtin_bit_cast(float, __builtin_amdgcn_readlane(__builtin_bit_cast(int, feat), i)) * w1c[i];
              h1 = __sinf(fq_ * h1);
              float h2 = b2;
#pragma unroll
              for (int i = 0; i < 64; ++i) h2 += __builtin_bit_cast(float, __builtin_amdgcn_readlane(__builtin_bit_cast(int, h1), i)) * w2c[i];
              ((GAS float*)hdn)[((size_t)l * M + t) * 64 + lane] = __sinf(fq_ * h2); } } }
    { bf16* wgt = F.W<bf16>(WS_WGT);
      for (int idx = gw * 64 + lane; idx < 2 * 2 * 2 * 8 * 16384; idx += NGW * 64) { const int i = idx & 127, j = (idx >> 7) & 127, h = (idx >> 14) & 7, g = (idx >> 17) & 1, ld = idx >> 18;
          const GAS float* src = (const GAS float*)(g ? F.I(7) : F.I(5)); ((GAS bf16*)wgt)[idx] = f2bf(src[((size_t)(ld * 8 + h) * 128 + i) * 128 + j]); } }
}
DEV void p0_prologue(const Frame& F, int rep = 0) {
    const int gw = F.vcu * 8 + F.wave, NGW = F.G * 8, lane = F.lane;
    if (F.wave & 1) { p0_small(F, gw, NGW, lane); p0_weights(F, gw, NGW, lane, rep); }
    else { p0_weights(F, gw, NGW, lane, rep); p0_small(F, gw, NGW, lane); }
}

DEV void hyt_unit(const Frame& F, int l, int unit) {
    int tid = F.tid; asm volatile("" : "+v"(tid)); const int tb = unit / 24, cb = unit - tb * 24, t0 = tb * 128, c0 = cb * 128;
    LAS float* S = (LAS float*)F.lds;
    const bf16* HU = F.W<bf16>(WS_PROJ + 64 * MiB);
    { v4u vv[5];
#pragma unroll
      for (int k = 0; k < 5; ++k) { const int task = tid + 512 * k, r = task >> 4, ch = task & 15, t = t0 - 1 + r; vv[k] = (v4u){0u, 0u, 0u, 0u};
          if (task < 130 * 16 && t >= 0 && t < M) vv[k] = *(const GAS v4u*)(HU + (size_t)t * 3072 + c0 + ch * 8); }
#pragma unroll
      for (int k = 0; k < 5; ++k) { const int task = tid + 512 * k, r = task >> 4, ch = task & 15; const v4u v = vv[k];
          if (task < 130 * 16) { LAS float* d = S + r * 129 + ch * 8; d[0] = bflo(v.x); d[1] = bfhi(v.x); d[2] = bflo(v.y); d[3] = bfhi(v.y); d[4] = bflo(v.z); d[5] = bfhi(v.z); d[6] = bflo(v.w); d[7] = bfhi(v.w); } } }
    __syncthreads();
    { const int cc = tid & 127, tq = tid >> 7, c = c0 + cc; const float* cw = F.I(11) + l * 3 * 3072; const float w0 = cw[c], w1 = cw[3072 + c], w2 = cw[2 * 3072 + c], b = F.I(12)[l * 3072 + c];
      bf16* dst = F.W<bf16>(WS_HYT) + (size_t)c * M + t0 + tq * 32;
#pragma unroll
      for (int k = 0; k < 4; ++k) { float y[8];
#pragma unroll
          for (int e = 0; e < 8; ++e) { const int t = tq * 32 + k * 8 + e; y[e] = b + w0 * S[t * 129 + cc] + w1 * S[(t + 1) * 129 + cc] + w2 * S[(t + 2) * 129 + cc]; }
          v4u o; o.x = pk2(y[0], y[1]); o.y = pk2(y[2], y[3]); o.z = pk2(y[4], y[5]); o.w = pk2(y[6], y[7]); *(GAS v4u*)(dst + k * 8) = o; } }
    __syncthreads();
}
DEV void split_bf16(const float (&x)[8], bf16x8& hi, bf16x8& lo) {
    unsigned h[4], l[4];
#pragma unroll
    for (int j = 0; j < 4; ++j) { h[j] = pk2(x[2 * j], x[2 * j + 1]); l[j] = pk2(x[2 * j] - bflo(h[j]), x[2 * j + 1] - bfhi(h[j])); }
    const v4u hv = (v4u){h[0], h[1], h[2], h[3]}, lv = (v4u){l[0], l[1], l[2], l[3]};
    hi = __builtin_bit_cast(bf16x8, hv); lo = __builtin_bit_cast(bf16x8, lv);
}
DEV void hyf_item(const Frame& F, int l, int item) {
    int lane = F.lane; asm volatile("" : "+v"(lane)); const int cg = item >> 5, tr = item & 31, fr = lane & 15, fq = lane >> 4;
    const float* w3 = F.I(17) + (size_t)l * 64 * 4096; const float* hdn = F.W<float>(WS_HDN) + (size_t)l * M * 64; bf16* filt = F.W<bf16>(WS_MIX);
    bf16x8 bh[4][2], bl[4][2]; float rate[4];
#pragma unroll
    for (int ct = 0; ct < 4; ++ct) { const int col = 64 * cg + 16 * ct + fr; rate[ct] = -fabsf(((const GAS float*)F.I(19))[l * 4096 + col]) * (1.0f / 16383.0f);
#pragma unroll
        for (int s = 0; s < 2; ++s) { float x[8];
#pragma unroll
            for (int j = 0; j < 8; ++j) x[j] = ((const GAS float*)w3)[(size_t)(32 * s + 8 * fq + j) * 4096 + col];
            split_bf16(x, bh[ct][s], bl[ct][s]); } }
    LAS unsigned char* wt = F.lds + F.wave * 9216;
    for (int tg = 0; tg < 8; ++tg) {
#pragma unroll
      for (int t4 = 0; t4 < 4; ++t4) { const int tb = tr * 512 + (tg * 4 + t4) * 16; const GAS f32x4* ap = (const GAS f32x4*)(hdn + (size_t)(tb + fr) * 64 + 8 * fq);
        bf16x8 ah[2], al[2];
#pragma unroll
        for (int s = 0; s < 2; ++s) { const f32x4 a0 = ap[8 * s], a1 = ap[8 * s + 1]; const float x[8] = {a0[0], a0[1], a0[2], a0[3], a1[0], a1[1], a1[2], a1[3]}; split_bf16(x, ah[s], al[s]); }
#pragma unroll
        for (int ct = 0; ct < 4; ++ct) { f32x4 acc = (f32x4){0.f, 0.f, 0.f, 0.f};
#pragma unroll
            for (int s = 0; s < 2; ++s) { acc = mfma16(al[s], bh[ct][s], acc); acc = mfma16(ah[s], bl[ct][s], acc); acc = mfma16(ah[s], bh[ct][s], acc); }
            const int t = tb + 4 * fq; float y[4];
#pragma unroll
            for (int e = 0; e < 4; ++e) y[e] = acc[e] * __expf((float)(t + e) * rate[ct]);
            v2u o; o.x = pk2(y[0], y[1]); o.y = pk2(y[2], y[3]); *(LAS v2u*)(wt + ct * 2304 + fr * 144 + t4 * 32 + fq * 8) = o; } }
      LDS_WAIT();
#pragma unroll
      for (int ct = 0; ct < 4; ++ct)
#pragma unroll
          for (int it = 0; it < 2; ++it) { const int row = lane >> 2, ch = (lane & 3) + 4 * it; const v4u v = *(const LAS v4u*)(wt + ct * 2304 + row * 144 + ch * 16);
              *(GAS v4u*)(filt + (size_t)(64 * cg + 16 * ct + row) * M + tr * 512 + tg * 64 + ch * 8) = v; }
      LDS_WAIT();
    }
}
template <bool PHASE_C> DEV void lru_unit(const Frame& F, int l, int n, int h) {
    int tid = F.tid; asm volatile("" : "+v"(tid)); const int t0 = n * 128, lane = tid & 63, w = F.wave, fr = lane & 15, fq = lane >> 4;
    LAS unsigned char* RAW = F.lds; LAS unsigned char* XCF = F.lds + 33792; LAS unsigned char* XCB = F.lds + 33792 + 67584;
    const bf16* LX = F.W<bf16>(WS_PROJ + 32 * MiB);
    const int cw16 = 16 * w + fr, cg = h * 128 + cw16;
    const float* CIN = F.W<float>(WS_LRUC) + 4 * 128 * 1024;
    const float* cw = F.I(3) + l * 4 * 1024; const float* cb = F.I(4) + l * 1024; const int c4 = tid & 31, c = h * 128 + c4 * 4;
    v4u vv[5];
#pragma unroll
    for (int k = 0; k < 5; ++k) { const int task = tid + 512 * k, r = (task >> 4) > 130 ? 130 : (task >> 4), ch = task & 15, t = t0 - 2 + r, tc = t < 0 ? 0 : (t > M - 1 ? M - 1 : t);
        vv[k] = *(const GAS v4u*)(LX + (size_t)tc * 1024 + h * 128 + ch * 8); if (t != tc) vv[k] = (v4u){0u, 0u, 0u, 0u}; }
    const f32x4 bias = *(const GAS f32x4*)(cb + c), w0 = *(const GAS f32x4*)(cw + c), w1 = *(const GAS f32x4*)(cw + 1024 + c), w2 = *(const GAS f32x4*)(cw + 2048 + c), w3 = *(const GAS f32x4*)(cw + 3072 + c);
    float brv2[2], biv2[2], lam2[2], cin2[2];
#pragma unroll
    for (int d = 0; d < 2; ++d) {
        const int pidx = (l * 2 + d) * 1024 + cg; brv2[d] = ((const GAS float*)F.I(6))[pidx]; biv2[d] = ((const GAS float*)F.I(8))[pidx]; lam2[d] = ((const GAS float*)F.I(9))[pidx];
        cin2[d] = PHASE_C ? ((const GAS float*)CIN)[(d * 128 + n) * 1024 + cg] : 0.f; }
#pragma unroll
    for (int k = 0; k < 5; ++k) { const int task = tid + 512 * k, r = task >> 4, ch = task & 15; if (task < 131 * 16) *(LAS v4u*)(RAW + r * 256 + ch * 16) = vv[k]; }
    __syncthreads();
    {
#pragma unroll
      for (int k = 0; k < 8; ++k) { const int t = (tid >> 5) + 16 * k; f32x4 a = bias;
          const v2u r0 = *(const LAS v2u*)(RAW + (t + 0) * 256 + c4 * 8), r1 = *(const LAS v2u*)(RAW + (t + 1) * 256 + c4 * 8), r2 = *(const LAS v2u*)(RAW + (t + 2) * 256 + c4 * 8), r3 = *(const LAS v2u*)(RAW + (t + 3) * 256 + c4 * 8);
          a[0] += w0[0] * bflo(r0.x) + w1[0] * bflo(r1.x) + w2[0] * bflo(r2.x) + w3[0] * bflo(r3.x); a[1] += w0[1] * bfhi(r0.x) + w1[1] * bfhi(r1.x) + w2[1] * bfhi(r2.x) + w3[1] * bfhi(r3.x);
          a[2] += w0[2] * bflo(r0.y) + w1[2] * bflo(r1.y) + w2[2] * bflo(r2.y) + w3[2] * bflo(r3.y); a[3] += w0[3] * bfhi(r0.y) + w1[3] * bfhi(r1.y) + w2[3] * bfhi(r2.y) + w3[3] * bfhi(r3.y);
          *(LAS f32x4*)(XCF + t * 528 + c4 * 16) = a; v2u pb; pb.x = pk2(a[0], a[1]); pb.y = pk2(a[2], a[3]); *(LAS v2u*)(XCB + t * 272 + c4 * 8) = pb; } }
    __syncthreads();
    float* AP = F.W<float>(WS_LRUC); float* BE = AP + 2 * 128 * 1024;
    float hs[8][4];
#pragma unroll
    for (int d = 0; d < 2; ++d) {
        const bf16* wg = F.W<bf16>(WS_WGT) + ((((size_t)(l * 2 + d) * 2) * 8 + h) * 128 + cw16) * 128;
        bf16x8 br_[4], bi_[4];
#pragma unroll
        for (int s = 0; s < 4; ++s) { br_[s] = *(const GAS bf16x8*)(wg + 32 * s + 8 * fq); bi_[s] = *(const GAS bf16x8*)(wg + (size_t)8 * 128 * 128 + 32 * s + 8 * fq); }
        const float brv = brv2[d], biv = biv2[d], sp = log1pf(__expf(-lam2[d]));
        const int bp16 = 4 * (d == 0 ? (lane >= 16 ? lane - 16 : lane) : (lane < 48 ? lane + 16 : lane)), bp32 = 4 * (d == 0 ? (lane >= 32 ? lane - 32 : lane) : (lane < 32 ? lane + 32 : lane)), bpt = 4 * (d == 0 ? fr + 48 : fr);
#define BPERM(addr, x) __builtin_bit_cast(float, __builtin_amdgcn_ds_bpermute((addr), __builtin_bit_cast(int, (x))))
        float hin = cin2[d], CA = 1.f, CB = 0.f;
#pragma unroll
        for (int hf = 0; hf < 4; ++hf) { const int mb = (d == 0 ? hf : 3 - hf) * 2;
        f32x4 pra[2], pia[2];
#pragma unroll
        for (int m4 = 0; m4 < 2; ++m4) { const int m = mb + m4;
            f32x4 pr = (f32x4){0.f, 0.f, 0.f, 0.f}, pi = (f32x4){0.f, 0.f, 0.f, 0.f};
#pragma unroll
            for (int s = 0; s < 4; ++s) { const bf16x8 a = lfrag(XCB, 16 * m, s, 272, fr, fq); pr = mfma16(a, br_[s], pr); pi = mfma16(a, bi_[s], pi); }
#pragma unroll
            for (int e = 0; e < 4; ++e) { const int tk = 16 * m + 4 * fq + e; const float xc = *(const LAS float*)(XCF + tk * 528 + cw16 * 4);
                const float r = sigmoidf_(pr[e] + brv), ig = sigmoidf_(pi[e] + biv), la = -8.f * r * sp;
                const float av = __expf(la), om = (1.f - av) * (1.f + av);
                pr[e] = av; pi[e] = __builtin_amdgcn_sqrtf(om) * ig * xc; }
            pra[m4] = pr; pia[m4] = pi; }
#pragma unroll
        for (int mm = 0; mm < 2; ++mm) { const int m4 = d == 0 ? mm : 1 - mm, m = mb + m4; const f32x4 pr = pra[m4], pi = pia[m4];
            float A = 1.f, B = 0.f;
#pragma unroll
            for (int rr = 0; rr < 4; ++rr) { const int e = d == 0 ? rr : 3 - rr; B = pr[e] * B + pi[e]; A = A * pr[e]; }
            float EA, EB, TA, TB;
            { float A1 = BPERM(bp16, A), B1 = BPERM(bp16, B); if (d == 0 ? fq >= 1 : fq <= 2) { B = A * B1 + B; A = A1 * A; }
              A1 = BPERM(bp32, A); B1 = BPERM(bp32, B); if (d == 0 ? fq >= 2 : fq <= 1) { B = A * B1 + B; A = A1 * A; }
              EA = BPERM(bp16, A); EB = BPERM(bp16, B); if (d == 0 ? fq == 0 : fq == 3) { EA = 1.f; EB = 0.f; }
              TA = BPERM(bpt, A); TB = BPERM(bpt, B); }
            if (PHASE_C) { float hc = EA * hin + EB;
#pragma unroll
                for (int rr = 0; rr < 4; ++rr) { const int e = d == 0 ? rr : 3 - rr; hc = pr[e] * hc + pi[e]; if (d == 0) hs[m][e] = hc; else hs[m][e] += hc; } }
            hin = TA * hin + TB; CB = TA * CB + TB; CA = CA * TA; }
        __builtin_amdgcn_sched_barrier(0); }
#undef BPERM
        if (!PHASE_C && fq == 0) { ((GAS float*)AP)[(d * 128 + n) * 1024 + cg] = CA; ((GAS float*)BE)[(d * 128 + n) * 1024 + cg] = CB; }
    }
    if (PHASE_C) {
        bf16* MIX = F.W<bf16>(WS_MIX); const bf16* LG = F.W<bf16>(WS_PROJ); const float* gn = F.I(10) + l * 1024 + h * 128;
        v4u lgv[4];
#pragma unroll
        for (int k = 0; k < 4; ++k) { const int task = tid + 512 * k, t = task >> 4, ch = task & 15; lgv[k] = *(const GAS v4u*)(LG + (size_t)(t0 + t) * 1024 + h * 128 + ch * 8); }
        const f32x4 gn0 = *(const GAS f32x4*)(gn + (tid & 15) * 8), gn1 = *(const GAS f32x4*)(gn + (tid & 15) * 8 + 4);
        __syncthreads();
#pragma unroll
        for (int m = 0; m < 8; ++m)
#pragma unroll
            for (int e = 0; e < 4; ++e) *(LAS float*)(XCF + (16 * m + 4 * fq + e) * 528 + cw16 * 4) = hs[m][e];
        __syncthreads();
#pragma unroll
        for (int k = 0; k < 4; ++k) { const int task = tid + 512 * k, t = task >> 4, ch = task & 15;
            const f32x4 h0 = *(const LAS f32x4*)(XCF + t * 528 + ch * 32), h1 = *(const LAS f32x4*)(XCF + t * 528 + ch * 32 + 16);
            const v4u lg = lgv[k];
            float y[8]; y[0] = bflo(lg.x) * h0[0]; y[1] = bfhi(lg.x) * h0[1]; y[2] = bflo(lg.y) * h0[2]; y[3] = bfhi(lg.y) * h0[3];
            y[4] = bflo(lg.z) * h1[0]; y[5] = bfhi(lg.z) * h1[1]; y[6] = bflo(lg.w) * h1[2]; y[7] = bfhi(lg.w) * h1[3];
            float ss = 0.f;
#pragma unroll
            for (int e = 0; e < 8; ++e) ss += y[e] * y[e];
            ss += shx(ss, 1, lane); ss += shx(ss, 2, lane); ss += shx(ss, 4, lane); ss += shx(ss, 8, lane);
            const float rinv = rsqrtf(ss * (1.f / 128.f) + EPS); const f32x4 g0 = gn0, g1 = gn1;
            v4u o; o.x = pk2(y[0] * rinv * g0[0], y[1] * rinv * g0[1]); o.y = pk2(y[2] * rinv * g0[2], y[3] * rinv * g0[3]);
            o.z = pk2(y[4] * rinv * g1[0], y[5] * rinv * g1[1]); o.w = pk2(y[6] * rinv * g1[2], y[7] * rinv * g1[3]);
            *(GAS v4u*)(MIX + (size_t)(t0 + t) * 4096 + h * 128 + ch * 8) = o; }
    }
    __syncthreads();
}
DEV void reta_unit(const Frame& F, int n, int h) {
    int tid = F.tid; asm volatile("" : "+v"(tid)); const int t0 = n * 128, lane = tid & 63, w = F.wave, fr = lane & 15, fq = lane >> 4;
    LAS unsigned char* KTF = F.lds; LAS unsigned char* KTB = F.lds + 34816; LAS unsigned char* VT = F.lds + 69632;
    const bf16* Kr = F.W<bf16>(WS_PROJ + 192 * MiB); const bf16* V = F.W<bf16>(WS_PROJ + 224 * MiB); bf16* KV = F.W<bf16>(WS_KV);
    const float l2g = log2f(1.f - exp2f(-5.f - (float)h));
    v4u kr0[2], kr1[2], vr0[4], vr1[4];
#pragma unroll
    for (int k = 0; k < 2; ++k) { const int task = tid + 512 * k, p = task & 63, ch = task >> 6, c0 = 2 * p;
        kr0[k] = *(const GAS v4u*)(Kr + (size_t)(t0 + c0) * 1024 + h * 128 + ch * 8); kr1[k] = *(const GAS v4u*)(Kr + (size_t)(t0 + c0 + 1) * 1024 + h * 128 + ch * 8); }
#pragma unroll
    for (int k = 0; k < 4; ++k) { const int task = tid + 512 * k, p = task & 63, ch = task >> 6, c0 = 2 * p;
        vr0[k] = *(const GAS v4u*)(V + (size_t)(t0 + c0) * 2048 + h * 256 + ch * 8); vr1[k] = *(const GAS v4u*)(V + (size_t)(t0 + c0 + 1) * 2048 + h * 256 + ch * 8); }
#pragma unroll
    for (int k = 0; k < 2; ++k) { const int task = tid + 512 * k, p = task & 63, ch = task >> 6, c0 = 2 * p;
        const v4u r0 = kr0[k], r1 = kr1[k];
        const float ff0 = __builtin_amdgcn_exp2f((float)(127 - c0) * l2g), ff1 = __builtin_amdgcn_exp2f((float)(126 - c0) * l2g), fb0 = __builtin_amdgcn_exp2f((float)c0 * l2g), fb1 = __builtin_amdgcn_exp2f((float)(c0 + 1) * l2g);
#define KT_ST(E) { const float k0 = bfe<E>(r0), k1 = bfe<E>(r1); *(LAS unsigned*)(KTF + (ch * 8 + E) * 272 + c0 * 2) = pk2(k0 * ff0, k1 * ff1); *(LAS unsigned*)(KTB + (ch * 8 + E) * 272 + c0 * 2) = pk2(k0 * fb0, k1 * fb1); }
        KT_ST(0) KT_ST(1) KT_ST(2) KT_ST(3) KT_ST(4) KT_ST(5) KT_ST(6) KT_ST(7)
#undef KT_ST
    }
#pragma unroll
    for (int k = 0; k < 4; ++k) { const int task = tid + 512 * k, p = task & 63, ch = task >> 6, c0 = 2 * p;
        const v4u r0 = vr0[k], r1 = vr1[k];
#define VT_ST(E) { *(LAS unsigned*)(VT + (ch * 8 + E) * 272 + c0 * 2) = pk2(bfe<E>(r0), bfe<E>(r1)); }
        VT_ST(0) VT_ST(1) VT_ST(2) VT_ST(3) VT_ST(4) VT_ST(5) VT_ST(6) VT_ST(7)
#undef VT_ST
    }
    __syncthreads();
    f32x4 acc[2][8][2];
#pragma unroll
    for (int a = 0; a < 2; ++a)
#pragma unroll
        for (int b = 0; b < 8; ++b)
#pragma unroll
            for (int c = 0; c < 2; ++c) acc[a][b][c] = (f32x4){0.f, 0.f, 0.f, 0.f};
#pragma unroll
    for (int s = 0; s < 4; ++s) { const bf16x8 bv0 = lfrag(VT, 32 * w, s, 272, fr, fq), bv1 = lfrag(VT, 32 * w + 16, s, 272, fr, fq);
#pragma unroll
        for (int dt = 0; dt < 8; ++dt) { const bf16x8 af = lfrag(KTF, 16 * dt, s, 272, fr, fq), ab = lfrag(KTB, 16 * dt, s, 272, fr, fq);
            acc[0][dt][0] = mfma16(af, bv0, acc[0][dt][0]); acc[0][dt][1] = mfma16(af, bv1, acc[0][dt][1]);
            acc[1][dt][0] = mfma16(ab, bv0, acc[1][dt][0]); acc[1][dt][1] = mfma16(ab, bv1, acc[1][dt][1]); } }
#pragma unroll
    for (int dir = 0; dir < 2; ++dir)
#pragma unroll
        for (int dt = 0; dt < 8; ++dt)
#pragma unroll
            for (int et = 0; et < 2; ++et) { const f32x4 a = acc[dir][dt][et]; v2u o; o.x = pk2(a[0], a[1]); o.y = pk2(a[2], a[3]);
                *(GAS v2u*)(KV + ((size_t)(dir * 128 + n) * 8 + h) * 32768 + (32 * w + 16 * et + fr) * 128 + 16 * dt + 4 * fq) = o; }
    __syncthreads();
}

DEV void lrub_all(const Frame& F) {
    const GAS float* AP = (const GAS float*)F.W<float>(WS_LRUC); const GAS float* BE = AP + 2 * 128 * 1024; GAS float* CIN = (GAS float*)F.W<float>(WS_LRUC) + 4 * 128 * 1024;
    for (int idx = F.vcu * 512 + F.tid; idx < 2048; idx += F.G * 512) { const int d = idx >> 10, c = idx & 1023; float s = 0.f;
        for (int it0 = 0; it0 < 128; it0 += 16) { float a[16], b[16];
#pragma unroll
            for (int j = 0; j < 16; ++j) { const int it = it0 + j, n = d ? 127 - it : it, o = (d * 128 + n) * 1024 + c; a[j] = AP[o]; b[j] = BE[o]; }
#pragma unroll
            for (int j = 0; j < 16; ++j) { const int it = it0 + j, n = d ? 127 - it : it, o = (d * 128 + n) * 1024 + c; CIN[o] = s; s = a[j] * s + b[j]; } } }
}
DEV void retb_all(const Frame& F) {
    GAS bf16* KV = (GAS bf16*)F.W<bf16>(WS_KV);
    for (int idx = F.vcu * 512 + F.tid; idx < 131072; idx += F.G * 512) { const int dir = idx >> 16, h = (idx >> 13) & 7, off = (idx & 8191) * 4;
        const float dec = exp2f(128.f * log2f(1.f - exp2f(-5.f - (float)h))); float s0 = 0.f, s1 = 0.f, s2 = 0.f, s3 = 0.f;
        for (int it0 = 0; it0 < 128; it0 += 16) { v2u v[16];
#pragma unroll
            for (int j = 0; j < 16; ++j) { const int it = it0 + j, n = dir ? 127 - it : it; v[j] = *(const GAS v2u*)(KV + ((size_t)(dir * 128 + n) * 8 + h) * 32768 + off); }
#pragma unroll
            for (int j = 0; j < 16; ++j) { const int it = it0 + j, n = dir ? 127 - it : it; v2u o; o.x = pk2(s0, s1); o.y = pk2(s2, s3); *(GAS v2u*)(KV + ((size_t)(dir * 128 + n) * 8 + h) * 32768 + off) = o;
                s0 = dec * s0 + bflo(v[j].x); s1 = dec * s1 + bfhi(v[j].x); s2 = dec * s2 + bflo(v[j].y); s3 = dec * s3 + bfhi(v[j].y); } } }
}
DEV int rev14(int p) { const unsigned r = __builtin_bitreverse32((unsigned)p) >> 18; return (int)(((r & 0x1555u) << 1) | ((r >> 1) & 0x1555u)); }
DEV f32x2 twid(const LAS f32x2* TH, const LAS f32x2* TL, int e) { return cmul(TH[e >> 7], TL[e & 127]); }
constexpr int FFT_IM_OFF = 69632, FFT_TAB_OFF = 139264;
DEV int ppad(int p) { return p + 4 * (p >> 6); }
struct cpx2 { f32x2 r, i; };
DEV cpx2 cmul2(const cpx2 a, const cpx2 b) { cpx2 c; c.r = a.r * b.r - a.i * b.i; c.i = a.r * b.i + a.i * b.r; return c; }
DEV cpx2 cmulc(const cpx2 a, float cr, float ci) { cpx2 c; c.r = a.r * cr - a.i * ci; c.i = a.r * ci + a.i * cr; return c; }
DEV void r4p(cpx2& a0, cpx2& a1, cpx2& a2, cpx2& a3) {
    const f32x2 b0r = a0.r + a2.r, b0i = a0.i + a2.i, b1r = a0.r - a2.r, b1i = a0.i - a2.i, b2r = a1.r + a3.r, b2i = a1.i + a3.i, tr = a1.r - a3.r, ti = a1.i - a3.i;
    a0.r = b0r + b2r; a0.i = b0i + b2i; a1.r = b1r + ti; a1.i = b1i - tr; a2.r = b0r - b2r; a2.i = b0i - b2i; a3.r = b1r - ti; a3.i = b1i + tr;
}
template <bool DIT> DEV void r16_core(cpx2 (&e)[16], const cpx2 w) {
    const cpx2 ww = cmul2(w, w), w4 = cmul2(ww, ww), w8 = cmul2(w4, w4), w12 = cmul2(w8, w4);
    if (DIT) {
#pragma unroll
        for (int p = 0; p < 4; ++p) { e[4 * p + 1] = cmul2(e[4 * p + 1], w4); e[4 * p + 2] = cmul2(e[4 * p + 2], w8); e[4 * p + 3] = cmul2(e[4 * p + 3], w12); r4p(e[4 * p], e[4 * p + 1], e[4 * p + 2], e[4 * p + 3]); }
    }
#pragma unroll
    for (int r = 0; r < 4; ++r) {
        const cpx2 w1 = r == 0 ? w : r == 1 ? cmulc(w, 0.9238795325112867f, -0.3826834323650898f) : r == 2 ? cmulc(w, 0.7071067811865476f, -0.7071067811865476f) : cmulc(w, 0.3826834323650898f, -0.9238795325112867f);
        const cpx2 w2 = cmul2(w1, w1), w3 = cmul2(w2, w1);
        if (DIT) { e[r + 4] = cmul2(e[r + 4], w1); e[r + 8] = cmul2(e[r + 8], w2); e[r + 12] = cmul2(e[r + 12], w3); }
        r4p(e[r], e[r + 4], e[r + 8], e[r + 12]);
        if (!DIT) { e[r + 4] = cmul2(e[r + 4], w1); e[r + 8] = cmul2(e[r + 8], w2); e[r + 12] = cmul2(e[r + 12], w3); }
    }
    if (!DIT) {
#pragma unroll
        for (int p = 0; p < 4; ++p) { r4p(e[4 * p], e[4 * p + 1], e[4 * p + 2], e[4 * p + 3]); e[4 * p + 1] = cmul2(e[4 * p + 1], w4); e[4 * p + 2] = cmul2(e[4 * p + 2], w8); e[4 * p + 3] = cmul2(e[4 * p + 3], w12); }
    }
}
template <bool DIT, int LQ16> DEV void r16_pass(LAS unsigned char* lds, const LAS f32x2* TH, const LAS f32x2* TL, int tid) {
    constexpr int q16 = 1 << LQ16, sp = q16 >= 64 ? q16 + 4 * (q16 >> 6) : q16;
    asm volatile("" : "+v"(tid));
    int g, i;
    if (LQ16 == 10) { g = 0; i = 2 * tid; } else if (LQ16 == 6) { g = tid >> 5; i = 2 * (tid & 31); } else { g = tid >> 1; i = 2 * (tid & 1); }
    const int p0 = ppad((g << (LQ16 + 4)) + i);
    const LAS float* RE = (const LAS float*)lds; const LAS float* IM = (const LAS float*)(lds + FFT_IM_OFF);
    const f32x2 wA = twid(TH, TL, i << (10 - LQ16)), wB = twid(TH, TL, (i + 1) << (10 - LQ16));
    cpx2 w; w.r = (f32x2){wA.x, wB.x}; w.i = (f32x2){wA.y, wB.y};
    cpx2 e[16];
#pragma unroll
    for (int r = 0; r < 16; ++r) { e[r].r = *(const LAS f32x2*)(RE + p0 + r * sp); e[r].i = *(const LAS f32x2*)(IM + p0 + r * sp); }
    r16_core<DIT>(e, w);
#pragma unroll
    for (int r = 0; r < 16; ++r) { *(LAS f32x2*)((LAS float*)RE + p0 + r * sp) = e[r].r; *(LAS f32x2*)((LAS float*)IM + p0 + r * sp) = e[r].i; }
    __syncthreads();
}
DEV void r4_pass(LAS unsigned char* lds, int tid) {
    asm volatile("" : "+v"(tid));
    LAS float* RE = (LAS float*)lds; LAS float* IM = (LAS float*)(lds + FFT_IM_OFF);
#pragma unroll
    for (int hh = 0; hh < 2; ++hh) { f32x4 R[4], I[4];
#pragma unroll
        for (int c = 0; c < 4; ++c) { const int g = tid + 512 * (4 * hh + c), p = 4 * g + 4 * (g >> 4); R[c] = *(const LAS f32x4*)(RE + p); I[c] = *(const LAS f32x4*)(IM + p); }
#pragma unroll
        for (int c = 0; c < 4; ++c) { const int g = tid + 512 * (4 * hh + c), p = 4 * g + 4 * (g >> 4);
            const float b0r = R[c][0] + R[c][2], b0i = I[c][0] + I[c][2], b1r = R[c][0] - R[c][2], b1i = I[c][0] - I[c][2], b2r = R[c][1] + R[c][3], b2i = I[c][1] + I[c][3], tr = R[c][1] - R[c][3], ti = I[c][1] - I[c][3];
            *(LAS f32x4*)(RE + p) = (f32x4){b0r + b2r, b1r + ti, b0r - b2r, b1r - ti}; *(LAS f32x4*)(IM + p) = (f32x4){b0i + b2i, b1i - tr, b0i - b2i, b1i + tr}; } }
    __syncthreads();
}
DEV void fft_dif(LAS unsigned char* lds, const LAS f32x2* TH, const LAS f32x2* TL, int tid) {
    r16_pass<false, 10>(lds, TH, TL, tid); r16_pass<false, 6>(lds, TH, TL, tid); r16_pass<false, 2>(lds, TH, TL, tid); r4_pass(lds, tid);
}
DEV void fft_dit(LAS unsigned char* lds, const LAS f32x2* TH, const LAS f32x2* TL, int tid) {
    r4_pass(lds, tid); r16_pass<true, 2>(lds, TH, TL, tid); r16_pass<true, 6>(lds, TH, TL, tid); r16_pass<true, 10>(lds, TH, TL, tid);
}
DEV f32x2 fb_ld(const LAS unsigned char* lds, int p) { const int q = ppad(p); return (f32x2){((const LAS float*)lds)[q], ((const LAS float*)(lds + FFT_IM_OFF))[q]}; }
DEV void fb_st(LAS unsigned char* lds, int p, const f32x2 v) { const int q = ppad(p); ((LAS float*)lds)[q] = v.x; ((LAS float*)(lds + FFT_IM_OFF))[q] = v.y; }
DEV void hy_pair(const f32x2 Z, const f32x2 Zp, const f32x2 G, const f32x2 Gq, const f32x2 w, f32x2& o0, f32x2& o1) {
    const float invN = 1.0f / 16384.0f;
    const f32x2 Ze = (f32x2){0.5f * (Z.x + Zp.x), 0.5f * (Z.y - Zp.y)}, Zo = (f32x2){0.5f * (Z.y + Zp.y), -0.5f * (Z.x - Zp.x)};
    const f32x2 Ge = (f32x2){0.5f * (G.x + Gq.x), 0.5f * (G.y - Gq.y)}, Go = (f32x2){0.5f * (G.y + Gq.y), -0.5f * (G.x - Gq.x)};
    const f32x2 wZo = cmul(w, Zo), wGo = cmul(w, Go), U = cmul(Ze + wZo, Ge + wGo), V = cmul(Ze - wZo, Ge - wGo);
    const f32x2 Ye = 0.5f * (U + V), Yo = 0.5f * cmul(U - V, (f32x2){w.x, -w.y});
    o0 = (f32x2){(Ye.x - Yo.y) * invN, -(Ye.y + Yo.x) * invN}; o1 = (f32x2){(Ye.x + Yo.y) * invN, (Ye.y - Yo.x) * invN};
}
struct RetbJob { GAS bf16* p; int step; float dec, s0, s1, s2, s3; int left; };
DEV RetbJob retb_begin(const Frame& F) {
    RetbJob j; const int idx = F.vcu * 512 + F.tid; j.left = 0; j.p = (GAS bf16*)F.W<bf16>(WS_KV); j.step = 0; j.dec = 0.f; j.s0 = j.s1 = j.s2 = j.s3 = 0.f;
    if (idx < 131072 && F.G * 512 >= 131072) { const int dir = idx >> 16, h = (idx >> 13) & 7, off = (idx & 8191) * 4;
        j.p += ((size_t)(dir * 128 + (dir ? 127 : 0)) * 8 + h) * 32768 + off; j.step = dir ? -(8 * 32768) : 8 * 32768; j.dec = exp2f(128.f * log2f(1.f - exp2f(-5.f - (float)h))); j.left = 128; }
    return j;
}
template <int NB> DEV void retb_load(const RetbJob& j, v2u (&v)[NB]) {
#pragma unroll
    for (int b = 0; b < NB; ++b) v[b] = *(const GAS v2u*)(j.p + (long)b * j.step);
}
template <int NB> DEV void retb_store(RetbJob& j, const v2u (&v)[NB]) {
#pragma unroll
    for (int b = 0; b < NB; ++b) if (b < j.left) { v2u o; o.x = pk2(j.s0, j.s1); o.y = pk2(j.s2, j.s3); *(GAS v2u*)(j.p + (long)b * j.step) = o;
        j.s0 = j.dec * j.s0 + bflo(v[b].x); j.s1 = j.dec * j.s1 + bfhi(v[b].x); j.s2 = j.dec * j.s2 + bflo(v[b].y); j.s3 = j.dec * j.s3 + bfhi(v[b].y); }
    const int n = j.left < NB ? j.left : NB; j.p += (long)n * j.step; j.left -= n;
}
DEV f32x2 conv_pair(unsigned wp, unsigned wc_, unsigned wn, const f32x4 k) { const float um = bfhi(wp), u0 = bflo(wc_), u1 = bfhi(wc_), u2 = bflo(wn);
    return (f32x2){k[3] + k[0] * um + k[1] * u0 + k[2] * u1, k[3] + k[0] * u0 + k[1] * u1 + k[2] * u2}; }
#define HY_LD3(rowp, wp, wc_, wn) do { _Pragma("unroll") for (int i = 0; i < 16; ++i) { const int m = tid + 512 * i, mp = m > 0 ? m - 1 : 0, mn = m < 8191 ? m + 1 : 8191;     \
    wc_[i] = *(const GAS unsigned*)((rowp) + 2 * m); wp[i] = *(const GAS unsigned*)((rowp) + 2 * mp); wn[i] = *(const GAS unsigned*)((rowp) + 2 * mn); } \
    _Pragma("unroll") for (int i = 0; i < 16; ++i) { const int m = tid + 512 * i; wp[i] = m > 0 ? wp[i] : 0u; wn[i] = m < 8191 ? wn[i] : 0u; } } while (0)
DEV void hyena_unit(const Frame& F, int l, int c, RetbJob& job) {
    int tid = F.tid; asm volatile("" : "+v"(tid));
    LAS unsigned char* FB = F.lds; LAS f32x2* TH = (LAS f32x2*)(F.lds + FFT_TAB_OFF); LAS f32x2* TL = TH + 128; LAS f32x2* T2H = TL + 128; LAS f32x2* T2L = T2H + 128;
    const bf16* FILT = F.W<bf16>(WS_MIX); const bf16* HYT = F.W<bf16>(WS_HYT); bf16* HYO = F.W<bf16>(WS_HYO);
    const bf16* zv = HYT + (size_t)c * M;
    f32x4 kz, kg0, kg1;
    { const GAS float* cw = (const GAS float*)F.I(11) + l * 3 * 3072; const GAS float* cb = (const GAS float*)F.I(12) + l * 3072;
      kz = (f32x4){cw[c], cw[3072 + c], cw[6144 + c], cb[c]}; kg0 = (f32x4){cw[1024 + c], cw[3072 + 1024 + c], cw[6144 + 1024 + c], cb[1024 + c]}; kg1 = (f32x4){cw[2048 + c], cw[3072 + 2048 + c], cw[6144 + 2048 + c], cb[2048 + c]}; }
    f32x2 Gk[16], Gq[16], Gmid;
    f32x2* Z1 = F.W<f32x2>(WS_GSCR + (size_t)blockIdx.x * 384 * 1024);
#pragma unroll
    for (int o = 0; o < 2; ++o) {
        const bf16* hf = FILT + (size_t)((2 * o) * 1024 + c) * M; const bf16* hb = FILT + (size_t)((2 * o + 1) * 1024 + c) * M;
        { unsigned wl[16]; unsigned short ha[16], hc[16]; const float hb0 = bf2f(((const GAS bf16*)hb)[0]);
#pragma unroll
          for (int i = 0; i < 16; ++i) { const int m = tid + 512 * i; wl[i] = *(const GAS unsigned*)(hf + 2 * m); ha[i] = ((const GAS bf16*)hb)[m ? 16384 - 2 * m : 0]; hc[i] = ((const GAS bf16*)hb)[16383 - 2 * m]; }
#pragma unroll
          for (int i = 0; i < 16; ++i) { const int m = tid + 512 * i; f32x2 v = (f32x2){bflo(wl[i]), bfhi(wl[i])}; if (m == 0) v.x += hb0; fb_st(FB, m, v);
              fb_st(FB, 8192 + m, (f32x2){m ? bf2f(ha[i]) : 0.f, bf2f(hc[i])}); } }
        __syncthreads();
        { v2u jv[8]; retb_load<8>(job, jv); fft_dif(FB, TH, TL, tid); retb_store<8>(job, jv); }
        asm volatile("" : "+v"(tid));
#pragma unroll
        for (int i = 0; i < 16; ++i) { const int q = 4 * (tid >> 1) + (tid & 1) + 1024 * i, k = rev14(q); Gk[i] = fb_ld(FB, q); Gq[i] = fb_ld(FB, rev14((16384 - k) & 16383)); }
        Gmid = fb_ld(FB, rev14(8192));
        __syncthreads();
        asm volatile("" : "+v"(tid));
        if (o == 0) { unsigned wp[16], wz[16], wn[16]; HY_LD3(zv, wp, wz, wn);
#pragma unroll
            for (int i = 0; i < 16; ++i) { const int m = tid + 512 * i; fb_st(FB, m, conv_pair(wp[i], wz[i], wn[i], kz)); fb_st(FB, 8192 + m, (f32x2){0.f, 0.f}); } }
        else { f32x2 zz[16];
#pragma unroll
            for (int i = 0; i < 16; ++i) zz[i] = ((const GAS f32x2*)Z1)[tid + 512 * i];
#pragma unroll
            for (int i = 0; i < 16; ++i) { const int m = tid + 512 * i; fb_st(FB, m, zz[i]); fb_st(FB, 8192 + m, (f32x2){0.f, 0.f}); } }
        __syncthreads();
        fft_dif(FB, TH, TL, tid);
        asm volatile("" : "+v"(tid));
        {
#pragma unroll
          for (int hb_ = 0; hb_ < 2; ++hb_) { asm volatile("" : "+v"(tid)); f32x2 Z[8], Zp[8]; int kk[8], fpp[8];
#pragma unroll
              for (int ii = 0; ii < 8; ++ii) { const int q = 4 * (tid >> 1) + (tid & 1) + 1024 * (8 * hb_ + ii); kk[ii] = rev14(q); fpp[ii] = rev14((16384 - kk[ii]) & 16383); Z[ii] = fb_ld(FB, q); Zp[ii] = fb_ld(FB, fpp[ii]); }
#pragma unroll
              for (int ii = 0; ii < 8; ++ii) { const int i = 8 * hb_ + ii, q = 4 * (tid >> 1) + (tid & 1) + 1024 * i; const f32x2 w = cmul(T2H[kk[ii] >> 7], T2L[kk[ii] & 127]); f32x2 o0, o1;
                  hy_pair(Z[ii], Zp[ii], Gk[i], Gq[i], w, o0, o1); fb_st(FB, q, o0); fb_st(FB, fpp[ii], o1); } }
          if (tid == 0) { const int fm = rev14(8192); const f32x2 Zm = fb_ld(FB, fm); f32x2 o0, o1; hy_pair(Zm, Zm, Gmid, Gmid, (f32x2){0.f, -1.f}, o0, o1); fb_st(FB, fm, o0); } }
        __syncthreads();
        { v2u jv[8]; retb_load<8>(job, jv); fft_dit(FB, TH, TL, tid); retb_store<8>(job, jv); }
        asm volatile("" : "+v"(tid));
        if (o == 0) { const bf16* g0 = HYT + (size_t)(1024 + c) * M; const float sk = ((const GAS float*)F.I(20))[l * 2048 + c]; f32x2 zc[16];
            { unsigned wp[16], wz[16], wn[16]; HY_LD3(zv, wp, wz, wn);
#pragma unroll
              for (int i = 0; i < 16; ++i) zc[i] = conv_pair(wp[i], wz[i], wn[i], kz); }
            { unsigned wp[16], wg[16], wn[16]; HY_LD3(g0, wp, wg, wn);
#pragma unroll
              for (int i = 0; i < 16; ++i) { const f32x2 y = fb_ld(FB, tid + 512 * i), gg = conv_pair(wp[i], wg[i], wn[i], kg0); ((GAS f32x2*)Z1)[tid + 512 * i] = (f32x2){gg.x * (y.x + sk * zc[i].x), gg.y * (-y.y + sk * zc[i].y)}; } } }
        else { const bf16* g1 = HYT + (size_t)(2048 + c) * M; const float sk = ((const GAS float*)F.I(20))[l * 2048 + 1024 + c]; unsigned wp[16], wg[16], wn[16]; f32x2 zz[16]; HY_LD3(g1, wp, wg, wn);
#pragma unroll
            for (int i = 0; i < 16; ++i) zz[i] = ((const GAS f32x2*)Z1)[tid + 512 * i];
#pragma unroll
            for (int i = 0; i < 16; ++i) { const f32x2 y = fb_ld(FB, tid + 512 * i), gg = conv_pair(wp[i], wg[i], wn[i], kg1);
                *(GAS unsigned*)(HYO + (size_t)c * M + 2 * (tid + 512 * i)) = pk2(gg.x * (y.x + sk * zz[i].x), gg.y * (-y.y + sk * zz[i].y)); } }
        __syncthreads();
    }
}
DEV void retc_unit(const Frame& F, int l, int n, int h) {
    int tid = F.tid; asm volatile("" : "+v"(tid)); const int t0 = n * 128, lane = tid & 63, w = F.wave, fr = lane & 15, fq = lane >> 4;
    LAS unsigned char* QS = F.lds; LAS unsigned char* KS = F.lds + 34816; LAS unsigned char* BIG = F.lds + 69632;
    const bf16* Qr = F.W<bf16>(WS_PROJ + 160 * MiB); const bf16* Kr = F.W<bf16>(WS_PROJ + 192 * MiB); const bf16* V = F.W<bf16>(WS_PROJ + 224 * MiB);
    const bf16* Gs = F.W<bf16>(WS_PROJ + 288 * MiB); const bf16* KV = F.W<bf16>(WS_KV); bf16* MIX = F.W<bf16>(WS_MIX);
    const float l2g = log2f(1.f - exp2f(-5.f - (float)h));
    { v4u qv[4], kv[4], vr0[4], vr1[4];
#pragma unroll
    for (int k = 0; k < 4; ++k) { const int task = tid + 512 * k, r = task >> 4, ch = task & 15;
        qv[k] = *(const GAS v4u*)(Qr + (size_t)(t0 + r) * 1024 + h * 128 + ch * 8); kv[k] = *(const GAS v4u*)(Kr + (size_t)(t0 + r) * 1024 + h * 128 + ch * 8); }
#pragma unroll
    for (int k = 0; k < 4; ++k) { const int task = tid + 512 * k, p = task & 63, ch = task >> 6, c0 = 2 * p;
        vr0[k] = *(const GAS v4u*)(V + (size_t)(t0 + c0) * 2048 + h * 256 + ch * 8); vr1[k] = *(const GAS v4u*)(V + (size_t)(t0 + c0 + 1) * 2048 + h * 256 + ch * 8); }
#pragma unroll
    for (int k = 0; k < 4; ++k) { const int task = tid + 512 * k, r = task >> 4, ch = task & 15; *(LAS v4u*)(QS + r * 272 + ch * 16) = qv[k]; *(LAS v4u*)(KS + r * 272 + ch * 16) = kv[k]; }
#pragma unroll
    for (int k = 0; k < 4; ++k) { const int task = tid + 512 * k, p = task & 63, ch = task >> 6, c0 = 2 * p;
        const v4u r0 = vr0[k], r1 = vr1[k];
#define VT_ST(E) { *(LAS unsigned*)(BIG + (ch * 8 + E) * 272 + c0 * 2) = pk2(bfe<E>(r0), bfe<E>(r1)); }
        VT_ST(0) VT_ST(1) VT_ST(2) VT_ST(3) VT_ST(4) VT_ST(5) VT_ST(6) VT_ST(7)
#undef VT_ST
    } }
    __syncthreads();
    v4u sv[8];
    { const bf16* st = KV + ((size_t)(0 * 128 + n) * 8 + h) * 32768;
#pragma unroll
      for (int k = 0; k < 8; ++k) { const int task = tid + 512 * k, r = task >> 4, ch = task & 15; sv[k] = *(const GAS v4u*)(st + r * 128 + ch * 8); } }
    bf16x8 aq[4];
#pragma unroll
    for (int s = 0; s < 4; ++s) aq[s] = lfrag(QS, 16 * w, s, 272, fr, fq);
    f32x4 S[8];
#pragma unroll
    for (int jt = 0; jt < 8; ++jt) { S[jt] = (f32x4){0.f, 0.f, 0.f, 0.f};
#pragma unroll
        for (int s = 0; s < 4; ++s) S[jt] = mfma16(aq[s], lfrag(KS, 16 * jt, s, 272, fr, fq), S[jt]);
#pragma unroll
        for (int e = 0; e < 4; ++e) { const int i = 16 * w + 4 * fq + e, j = 16 * jt + fr; S[jt][e] *= __builtin_amdgcn_exp2f(l2g * fabsf((float)(i - j))); } }
    __syncthreads();
#pragma unroll
    for (int jt = 0; jt < 8; ++jt)
#pragma unroll
        for (int e = 0; e < 4; ++e) *(LAS bf16*)(KS + (16 * w + 4 * fq + e) * 272 + (16 * jt + fr) * 2) = f2bf(S[jt][e]);
    LDS_WAIT();
    __syncthreads();
    f32x4 y[16];
    { bf16x8 ap[4];
#pragma unroll
      for (int s = 0; s < 4; ++s) ap[s] = lfrag(KS, 16 * w, s, 272, fr, fq);
#pragma unroll
      for (int et = 0; et < 16; ++et) { y[et] = (f32x4){0.f, 0.f, 0.f, 0.f};
#pragma unroll
          for (int s = 0; s < 4; ++s) y[et] = mfma16(ap[s], lfrag(BIG, 16 * et, s, 272, fr, fq), y[et]);
          __builtin_amdgcn_sched_barrier(0); } }
    __syncthreads();
    const float* gn = F.I(22) + l * 2048 + h * 256;
    v4u gvv[8];
#pragma unroll
    for (int dir = 0; dir < 2; ++dir) {
#pragma unroll
        for (int k = 0; k < 8; ++k) { const int task = tid + 512 * k, r = task >> 4, ch = task & 15; *(LAS v4u*)(BIG + r * 272 + ch * 16) = sv[k]; }
        if (dir == 0) { const bf16* st = KV + ((size_t)(1 * 128 + n) * 8 + h) * 32768;
#pragma unroll
            for (int k = 0; k < 8; ++k) { const int task = tid + 512 * k, r = task >> 4, ch = task & 15; sv[k] = *(const GAS v4u*)(st + r * 128 + ch * 8); } }
        else {
#pragma unroll
            for (int k = 0; k < 8; ++k) { const int task = tid + 512 * k, t = task >> 5, ch = task & 31; gvv[k] = *(const GAS v4u*)(Gs + (size_t)(t0 + t) * 2048 + h * 256 + ch * 8); } }
        __syncthreads();
        float fac[4];
#pragma unroll
        for (int e = 0; e < 4; ++e) { const int i = 16 * w + 4 * fq + e; fac[e] = __builtin_amdgcn_exp2f(l2g * (dir == 0 ? (float)(i + 1) : (float)(128 - i))); }
#pragma unroll
        for (int et = 0; et < 16; ++et) { f32x4 t = (f32x4){0.f, 0.f, 0.f, 0.f};
#pragma unroll
            for (int s = 0; s < 4; ++s) t = mfma16(aq[s], lfrag(BIG, 16 * et, s, 272, fr, fq), t);
#pragma unroll
            for (int e = 0; e < 4; ++e) y[et][e] += fac[e] * t[e];
            __builtin_amdgcn_sched_barrier(0); }
        __syncthreads();
    }
    float rinv[4];
#pragma unroll
    for (int e = 0; e < 4; ++e) { float ss = 0.f;
#pragma unroll
        for (int et = 0; et < 16; ++et) ss += y[et][e] * y[et][e];
        ss += shx(ss, 1, lane); ss += shx(ss, 2, lane); ss += shx(ss, 4, lane); ss += shx(ss, 8, lane); rinv[e] = rsqrtf(ss * (1.f / 256.f) + EPS); }
#pragma unroll
    for (int et = 0; et < 16; ++et)
#pragma unroll
        for (int e = 0; e < 4; ++e) *(LAS bf16*)(BIG + (16 * w + 4 * fq + e) * 528 + (16 * et + fr) * 2) = f2bf(y[et][e] * rinv[e]);
    __syncthreads();
    const f32x4 g0 = *(const GAS f32x4*)(gn + (tid & 31) * 8), g1 = *(const GAS f32x4*)(gn + (tid & 31) * 8 + 4);
#pragma unroll
    for (int k = 0; k < 8; ++k) { const int task = tid + 512 * k, t = task >> 5, ch = task & 31;
        const v4u yv = *(const LAS v4u*)(BIG + t * 528 + ch * 16); const v4u gv = gvv[k];
        v4u o; o.x = pk2(bflo(yv.x) * g0[0] * bflo(gv.x), bfhi(yv.x) * g0[1] * bfhi(gv.x)); o.y = pk2(bflo(yv.y) * g0[2] * bflo(gv.y), bfhi(yv.y) * g0[3] * bfhi(gv.y));
        o.z = pk2(bflo(yv.z) * g1[0] * bflo(gv.z), bfhi(yv.z) * g1[1] * bfhi(gv.z)); o.w = pk2(bflo(yv.w) * g1[2] * bflo(gv.w), bfhi(yv.w) * g1[3] * bfhi(gv.w));
        *(GAS v4u*)(MIX + (size_t)(t0 + t) * 4096 + 2048 + h * 256 + ch * 8) = o; }
}
DEV void hyn_unit(const Frame& F, int l, int unit) {
    int tid = F.tid; asm volatile("" : "+v"(tid)); const int g = unit >> 7, t0 = (unit & 127) * 128;
    LAS float* S = (LAS float*)F.lds; LAS float* RED = S + 128 * 129;
    const bf16* HYO = F.W<bf16>(WS_HYO); bf16* MIX = F.W<bf16>(WS_MIX);
    v4u hv[4];
#pragma unroll
    for (int k = 0; k < 4; ++k) { const int task = tid + 512 * k, cc = task >> 4, ch = task & 15; hv[k] = *(const GAS v4u*)(HYO + (size_t)(128 * g + cc) * M + t0 + ch * 8); }
#pragma unroll
    for (int k = 0; k < 4; ++k) { const int task = tid + 512 * k, cc = task >> 4, ch = task & 15; const v4u v = hv[k];
        LAS float* d = S + cc * 129 + ch * 8; d[0] = bflo(v.x); d[1] = bfhi(v.x); d[2] = bflo(v.y); d[3] = bfhi(v.y); d[4] = bflo(v.z); d[5] = bfhi(v.z); d[6] = bflo(v.w); d[7] = bfhi(v.w); }
    __syncthreads();
    { const int t = tid & 127, part = tid >> 7; float ss = 0.f;
#pragma unroll 8
      for (int cc = 0; cc < 32; ++cc) { const float v = S[(32 * part + cc) * 129 + t]; ss += v * v; }
      RED[part * 128 + t] = ss; }
    __syncthreads();
    const float* gn = F.I(21) + l * 1024 + 128 * g;
    for (int task = tid; task < 2048; task += 512) { const int t = task >> 4, ch = task & 15;
        const float rinv = rsqrtf((RED[t] + RED[128 + t] + RED[256 + t] + RED[384 + t]) * (1.f / 128.f) + EPS); float y[8];
#pragma unroll
        for (int e = 0; e < 8; ++e) y[e] = S[(8 * ch + e) * 129 + t] * rinv * gn[8 * ch + e];
        v4u o; o.x = pk2(y[0], y[1]); o.y = pk2(y[2], y[3]); o.z = pk2(y[4], y[5]); o.w = pk2(y[6], y[7]);
        *(GAS v4u*)(MIX + (size_t)(t0 + t) * 4096 + 1024 + 128 * g + 8 * ch) = o; }
    __syncthreads();
}
DEV void final_norm(const Frame& F) {
    const ssq_t* ssq = F.W<ssq_t>(CTL_SSQ_OFF) + 4 * M; const float* gn = F.I(28); const bf16* xb = F.W<bf16>(WS_XB); const int gw = F.vcu * 8 + F.wave, NGW = F.G * 8, lane = F.lane;
    for (int m = gw; m < M; m += NGW) { const float rs = rstd_of(ssq, m); GAS f32x4* xo = (GAS f32x4*)(F.O() + (size_t)m * D) + lane; const GAS v2u* xi = (const GAS v2u*)(xb + (size_t)m * D) + lane; const GAS f32x4* gr = (const GAS f32x4*)gn + lane;
#pragma unroll
        for (int j = 0; j < 16; ++j) { const v2u v = xi[64 * j]; const f32x4 g = gr[64 * j]; xo[64 * j] = (f32x4){bflo(v.x) * rs * g[0], bfhi(v.x) * rs * g[1], bflo(v.y) * rs * g[2], bfhi(v.y) * rs * g[3]}; } }
}

DEV int bidx() { int c = (int)blockIdx.x; asm volatile("" : "+s"(c)); return c; }
DEV bool in_phase(int lo, int hi, int k) { asm volatile("" : "+s"(lo), "+s"(hi)); return lo <= k && k < hi; }
__global__ void __launch_bounds__(512, 2) fwd_kernel(Args args) {
    extern __shared__ __attribute__((aligned(16))) unsigned char lds_raw[];
    Frame F; F.lds = (LAS unsigned char*)lds_raw; F.tid = threadIdx.x; F.lane = F.tid & 63; F.wave = __builtin_amdgcn_readfirstlane(F.tid >> 6);
    F.G = gridDim.x; { const int bx = blockIdx.x; F.vcu = (F.G % 8 == 0) ? (bx % 8) * (F.G / 8) + bx / 8 : bx; }
    F.in = args.in; F.out = args.out; F.ws = args.ws;
    volatile LAS unsigned* MISC = (volatile LAS unsigned*)(F.lds + MISC_OFF);
    if (F.tid < 64) MISC[F.tid] = 0u;
    __syncthreads();
    const int lo = args.ph_lo, hi = args.ph_hi;
    unsigned* barw = F.W<unsigned>(WS_CTL) + CW_BAR;
    XcdBarrier bar; bar.bar = barw; bar.x = 0; bar.st = nullptr;
    if (hi - lo > 1) bar = xcd_barrier_post(barw, MISC + 8);
#ifndef G3_ALIGN
#define G3_ALIGN GEMM_ALIGN
#endif
#ifndef GEMM_ALIGN
#define GEMM_ALIGN true
#endif
#ifndef GEMM_SP2
#define GEMM_SP2 true
#endif
#ifndef REP_P0
#define REP_P0 1
#endif
#ifndef REP_G1
#define REP_G1 1
#endif
#ifndef REP_MA
#define REP_MA 1
#endif
#ifndef REP_HY
#define REP_HY 1
#endif
#ifndef REP_MC
#define REP_MC 1
#endif
#ifndef REP_G3
#define REP_G3 1
#endif
#ifndef REP_HYT
#define REP_HYT 1
#endif
#ifndef REP_HYF
#define REP_HYF 1
#endif
#ifndef REP_LRUA
#define REP_LRUA 1
#endif
#ifndef REP_RETA
#define REP_RETA 1
#endif
#ifndef REP_LRUC
#define REP_LRUC 1
#endif
#ifndef REP_RETC
#define REP_RETC 1
#endif
#ifndef REP_HYN
#define REP_HYN 1
#endif
#ifndef PHASE_EN
#define PHASE_EN 0xffffffffu
#endif
#define EN(b) ((PHASE_EN >> (b)) & 1u)
#define IN(k) in_phase(lo, hi, (k))
#define SEAM(k) do { if (IN(k) && IN((k) + 1)) { asm volatile("" : "+s"(bar.bar)); xcd_barrier(bar, F.tid == 0); } FENCE(); } while (0)
#define FENCE() do { asm volatile("" : "+s"(F.ws), "+s"(F.out)); asm volatile("" : "+s"(F.G)); int ln_; asm volatile("v_mbcnt_lo_u32_b32 %0, -1, 0\n\tv_mbcnt_hi_u32_b32 %0, -1, %0" : "=v"(ln_)); F.lane = ln_; F.tid = F.wave * 64 + ln_; } while (0)
    FENCE();
    if (EN(0) && IN(0)) { for (int rep = 0; rep < REP_P0; ++rep) p0_prologue(F, rep); }
    SEAM(0);
    for (int l = 0; l < NLAYER; ++l) {
        const int pb = 1 + 7 * l;
        if (EN(1) && IN(pb + 0)) for (int rep = 0; rep < REP_G1; ++rep) {
            if (l == 0 && I8_GU(0)) { wq_rows(F, 0); FENCE(); }
            bf16* XB = F.W<bf16>(WS_XB); bf16* PR = F.W<bf16>(WS_PROJ);
            pg8::Gemm g{XB, F.W<bf16>(WS_WIN + (size_t)l * 88 * MiB), M, NIN, D};
            struct SkipHu : pg8::StaticOrder { DEV bool next(int i, pg8::Unit& u) const { const bool ok = pg8::StaticOrder::next(i, u); if (u.pn >= 8) u.pn += 12; return ok; } };
            SkipHu S; S.init(M, NIN - 3072, F.G, bidx());
            EpiIn E{PR, F.W<bf16>(WS_PROJ + 32 * MiB), F.W<bf16>(WS_PROJ + 64 * MiB), F.W<bf16>(WS_PROJ + 160 * MiB), F.W<bf16>(WS_PROJ + 192 * MiB), F.W<bf16>(WS_PROJ + 224 * MiB), F.W<bf16>(WS_PROJ + 288 * MiB),
                    F.W<ssq_t>(CTL_SSQ_OFF) + (2 * l) * M, F.W<float>(WS_ROT)};
            pg8::gemm_phase<EpiIn, SkipHu, GEMM_ALIGN, GEMM_SP2>(F.lds, g, S, E, F.tid);
            pg8::Gemm g2{F.W<bf16>(WS_WIN + (size_t)l * 88 * MiB) + (size_t)2048 * D, XB, 3072, M, D}; pg8::StaticOrder S2; S2.init(3072, M, F.G, bidx());
            EpiHuT E2{F.W<bf16>(WS_HYT), F.W<ssq_t>(CTL_SSQ_OFF) + (2 * l) * M};
            pg8::gemm_phase<EpiHuT, pg8::StaticOrder, GEMM_ALIGN, GEMM_SP2>(F.lds, g2, S2, E2, F.tid);
        }
        SEAM(pb + 0);
        if (IN(pb + 1)) for (int rep = 0; rep < REP_MA; ++rep) {
            if (I8_GU(l) && l > 0) wq_rows(F, l);
            if (EN(3)) for (int r2 = 0; r2 < REP_HYF; ++r2) for (int it = F.vcu * 8 + F.wave; it < 2048; it += F.G * 8) hyf_item(F, l, it);
            __syncthreads();
            if (EN(4)) for (int r2 = 0; r2 < REP_LRUA; ++r2) for (int u = F.vcu; u < 1024; u += F.G) lru_unit<false>(F, l, u >> 3, u & 7);
            if (EN(5)) for (int r2 = 0; r2 < REP_RETA; ++r2) for (int u = F.vcu; u < 1024; u += F.G) reta_unit(F, u >> 3, u & 7);
        }
        SEAM(pb + 1);
        if (IN(pb + 2)) {
            if (EN(6)) { lrub_all(F); if (F.G * 512 < 131072) retb_all(F); }
            RetbJob job = retb_begin(F);
            FENCE();
            { LAS f32x2* TH = (LAS f32x2*)(F.lds + FFT_TAB_OFF);
              if (F.tid < 128) { const float j = (float)F.tid; TH[F.tid] = (f32x2){cospif(j * (1.f / 64.f)), -sinpif(j * (1.f / 64.f))}; TH[128 + F.tid] = (f32x2){cospif(j * (1.f / 8192.f)), -sinpif(j * (1.f / 8192.f))};
                  TH[256 + F.tid] = (f32x2){cospif(j * (1.f / 128.f)), -sinpif(j * (1.f / 128.f))}; TH[384 + F.tid] = (f32x2){cospif(j * (1.f / 16384.f)), -sinpif(j * (1.f / 16384.f))}; }
              __syncthreads(); }
            if (EN(7)) for (int rep = 0; rep < REP_HY; ++rep) for (int u = F.vcu; u < 1024; u += F.G) hyena_unit(F, l, u, job);
            while (job.left > 0) { v2u jv[8]; retb_load<8>(job, jv); retb_store<8>(job, jv); }
        }
        SEAM(pb + 2);
        if (IN(pb + 3)) for (int rep = 0; rep < REP_MC; ++rep) {
            if (EN(8)) for (int r2 = 0; r2 < REP_LRUC; ++r2) for (int u = F.vcu; u < 1024; u += F.G) lru_unit<true>(F, l, u >> 3, u & 7);
            if (EN(9)) for (int r2 = 0; r2 < REP_RETC; ++r2) for (int u = F.vcu; u < 1024; u += F.G) { retc_unit(F, l, u >> 3, u & 7); __syncthreads(); }
            if (EN(10)) for (int r2 = 0; r2 < REP_HYN; ++r2) for (int u = F.vcu; u < 1024; u += F.G) hyn_unit(F, l, u);
        }
        SEAM(pb + 3);
        if (EN(11) && IN(pb + 4)) {
            bf16* XB = F.W<bf16>(WS_XB); bf16* MIX = F.W<bf16>(WS_MIX);
            pg8::Gemm g{MIX, F.W<bf16>(WS_WOUT + (size_t)l * 32 * MiB), M, D, D}; pg8::StaticOrder S; S.init(M, D, F.G, bidx());
            EpiRes E{XB, F.W<ssq_t>(CTL_SSQ_OFF) + (2 * l + 1) * M, 1.f, I8_GU(l) ? F.W<unsigned char>(WS_KV) : nullptr, F.W<ssq_t>(CTL_SSQ_OFF) + (2 * l) * M};
            pg8::gemm_phase<EpiRes, pg8::StaticOrder, GEMM_ALIGN, GEMM_SP2>(F.lds, g, S, E, F.tid);
        }
        SEAM(pb + 4);
        if (EN(12) && IN(pb + 5)) for (int rep = 0; rep < REP_G3; ++rep) {
            bf16* XB = F.W<bf16>(WS_XB); bf16* PR = F.W<bf16>(WS_PROJ);
            pg8::StaticOrder S; S.init(M, NGU, F.G, bidx());
            if (I8_GU(l)) {
                pg8::Gemm g{F.W<bf16>(WS_KV), F.W<bf16>(WS_WGU + (size_t)l * 172 * MiB), M, NGU, D / 2, D / 2, D};
                EpiGU_<2> E{(unsigned char*)PR, F.W<ssq_t>(CTL_SSQ_OFF) + (2 * l + 1) * M, FP8_DOWN(l), F.W<ssq_t>(CTL_SSQ_OFF) + (2 * l) * M, F.W<unsigned>(CTL_AMAX_OFF) + l * NGU};
                pg8::gemm_phase<EpiGU_<2>, pg8::StaticOrder, G3_ALIGN, GEMM_SP2, 2>(F.lds, g, S, E, F.tid);
            } else {
                pg8::Gemm g{XB, F.W<bf16>(WS_WGU + (size_t)l * 172 * MiB), M, NGU, D};
                EpiGU E{(unsigned char*)PR, F.W<ssq_t>(CTL_SSQ_OFF) + (2 * l + 1) * M, FP8_DOWN(l), nullptr, nullptr};
                pg8::gemm_phase<EpiGU, pg8::StaticOrder, GEMM_ALIGN, GEMM_SP2>(F.lds, g, S, E, F.tid);
            }
        }
        SEAM(pb + 5);
        if (EN(13) && IN(pb + 6)) {
            bf16* XB = F.W<bf16>(WS_XB); bf16* PR = F.W<bf16>(WS_PROJ);
            pg8::StaticOrder S; S.init(M, D, F.G, bidx());
            if (FP8_DOWN(l)) {
                pg8::Gemm g{PR, F.W<bf16>(WS_WDN + (size_t)l * 86 * MiB), M, D, DFF / 2}; EpiRes E{XB, F.W<ssq_t>(CTL_SSQ_OFF) + (2 * l + 2) * M, 1.f / 8192.f, nullptr, nullptr};
                pg8::gemm_phase<EpiRes, pg8::StaticOrder, GEMM_ALIGN, GEMM_SP2, 1>(F.lds, g, S, E, F.tid);
            } else {
                pg8::Gemm g{PR, F.W<bf16>(WS_WDN + (size_t)l * 86 * MiB), M, D, DFF}; EpiRes E{XB, F.W<ssq_t>(CTL_SSQ_OFF) + (2 * l + 2) * M, 1.f, nullptr, nullptr};
                pg8::gemm_phase<EpiRes, pg8::StaticOrder, GEMM_ALIGN, GEMM_SP2>(F.lds, g, S, E, F.tid);
            }
        }
        SEAM(pb + 6);
    }
    if (EN(14) && IN(15)) final_norm(F);
#undef IN
#undef SEAM
}

#ifndef MK_PER_PHASE
#define MK_PER_PHASE 0
#endif
extern "C" void kernel_launch(void* const* d_in, const int* in_sizes, int n_in, void* d_out, int out_size, void* d_ws, size_t ws_size, hipStream_t stream) {
    static int grid = 0;
    if (grid == 0) {
        if (n_in != 29 || in_sizes[0] != M * D || out_size != M * D || ws_size < WS_END) { fprintf(stderr, "kernel_launch: unexpected shapes / workspace (n_in %d, ws %zu < %zu); nothing launched\n", n_in, ws_size, (size_t)WS_END); grid = -1; return; }
        int dev = 0, cus = 0, per_cu = 0;
        if (hipGetDevice(&dev) != hipSuccess || hipDeviceGetAttribute(&cus, hipDeviceAttributeMultiprocessorCount, dev) != hipSuccess) { grid = -1; return; }
        if (hipFuncSetAttribute((const void*)fwd_kernel, hipFuncAttributeMaxDynamicSharedMemorySize, LDS_BYTES) != hipSuccess) { fprintf(stderr, "kernel_launch: hipFuncSetAttribute failed\n"); grid = -1; return; }
        if (hipOccupancyMaxActiveBlocksPerMultiprocessor(&per_cu, (const void*)fwd_kernel, 512, LDS_BYTES) != hipSuccess || per_cu < 1) { fprintf(stderr, "kernel_launch: occupancy query says %d blocks per CU\n", per_cu); }
        (void)hipGetLastError();
        grid = cus;
    }
    if (grid < 0) return;
    if (hipMemsetAsync((char*)d_ws + WS_CTL, 0, CTL_BYTES, stream) != hipSuccess) return;
    Args a{};
    for (int i = 0; i < 29; ++i) a.in[i] = (const float*)d_in[i];
    a.out = (float*)d_out; a.ws = (unsigned char*)d_ws;
#if MK_PER_PHASE
    for (int p = 0; p < NPH; ++p) { a.ph_lo = p; a.ph_hi = p + 1; hipLaunchKernelGGL(fwd_kernel, dim3(grid), dim3(512), LDS_BYTES, stream, a); }
#else
    a.ph_lo = 0; a.ph_hi = NPH; hipLaunchKernelGGL(fwd_kernel, dim3(grid), dim3(512), LDS_BYTES, stream, a);
#endif
}
```
